# Optimizing an MI355X kernel written in HIP

```python
import jax, jax.numpy as jnp
from jax import lax
import numpy as np

D_MODEL = 1024
BATCH = 16
SEQ = 2048
DEPTH = 1

CHUNK = 64
MIX_WIDTH = D_MODEL
MLSTM_WIDTH = MIX_WIDTH // 2
MLSTM_HEADS = 4
MLSTM_HEAD_DIM = MLSTM_WIDTH // MLSTM_HEADS
MLSTM_CONV = 4
SB_WIDTH = MIX_WIDTH - MLSTM_WIDTH
SB_HEADS = 8
SB_HEAD_DIM = SB_WIDTH // SB_HEADS
SB_BLOCK = 128
D_FF = 2816
FFN_CONV = 3
EPS = 1e-6
IN_COLS = 4 * MLSTM_WIDTH + 2 * MLSTM_HEADS + 3 * SB_WIDTH

kernel_name = 'hybrid_mlstm_stickbreaking_convffn'


def rms_norm(x, w):
    xf = x.astype(jnp.float32)
    y = xf * lax.rsqrt(jnp.mean(xf * xf, axis=-1, keepdims=True) + EPS)
    return (y * w.astype(jnp.float32)).astype(x.dtype)


def causal_depthwise_conv(x, w, b):
    k_width, ch = w.shape
    y = lax.conv_general_dilated(x, w[:, None, :].astype(x.dtype), window_strides=(1,),
                                 padding=[(k_width - 1, 0)],
                                 dimension_numbers=('NWC', 'WIO', 'NWC'),
                                 feature_group_count=ch)
    return y + b.astype(x.dtype)


def split_heads(t, n_heads):
    b, s, w = t.shape
    return t.reshape(b, s, n_heads, w // n_heads).transpose(0, 2, 1, 3)


def merge_heads(t):
    b, h, s, d = t.shape
    return t.transpose(0, 2, 1, 3).reshape(b, s, h * d)


def mlstm_chunkwise(q, k, v, log_i, log_f):
    b, h, s, d = q.shape
    nc = s // CHUNK
    q = q.astype(jnp.float32)
    k = k.astype(jnp.float32) * (d ** -0.5)
    v = v.astype(jnp.float32)
    log_i = log_i.astype(jnp.float32)
    log_f = log_f.astype(jnp.float32)

    def to_chunks(t):
        return jnp.moveaxis(t.reshape(b, h, nc, CHUNK, *t.shape[3:]), 2, 0)

    causal = jnp.tril(jnp.ones((CHUNK, CHUNK), dtype=bool))

    def step(carry, inp):
        c_state, n_state, m_state = carry
        qc, kc, vc, li, lf = inp
        bcum = jnp.cumsum(lf, axis=-1)
        d_log = jnp.where(causal, bcum[..., :, None] - bcum[..., None, :] + li[..., None, :], -jnp.inf)
        inter = bcum + m_state[..., None]
        m_t = jnp.maximum(jnp.max(d_log, axis=-1), inter)
        w_intra = jnp.exp(d_log - m_t[..., None])
        w_inter = jnp.exp(inter - m_t)
        scores = jnp.einsum('bhtd,bhsd->bhts', qc, kc) * w_intra
        num = (jnp.einsum('bhts,bhse->bhte', scores, vc)
               + w_inter[..., None] * jnp.einsum('bhtd,bhde->bhte', qc, c_state))
        den = jnp.sum(scores, axis=-1) + w_inter * jnp.einsum('bhtd,bhd->bht', qc, n_state)
        h_c = num / jnp.maximum(jnp.abs(den), jnp.exp(-m_t))[..., None]
        b_last = bcum[..., -1]
        g = b_last[..., None] - bcum + li
        a = b_last + m_state
        m_new = jnp.maximum(a, jnp.max(g, axis=-1))
        w_k = jnp.exp(g - m_new[..., None])
        decay = jnp.exp(a - m_new)
        c_new = decay[..., None, None] * c_state + jnp.einsum('bhs,bhsd,bhse->bhde', w_k, kc, vc)
        n_new = decay[..., None] * n_state + jnp.einsum('bhs,bhsd->bhd', w_k, kc)
        return (c_new, n_new, m_new), h_c

    init = (jnp.zeros((b, h, d, d), jnp.float32), jnp.zeros((b, h, d), jnp.float32),
            jnp.zeros((b, h), jnp.float32))
    _, hs = lax.scan(step, init, (to_chunks(q), to_chunks(k), to_chunks(v),
                                  to_chunks(log_i), to_chunks(log_f)))
    return jnp.moveaxis(hs, 0, 2).reshape(b, h, s, d)


def stick_breaking_attention(q, k, v):
    b, h, s, d = q.shape
    scale = d ** -0.5
    q = q.astype(jnp.float32)
    k = k.astype(jnp.float32)
    v = v.astype(jnp.float32)
    outs = []
    for blk in range(s // SB_BLOCK):
        t0 = blk * SB_BLOCK
        t1 = t0 + SB_BLOCK
        z = jnp.einsum('bhtd,bhsd->bhts', q[:, :, t0:t1], k[:, :, :t1]) * scale
        t_idx = t0 + jnp.arange(SB_BLOCK)[:, None]
        s_idx = jnp.arange(t1)[None, :]
        mask = s_idx < t_idx
        log_1mb = jnp.where(mask, jax.nn.log_sigmoid(-z), 0.0)
        rem = lax.cumsum(log_1mb, axis=3, reverse=True) - log_1mb
        attn = jnp.where(mask, jnp.exp(jax.nn.log_sigmoid(z) + rem), 0.0)
        outs.append(jnp.einsum('bhts,bhse->bhte', attn, v[:, :, :t1]))
    return jnp.concatenate(outs, axis=2)


def setup_inputs(seed: int = 0) -> dict:
    key = jax.random.key(seed)
    ks = jax.random.split(key, 20)
    f32 = jnp.float32

    def gain(k_, n):
        return 1.0 + 0.05 * jax.random.normal(k_, (DEPTH, n), f32)

    b_f = (jnp.linspace(3.0, 6.0, MLSTM_HEADS, dtype=f32)[None, :]
           + 0.1 * jax.random.normal(ks[6], (DEPTH, MLSTM_HEADS), f32))
    return {
        'x': jax.random.normal(ks[0], (BATCH, SEQ, D_MODEL), f32),
        'pre_mix_norm': gain(ks[1], D_MODEL),
        'w_in': jax.random.normal(ks[2], (DEPTH, D_MODEL, IN_COLS), f32) * D_MODEL ** -0.5,
        'mlstm_conv_w': jax.random.normal(ks[3], (DEPTH, MLSTM_CONV, 2 * MLSTM_WIDTH), f32) * MLSTM_CONV ** -0.5,
        'mlstm_conv_b': 0.01 * jax.random.normal(ks[4], (DEPTH, 2 * MLSTM_WIDTH), f32),
        'mlstm_b_i': 0.1 * jax.random.normal(ks[5], (DEPTH, MLSTM_HEADS), f32),
        'mlstm_b_f': b_f,
        'mlstm_norm': gain(ks[7], MLSTM_WIDTH),
        'w_out': jax.random.normal(ks[8], (DEPTH, MIX_WIDTH, D_MODEL), f32) * MIX_WIDTH ** -0.5,
        'post_mix_norm': gain(ks[9], D_MODEL),
        'pre_ffn_norm': gain(ks[10], D_MODEL),
        'w_up': jax.random.normal(ks[11], (DEPTH, D_MODEL, 2 * D_FF), f32) * D_MODEL ** -0.5,
        'ffn_conv_w': jax.random.normal(ks[12], (DEPTH, FFN_CONV, D_FF), f32) * FFN_CONV ** -0.5,
        'ffn_conv_b': 0.01 * jax.random.normal(ks[13], (DEPTH, D_FF), f32),
        'w_down': jax.random.normal(ks[14], (DEPTH, D_FF, D_MODEL), f32) * D_FF ** -0.5,
        'post_ffn_norm': gain(ks[15], D_MODEL),
    }


def reference(x, pre_mix_norm, w_in, mlstm_conv_w, mlstm_conv_b, mlstm_b_i, mlstm_b_f,
              mlstm_norm, w_out, post_mix_norm, pre_ffn_norm, w_up, ffn_conv_w, ffn_conv_b,
              w_down, post_ffn_norm):
    bsz, seq, _ = x.shape
    o1 = 2 * MLSTM_WIDTH
    o2 = o1 + MLSTM_WIDTH
    o3 = o2 + MLSTM_WIDTH
    o4 = o3 + MLSTM_HEADS
    o5 = o4 + MLSTM_HEADS
    o6 = o5 + SB_WIDTH
    o7 = o6 + SB_WIDTH
    for l in range(DEPTH):
        h = rms_norm(x, pre_mix_norm[l])
        proj = h @ w_in[l]
        qk_m = jax.nn.silu(causal_depthwise_conv(proj[..., :o1], mlstm_conv_w[l], mlstm_conv_b[l]))
        q_m = split_heads(qk_m[..., :MLSTM_WIDTH], MLSTM_HEADS)
        k_m = split_heads(qk_m[..., MLSTM_WIDTH:], MLSTM_HEADS)
        v_m = split_heads(proj[..., o1:o2], MLSTM_HEADS)
        o_gate = jax.nn.sigmoid(proj[..., o2:o3])
        log_i = (proj[..., o3:o4] + mlstm_b_i[l]).transpose(0, 2, 1)
        log_f = jax.nn.log_sigmoid(proj[..., o4:o5] + mlstm_b_f[l]).transpose(0, 2, 1)
        h_m = mlstm_chunkwise(q_m, k_m, v_m, log_i, log_f)
        h_m = rms_norm(h_m.transpose(0, 2, 1, 3),
                       mlstm_norm[l].reshape(MLSTM_HEADS, MLSTM_HEAD_DIM)).reshape(bsz, seq, MLSTM_WIDTH)
        h_m = (o_gate * h_m).astype(x.dtype)

        q_s = split_heads(proj[..., o5:o6], SB_HEADS)
        k_s = split_heads(proj[..., o6:o7], SB_HEADS)
        v_s = split_heads(proj[..., o7:], SB_HEADS)
        h_s = merge_heads(stick_breaking_attention(q_s, k_s, v_s)).astype(x.dtype)

        mix = jnp.concatenate([h_m, h_s], axis=-1) @ w_out[l]
        x = x + rms_norm(mix, post_mix_norm[l])

        h = rms_norm(x, pre_ffn_norm[l])
        gu = h @ w_up[l]
        gate = causal_depthwise_conv(gu[..., :D_FF], ffn_conv_w[l], ffn_conv_b[l])
        y = (jax.nn.gelu(gate, approximate=True) * gu[..., D_FF:]) @ w_down[l]
        x = x + rms_norm(y, post_ffn_norm[l])
    return x
```

```cpp
#include <hip/hip_runtime.h>
#include <cstdio>
#include <cstdint>
namespace pg8 {
#define PG8_LAS __attribute__((address_space(3)))
typedef unsigned short bf16_t;
typedef short bf16x8 __attribute__((ext_vector_type(8)));
typedef float f32x4 __attribute__((ext_vector_type(4)));
typedef unsigned u32x4 __attribute__((ext_vector_type(4)));
constexpr int BM = 256, BK = 64, HALF = 128, HTB = HALF * BK * 2  , STAGE_BYTES = 8 * HTB, NXCD = 8, WGM = 8;

__host__ __device__ __forceinline__ int lds_byte(int r, int c) { const int st = (r >> 4) * 2 + (c >> 5), rr = r & 15, cc = c & 31, ob = rr * 64 + cc * 2; return st * 1024 + (ob ^ (((ob >> 9) & 1) << 5)); }
__host__ __device__ __forceinline__ void stage_rc(int b, int& R, int& C) { const int st = b / 1024, sb = b % 1024, swz = sb ^ (((sb >> 9) & 1) << 5); R = (st >> 1) * 16 + swz / 64; C = (st & 1) * 32 + (swz % 64) / 2; }
__host__ __device__ __forceinline__ int perm32(int rho) { const int n = rho >> 4, i = rho & 15; return 8 * (i >> 2) + 4 * n + (i & 3); }

struct Unit { int pm, pn; };
struct Gemm { const bf16_t* A; const bf16_t* Bt; int M, N, K; };

struct StaticOrder {
    int nM, nN, nwg, G, c;
    __host__ __device__ void init(int M, int N, int G_, int c_) { nM = M / BM; nN = N / BM; nwg = nM * nN; G = G_; c = c_; }
    __host__ __device__ bool next(int i, Unit& u) const {
        const long L = (long)i * G + c; if (L >= nwg) return false;
        int wgid = (int)L; { const int q = nwg / NXCD, r = nwg % NXCD, xcd = wgid % NXCD, off = wgid / NXCD; wgid = (xcd < r ? xcd * (q + 1) : r * (q + 1) + (xcd - r) * q) + off; }
        const int nig = WGM * nN, gid = wgid / nig, fm = gid * WGM, gsz = (nM - fm) < WGM ? (nM - fm) : WGM;
        u.pm = fm + ((wgid % nig) % gsz); u.pn = (wgid % nig) / gsz; return true;
    }
    __device__ __forceinline__ void a_ready(const Unit&) const {}
    __device__ __forceinline__ void done(const Unit&) const {}
};

__device__ __forceinline__ unsigned cvt_pk_bf16(float lo, float hi) { unsigned r; asm volatile("v_cvt_pk_bf16_f32 %0, %1, %2" : "=v"(r) : "v"(lo), "v"(hi)); return r; }
typedef float f32x2 __attribute__((ext_vector_type(2)));
__device__ __forceinline__ f32x2 gelu_pk(f32x2 v) {
    const f32x2 av = __builtin_elementwise_abs(v), d = av * 0.2316418882f + 1.0f;
    f32x2 t; t.x = __builtin_amdgcn_rcpf(d.x); t.y = __builtin_amdgcn_rcpf(d.y);
    f32x2 q = t * 0.5307027145f + (-0.7265760135f); q = q * t + 0.7107068705f; q = q * t + (-0.142248368f); q = q * t + 0.127414796f; q = q * t;
    const f32x2 s = (v * v) * (-0.72134752044f);
    f32x2 e; e.x = __builtin_amdgcn_exp2f(s.x); e.y = __builtin_amdgcn_exp2f(s.y);
    const f32x2 m = v * (q * e), r = v - m;
    f32x2 o; o.x = v.x < 0.f ? m.x : r.x; o.y = v.y < 0.f ? m.y : r.y; return o;
}

template <int ACT  > struct EpiBf16 {
    static constexpr bool PERM = true, AFTER_DRAIN = false; static_assert(ACT == 0 || ACT == 1, "EpiBf16: ACT is 0 (none) or 1 (gelu_pk)");
    bf16_t* O; int ldc; const float* bias; int split_cols; size_t split_stride; float scale0;
    __device__ __forceinline__ void operator()(const f32x4 (&acc)[2][2][4][2], const Unit& u, int wr, int wc, int fr, int fq) const {
        const int row0 = u.pm * BM + wr * 64 + fr; int colt = u.pn * BM; bf16_t* base = O;
        float sc = 1.f; if (split_cols) { const int t = colt / split_cols; base += (size_t)t * split_stride; colt -= t * split_cols; if (t == 0) sc = scale0; }
        const int col0 = colt + wc * 32 + 8 * fq, bcol0 = u.pn * BM + wc * 32 + 8 * fq;
        f32x4 bv[2][2];
#pragma unroll
        for (int bj = 0; bj < 2; ++bj)
#pragma unroll
            for (int n = 0; n < 2; ++n) bv[bj][n] = bias ? *(const f32x4*)(bias + bcol0 + bj * HALF + 4 * n) : (f32x4){0.f, 0.f, 0.f, 0.f};
#pragma unroll
        for (int ai = 0; ai < 2; ++ai)
#pragma unroll
            for (int m = 0; m < 4; ++m) { bf16_t* rowp = base + (size_t)(row0 + ai * HALF + m * 16) * ldc + col0;
#pragma unroll
                for (int bj = 0; bj < 2; ++bj) { f32x4 v0 = acc[ai][bj][m][0] + bv[bj][0], v1 = acc[ai][bj][m][1] + bv[bj][1];
                    if (ACT == 1) { f32x2 a = gelu_pk((f32x2){v0[0], v0[1]}), b = gelu_pk((f32x2){v0[2], v0[3]}), c = gelu_pk((f32x2){v1[0], v1[1]}), d = gelu_pk((f32x2){v1[2], v1[3]});
                        v0 = (f32x4){a.x, a.y, b.x, b.y}; v1 = (f32x4){c.x, c.y, d.x, d.y}; }
                    v0 = v0 * sc; v1 = v1 * sc; u32x4 w; w.x = cvt_pk_bf16(v0[0], v0[1]); w.y = cvt_pk_bf16(v0[2], v0[3]); w.z = cvt_pk_bf16(v1[0], v1[1]); w.w = cvt_pk_bf16(v1[2], v1[3]);
                    *(u32x4*)(rowp + bj * HALF) = w; } }
    }
};

__device__ __forceinline__ float gelu_tanh(float x) {
    const float y = 1.5957691216057308f * (x + 0.044715f * x * x * x);
    return x / (1.0f + __expf(-y));
}
struct EpiGateUp {
    static constexpr bool PERM = true, AFTER_DRAIN = false;
    static constexpr int DFF = 2816;
    bf16_t* ACT; const float* cw; const float* cb; float* GFIRST; float* GLAST; float* UFIRST;
    __device__ __forceinline__ void operator()(const f32x4 (&acc)[2][2][4][2], const Unit& u, int wr, int wc, int fr, int fq) const {
        const int lane = fq * 16 + fr;
        const int colg = u.pn * 128 + wc * 32 + 8 * fq;
        f32x4 w0[2], w1[2], w2[2], bb[2];
#pragma unroll
        for (int n = 0; n < 2; ++n) { w0[n] = *(const f32x4*)(cw + colg + 4 * n); w1[n] = *(const f32x4*)(cw + DFF + colg + 4 * n); w2[n] = *(const f32x4*)(cw + 2 * DFF + colg + 4 * n); bb[n] = *(const f32x4*)(cb + colg + 4 * n); }
        const int src1 = (lane & 48) | ((fr + 15) & 15), src2 = (lane & 48) | ((fr + 14) & 15);
#pragma unroll
        for (int ai = 0; ai < 2; ++ai) {
            f32x4 pp1[2] = {{0.f, 0.f, 0.f, 0.f}, {0.f, 0.f, 0.f, 0.f}}, pp2[2] = {{0.f, 0.f, 0.f, 0.f}, {0.f, 0.f, 0.f, 0.f}};
            const int slab = u.pm * 4 + ai * 2 + wr;
#pragma unroll
            for (int m = 0; m < 4; ++m) {
                f32x4 g[2], uu[2], p1[2], p2[2];
#pragma unroll
                for (int n = 0; n < 2; ++n) { g[n] = acc[ai][0][m][n]; uu[n] = acc[ai][1][m][n];
#pragma unroll
                    for (int j = 0; j < 4; ++j) { p1[n][j] = __shfl(g[n][j], src1); p2[n][j] = __shfl(g[n][j], src2); } }
                const size_t row = (size_t)(u.pm * BM + ai * HALF + wr * 64 + m * 16 + fr);
                u32x4 w;
                unsigned pk[4];
#pragma unroll
                for (int n = 0; n < 2; ++n) {
                    const f32x4 g1 = fr >= 1 ? p1[n] : pp1[n], g2 = fr >= 2 ? p2[n] : pp2[n];
                    const f32x4 cv = w2[n] * g[n] + w1[n] * g1 + w0[n] * g2 + bb[n];
                    float a[4];
#pragma unroll
                    for (int j = 0; j < 4; ++j) a[j] = gelu_tanh(cv[j]) * uu[n][j];
                    pk[2 * n] = cvt_pk_bf16(a[0], a[1]); pk[2 * n + 1] = cvt_pk_bf16(a[2], a[3]);
                }
                w.x = pk[0]; w.y = pk[1]; w.z = pk[2]; w.w = pk[3];
                if (m == 0 && fr < 2) {
                    float* gf = GFIRST + (size_t)(slab * 2 + fr) * DFF + colg; float* uf = UFIRST + (size_t)(slab * 2 + fr) * DFF + colg;
                    *(f32x4*)gf = g[0]; *(f32x4*)(gf + 4) = g[1]; *(f32x4*)uf = uu[0]; *(f32x4*)(uf + 4) = uu[1];
                } else {
                    *(u32x4*)(ACT + row * DFF + colg) = w;
                }
                if (m == 3 && fr >= 14) { float* gl = GLAST + (size_t)(slab * 2 + (fr - 14)) * DFF + colg; *(f32x4*)gl = g[0]; *(f32x4*)(gl + 4) = g[1]; }
#pragma unroll
                for (int n = 0; n < 2; ++n) { pp1[n] = p1[n]; pp2[n] = p2[n]; }
            }
        }
    }
};
template <class Epi, class Sched, bool ALIGN_EPI = false, bool SP2 = false>
__device__ __forceinline__ void gemm_phase(PG8_LAS unsigned char* lds, const Gemm g, const Sched& S, const Epi& E) {
    const int tid = threadIdx.x, wid = __builtin_amdgcn_readfirstlane(tid >> 6), lane = tid & 63, wr = wid >> 2, wc = wid & 3, fr = lane & 15, fq = lane >> 4;
    const int K = g.K, nt = K / BK;
    unsigned voffA[2], voffB[2];
#pragma unroll
    for (int i = 0; i < 2; ++i) { int R, C; stage_rc(tid * 16 + i * 8192, R, C); const int Rb = Epi::PERM ? ((R & ~31) + perm32(R & 31)) : R;
        voffA[i] = (unsigned)(R * K + C) * 2u; voffB[i] = (unsigned)(Rb * K + C) * 2u; }
    const size_t kstep = (size_t)(BK * 2);
    const size_t hstep = (size_t)HALF * K * 2;
    const size_t tstep = 2 * hstep;
    const unsigned ldsw = (unsigned)wid * 1024u;
    const int aoff = lds_byte(wr * 64 + fr, fq * 8), boff = lds_byte(wc * 32 + fr, fq * 8);
#define PG8_SA(b, h) (((b) * 2 + (h)) * HTB)
#define PG8_SB(b, h) ((4 + (b) * 2 + (h)) * HTB)
#define PG8_STAGE(bufoff, gbase, voff) do { _Pragma("unroll") for (int _i = 0; _i < 2; ++_i) \
        __builtin_amdgcn_global_load_lds((const unsigned*)((const char*)(gbase) + (voff)[_i]), (PG8_LAS unsigned*)(lds + (bufoff) + ldsw + _i * 8192), 16, 0, 0); } while (0)
#define PG8_LDA(dst, b, h) do { _Pragma("unroll") for (int m = 0; m < 4; ++m) _Pragma("unroll") for (int k = 0; k < 2; ++k) dst[m][k] = *(const PG8_LAS bf16x8*)(lds + PG8_SA(b, h) + aoff + m * 2048 + k * 1024); } while (0)
#define PG8_LDB(dst, b, h) do { _Pragma("unroll") for (int n = 0; n < 2; ++n) _Pragma("unroll") for (int k = 0; k < 2; ++k) dst[n][k] = *(const PG8_LAS bf16x8*)(lds + PG8_SB(b, h) + boff + n * 2048 + k * 1024); } while (0)
#define PG8_MMA(ai, bj, At, Bt) do { __builtin_amdgcn_s_setprio(1); _Pragma("unroll") for (int m = 0; m < 4; ++m) _Pragma("unroll") for (int n = 0; n < 2; ++n) _Pragma("unroll") for (int k = 0; k < 2; ++k) \
        acc[ai][bj][m][n] = __builtin_amdgcn_mfma_f32_16x16x32_bf16(Bt[n][k], At[m][k], acc[ai][bj][m][n], 0, 0, 0); __builtin_amdgcn_s_setprio(0); } while (0)
#define PG8_WAIT_V(n) asm volatile("s_waitcnt vmcnt(" #n ")" ::: "memory")
#define PG8_WAIT_L(n) asm volatile("s_waitcnt lgkmcnt(" #n ")" ::: "memory")
#define PG8_BAR __builtin_amdgcn_s_barrier()
#define PG8_SCHED __builtin_amdgcn_sched_barrier(0)
    Unit cur, nxt; int ui = 0;
    if (!S.next(0, cur)) return;
    f32x4 acc[2][2][4][2];
#pragma unroll
    for (int a = 0; a < 2; ++a)
#pragma unroll
        for (int b = 0; b < 2; ++b)
#pragma unroll
            for (int m = 0; m < 4; ++m)
#pragma unroll
                for (int n = 0; n < 2; ++n) acc[a][b][m][n] = (f32x4){0.f, 0.f, 0.f, 0.f};
    bf16x8 At[4][2], B0[2][2], B1[2][2];
    const char* cA = (const char*)g.A + (size_t)cur.pm * tstep; const char* cB = (const char*)g.Bt + (size_t)cur.pn * tstep;
    S.a_ready(cur);
    if constexpr (SP2) {
        PG8_STAGE(PG8_SB(0, 0), cB, voffB); PG8_STAGE(PG8_SB(0, 1), cB + hstep, voffB); PG8_STAGE(PG8_SA(0, 0), cA, voffA); PG8_STAGE(PG8_SA(0, 1), cA + hstep, voffA);
        if (wr == 1) PG8_BAR;
        PG8_WAIT_V(2); PG8_BAR;
        PG8_STAGE(PG8_SB(1, 0), cB + kstep, voffB); PG8_STAGE(PG8_SA(1, 0), cA + kstep, voffA); PG8_STAGE(PG8_SB(1, 1), cB + hstep + kstep, voffB);
        PG8_WAIT_V(6); PG8_BAR;
    } else {
        PG8_STAGE(PG8_SB(0, 0), cB, voffB); PG8_STAGE(PG8_SA(0, 0), cA, voffA); PG8_STAGE(PG8_SB(0, 1), cB + hstep, voffB); PG8_STAGE(PG8_SA(0, 1), cA + hstep, voffA);
        if (wr == 1) PG8_BAR;
        PG8_WAIT_V(4); PG8_BAR;
        PG8_STAGE(PG8_SB(1, 0), cB + kstep, voffB); PG8_STAGE(PG8_SA(1, 0), cA + kstep, voffA); PG8_STAGE(PG8_SB(1, 1), cB + hstep + kstep, voffB);
        PG8_WAIT_V(6); PG8_BAR;
    }
    for (;;) {
        const bool has_next = S.next(ui + 1, nxt);
        const char* nA = has_next ? (const char*)g.A + (size_t)nxt.pm * tstep : cA; const char* nB = has_next ? (const char*)g.Bt + (size_t)nxt.pn * tstep : cB;
        for (int t = 0; t < nt; t += 2) {
            const bool last = (t == nt - 2);
            const char* a1 = cA + (size_t)(t + 1) * kstep;
            const char* a2 = last ? nA : cA + (size_t)(t + 2) * kstep; const char* b2 = last ? nB : cB + (size_t)(t + 2) * kstep;
            const char* a3 = a2 + kstep; const char* b3 = b2 + kstep;
            if (last && has_next) S.a_ready(nxt);
            if constexpr (SP2) {
            PG8_LDB(B0, 0, 0); PG8_LDB(B1, 0, 1); PG8_SCHED; PG8_LDA(At, 0, 0); PG8_STAGE(PG8_SA(1, 1), a1 + hstep, voffA);
            PG8_WAIT_V(8); PG8_WAIT_L(0); PG8_BAR; PG8_MMA(0, 0, At, B0); PG8_MMA(0, 1, At, B1); PG8_BAR; PG8_SCHED;
            PG8_LDA(At, 0, 1); PG8_STAGE(PG8_SB(0, 0), b2, voffB); PG8_STAGE(PG8_SB(0, 1), b2 + hstep, voffB); PG8_STAGE(PG8_SA(0, 0), a2, voffA);
            PG8_WAIT_V(8); PG8_WAIT_L(0); PG8_BAR; PG8_MMA(1, 0, At, B0); PG8_MMA(1, 1, At, B1); PG8_BAR; PG8_SCHED;
            PG8_LDB(B0, 1, 0); PG8_LDB(B1, 1, 1); PG8_SCHED; PG8_LDA(At, 1, 0); PG8_STAGE(PG8_SA(0, 1), a2 + hstep, voffA);
            PG8_WAIT_V(8); PG8_WAIT_L(0); PG8_BAR; PG8_MMA(0, 0, At, B0); PG8_MMA(0, 1, At, B1); PG8_BAR; PG8_SCHED;
            PG8_LDA(At, 1, 1); PG8_STAGE(PG8_SB(1, 0), b3, voffB); PG8_STAGE(PG8_SB(1, 1), b3 + hstep, voffB); PG8_STAGE(PG8_SA(1, 0), a3, voffA);
            PG8_WAIT_V(8); PG8_WAIT_L(0); PG8_BAR; PG8_MMA(1, 0, At, B0); PG8_MMA(1, 1, At, B1); PG8_BAR; PG8_SCHED;
            } else {
            PG8_LDB(B0, 0, 0); PG8_SCHED; PG8_LDA(At, 0, 0); PG8_STAGE(PG8_SA(1, 1), a1 + hstep, voffA);
            PG8_WAIT_L(8); PG8_BAR; PG8_WAIT_L(0); PG8_MMA(0, 0, At, B0); PG8_BAR; PG8_SCHED;
            PG8_LDB(B1, 0, 1); PG8_STAGE(PG8_SB(0, 0), b2, voffB);
            PG8_BAR; PG8_WAIT_L(0); PG8_MMA(0, 1, At, B1); PG8_BAR;
            PG8_LDA(At, 0, 1); PG8_STAGE(PG8_SA(0, 0), a2, voffA);
            PG8_BAR; PG8_WAIT_L(0); PG8_MMA(1, 0, At, B0); PG8_BAR; PG8_SCHED;
            PG8_STAGE(PG8_SB(0, 1), b2 + hstep, voffB);
            PG8_WAIT_V(6); PG8_BAR; PG8_MMA(1, 1, At, B1); PG8_BAR;
            PG8_LDB(B0, 1, 0); PG8_SCHED; PG8_LDA(At, 1, 0); PG8_STAGE(PG8_SA(0, 1), a2 + hstep, voffA);
            PG8_WAIT_L(8); PG8_BAR; PG8_WAIT_L(0); PG8_MMA(0, 0, At, B0); PG8_BAR; PG8_SCHED;
            PG8_LDB(B1, 1, 1); PG8_STAGE(PG8_SB(1, 0), b3, voffB);
            PG8_BAR; PG8_WAIT_L(0); PG8_MMA(0, 1, At, B1); PG8_BAR;
            PG8_LDA(At, 1, 1); PG8_STAGE(PG8_SA(1, 0), a3, voffA);
            PG8_BAR; PG8_WAIT_L(0); PG8_MMA(1, 0, At, B0); PG8_BAR; PG8_SCHED;
            PG8_STAGE(PG8_SB(1, 1), b3 + hstep, voffB);
            PG8_WAIT_V(6); PG8_BAR; PG8_MMA(1, 1, At, B1); PG8_BAR;
            }
        }
        if constexpr (ALIGN_EPI) { if (wr == 0) PG8_BAR; }
        if constexpr (!Epi::AFTER_DRAIN) { E(acc, cur, wr, wc, fr, fq); S.done(cur); }
        if (!has_next) break;
#pragma unroll
        for (int a = 0; a < 2; ++a)
#pragma unroll
            for (int b = 0; b < 2; ++b)
#pragma unroll
                for (int m = 0; m < 4; ++m)
#pragma unroll
                    for (int n = 0; n < 2; ++n) acc[a][b][m][n] = (f32x4){0.f, 0.f, 0.f, 0.f};
        cur = nxt; cA = nA; cB = nB; ++ui;
        if constexpr (ALIGN_EPI) { if (wr == 1) PG8_BAR; }
    }
    PG8_WAIT_V(0);
    if constexpr (!ALIGN_EPI) { if (wr == 0) PG8_BAR; }
    PG8_BAR;
    if constexpr (Epi::AFTER_DRAIN) { E.fused(acc, cur, wr, wc, fr, fq, lds, wid, lane); S.done(cur); }
#undef PG8_SA
#undef PG8_SB
#undef PG8_STAGE
#undef PG8_LDA
#undef PG8_LDB
#undef PG8_MMA
#undef PG8_WAIT_V
#undef PG8_WAIT_L
#undef PG8_BAR
#undef PG8_SCHED
}
}
#define GAS __attribute__((address_space(1)))
#define LAS __attribute__((address_space(3)))
typedef unsigned short bf16;
typedef unsigned v4u __attribute__((ext_vector_type(4)));
typedef float f32x4 __attribute__((ext_vector_type(4)));
typedef short bf16x8 __attribute__((ext_vector_type(8)));
typedef GAS unsigned gu32;
typedef GAS unsigned long long gu64;
#define RLX_AGENT __ATOMIC_RELAXED, __HIP_MEMORY_SCOPE_AGENT
#define LDS_WAIT() asm volatile("s_waitcnt lgkmcnt(0)" ::: "memory")
#define VM_WAIT() asm volatile("s_waitcnt vmcnt(0)" ::: "memory")
__device__ __forceinline__ unsigned long long rt() { return __builtin_amdgcn_s_memrealtime(); }
__device__ __forceinline__ unsigned f2bf(float f) { unsigned u = __builtin_bit_cast(unsigned, f); return (u + 0x7fffu + ((u >> 16) & 1u)) >> 16; }
__device__ __forceinline__ unsigned pk2(float lo, float hi) { return f2bf(lo) | (f2bf(hi) << 16); }

#define XB_TMO      128
#define XB_XCNT(j)  (256  + 64 * (j))
#define XB_XSUB(j)  (1280 + 64 * (j))
#define XB_XGEN(j)  (2304 + 64 * (j))
#define XB_TOP      3328
#define XB_TOPGEN   3392
#define XCD_BAR_WORDS 3456
#define XB_SPIN_CAP (1u << 18)

__device__ __forceinline__ unsigned xb_ld(unsigned* p)              { return __hip_atomic_load(p, __ATOMIC_RELAXED, __HIP_MEMORY_SCOPE_AGENT); }
__device__ __forceinline__ unsigned xb_add(unsigned* p, unsigned v) { return __hip_atomic_fetch_add(p, v, __ATOMIC_RELAXED, __HIP_MEMORY_SCOPE_AGENT); }
__device__ __forceinline__ unsigned xb_xcc_id() { return (unsigned)__builtin_amdgcn_s_getreg((3 << 11) | 20) & 0xFu; }
#define XB_SPIN(cond, bar) do { unsigned _sp = 0; while (cond) { __builtin_amdgcn_s_sleep(1); \
    if ((++_sp & 255u) == 0u) { if (xb_ld(&(bar)[XB_TMO])) break; if (_sp > XB_SPIN_CAP) { atomicAdd(&(bar)[XB_TMO], 1u); break; } } } } while (0)

struct XcdBarrier {
    unsigned* bar; unsigned x;
    volatile LAS unsigned* st;
};

__device__ __forceinline__ XcdBarrier xcd_barrier_post(unsigned* bar, volatile LAS unsigned* st) {
    XcdBarrier b; b.bar = bar; b.x = xb_xcc_id(); b.st = st;
    if (threadIdx.x == 0) (void)xb_add(&bar[XB_XCNT(b.x)], 1u);
    return b;
}
__device__ __forceinline__ void xcd_barrier_complete(unsigned* bar, unsigned x, unsigned& nloc, unsigned& nx) {
    const unsigned G = gridDim.x * gridDim.y * gridDim.z;
    unsigned sum, cnt, mine, sp = 0u;
    for (;;) {
        sum = 0u; cnt = 0u; mine = 0u;
#pragma unroll
        for (unsigned j = 0; j < 16; ++j) { const unsigned c = xb_ld(&bar[XB_XCNT(j)]); sum += c; cnt += (c > 0u) ? 1u : 0u; mine = (j == x) ? c : mine; }
        if (sum == G) break;
        __builtin_amdgcn_s_sleep(1);
        if ((++sp & 255u) == 0u) { if (xb_ld(&bar[XB_TMO])) break; if (sp > XB_SPIN_CAP) { atomicAdd(&bar[XB_TMO], 1u); break; } }
    }
    nloc = mine > 0u ? mine : 1u; nx = cnt > 0u ? cnt : 1u;
}

__device__ __forceinline__ void xcd_barrier(const XcdBarrier& b) {
    asm volatile("s_waitcnt vmcnt(0)" ::: "memory");
    __syncthreads();
    if (threadIdx.x == 0) {
        unsigned* bar = b.bar;
        __builtin_amdgcn_s_waitcnt(0);
        unsigned nloc = b.st[0], nx = b.st[1];
        if (nloc == 0u) { xcd_barrier_complete(bar, b.x, nloc, nx); b.st[0] = nloc; b.st[1] = nx; }
        const unsigned old = xb_add(&bar[XB_XSUB(b.x)], 1u);
        const unsigned gen = old / nloc;
        if (old + 1u == (gen + 1u) * nloc) {
            __builtin_amdgcn_fence(__ATOMIC_RELEASE, "agent");
            asm volatile("s_waitcnt vmcnt(0)" ::: "memory");
            const unsigned og = xb_add(&bar[XB_TOP], 1u);
            const unsigned tg = og / nx;
            if (og + 1u == (tg + 1u) * nx) xb_add(&bar[XB_TOPGEN], 1u);
            else XB_SPIN(xb_ld(&bar[XB_TOPGEN]) == tg, bar);
            __builtin_amdgcn_fence(__ATOMIC_ACQUIRE, "agent");
            xb_add(&bar[XB_XGEN(b.x)], 1u);
            asm volatile("s_waitcnt vmcnt(0)" ::: "memory");
        } else {
            XB_SPIN(xb_ld(&bar[XB_XGEN(b.x)]) == gen, bar);
            __builtin_amdgcn_fence(__ATOMIC_ACQUIRE, "agent");
            asm volatile("s_waitcnt vmcnt(0)" ::: "memory");
        }
    }
    __syncthreads();
}
namespace mk {
constexpr int NWAVES = 8;
constexpr int BATCH = 16, SEQ = 2048, D = 1024, T = BATCH * SEQ;
constexpr int IN_COLS = 3592, NIN = 3584, DFF = 2816, NUP = 2 * DFF;
constexpr int C_QM = 0, C_KM = 512, C_VM = 1024, C_OM = 1536, C_QS = 2048, C_KS = 2560, C_VS = 3072;
constexpr float EPS = 1e-6f;
constexpr size_t MiB = 1u << 20;
constexpr size_t WS_CTL = 0, CTL_ZERO_BYTES = 1 * MiB;
constexpr size_t WS_WIN = 2 * MiB, WS_WOUT = 9 * MiB, WS_WUP = 11 * MiB, WS_WDN = 22 * MiB, WS_GATES = 28 * MiB;
constexpr size_t WS_H = 32 * MiB, WS_PROJ = 96 * MiB, WS_MIXIN = 320 * MiB, WS_MIX = 384 * MiB, WS_END = 448 * MiB;
constexpr size_t WS_ACT = 96 * MiB, WS_GFIRST = 272 * MiB, WS_GLAST = 283 * MiB, WS_UFIRST = 294 * MiB;
constexpr size_t WS_Y = 320 * MiB;
static_assert(WS_ACT + (size_t)T * DFF * 2 <= WS_GFIRST && WS_UFIRST + 11 * MiB <= WS_MIXIN, "ws map");
constexpr int CW_TMO = 0, CW_BAR = 4096;
constexpr int RING_OFF = 0, RING_BYTES = 131072, LDSCTL_OFF = RING_BYTES, MISC_OFF = LDSCTL_OFF + 320, LDS_BYTES = 147456;

struct Frame {
    LAS unsigned char* lds;
    volatile LAS unsigned* MISC;
    gu32* ctl;
    int tid, lane, wave, vcu, G;
};
__device__ __forceinline__ float wave_sum(float v) {
#pragma unroll
    for (int o = 1; o < 64; o <<= 1) v += __shfl_xor(v, o);
    return v;
}
__device__ __forceinline__ float bf2f(bf16 b) { return __uint_as_float((unsigned)b << 16); }
__device__ __forceinline__ float logsig(float x) { return fminf(x, 0.f) - __logf(1.f + __expf(-fabsf(x))); }
__device__ __forceinline__ float sigmoidf_(float x) { return 1.f / (1.f + __expf(-x)); }

__device__ __forceinline__ void transpose_item(const float* W, int ldw, int srccol0, bf16* WT, int K, int destrow0, int k0, LAS float* scr, int lane) {
#pragma unroll 8
    for (int i = 0; i < 32; ++i) { const int kk = 2 * i + (lane >> 5); scr[kk * 33 + (lane & 31)] = W[(size_t)(k0 + kk) * ldw + srccol0 + (lane & 31)]; }
    LDS_WAIT(); asm volatile("" ::: "memory");
    const int c = lane & 7;
#pragma unroll
    for (int j = 0; j < 4; ++j) { const int n = (lane >> 3) + 8 * j; const LAS float* s = scr + (8 * c) * 33 + n;
        v4u o; o.x = pk2(s[0 * 33], s[1 * 33]); o.y = pk2(s[2 * 33], s[3 * 33]); o.z = pk2(s[4 * 33], s[5 * 33]); o.w = pk2(s[6 * 33], s[7 * 33]);
        *(GAS v4u*)(WT + (size_t)(destrow0 + n) * K + k0 + 8 * c) = o; }
    LDS_WAIT(); asm volatile("" ::: "memory");
}
struct P0Args { const float *x, *g_pre, *w_in, *b_i, *b_f, *w_out, *w_up, *w_down; bf16 *WT_IN, *WT_OUT, *WT_UP, *WT_DN, *H; float* GATES; };
__device__ __forceinline__ void p0_prologue(Frame& F, const P0Args& a) {
    LAS float* scr = (LAS float*)(F.lds + RING_OFF + F.wave * 16384);
    const int gw = F.vcu * NWAVES + F.wave, NGW = F.G * NWAVES;
    constexpr int I_IN = 16 * (NIN / 32), I_OUT = 16 * 32, I_UP = 16 * (NUP / 32), I_DN = (DFF / 64) * 32;
    constexpr int NITEMS = I_IN + I_OUT + I_UP + I_DN;
    for (int it = gw; it < NITEMS; it += NGW) {
        int r = it;
        if (r < I_IN) { const int nblk = NIN / 32, kb = r / nblk, nb = r % nblk, n0 = 32 * nb; const int src = n0 < 2048 ? n0 : n0 + 8;
            transpose_item(a.w_in, IN_COLS, src, a.WT_IN, D, n0, 64 * kb, scr, F.lane); continue; }
        r -= I_IN;
        if (r < I_OUT) { const int kb = r / 32, nb = r % 32; transpose_item(a.w_out, D, 32 * nb, a.WT_OUT, D, 32 * nb, 64 * kb, scr, F.lane); continue; }
        r -= I_OUT;
        if (r < I_UP) { const int nblk = NUP / 32, kb = r / nblk, nb = r % nblk, n0 = 32 * nb, tj = n0 >> 8, w = n0 & 255; const int src = w < 128 ? 128 * tj + w : DFF + 128 * tj + (w - 128);
            transpose_item(a.w_up, NUP, src, a.WT_UP, D, n0, 64 * kb, scr, F.lane); continue; }
        r -= I_UP;
        { const int kb = r / 32, nb = r % 32; transpose_item(a.w_down, D, 32 * nb, a.WT_DN, DFF, 32 * nb, 64 * kb, scr, F.lane); }
    }
    __syncthreads();
    LAS float* WG = (LAS float*)(F.lds + RING_OFF);
    for (int i = F.tid; i < 8 * D; i += NWAVES * 64) { const int k = i >> 3, g = i & 7; WG[g * D + k] = a.w_in[(size_t)k * IN_COLS + 2048 + g]; }
    __syncthreads();
    f32x4 gain[4];
#pragma unroll
    for (int j = 0; j < 4; ++j) gain[j] = ((const GAS f32x4*)a.g_pre)[64 * j + F.lane];
    for (int m = gw; m < T; m += NGW) {
        const GAS f32x4* xr = (const GAS f32x4*)(a.x + (size_t)m * D) + F.lane;
        f32x4 v[4]; float s = 0.f;
#pragma unroll
        for (int j = 0; j < 4; ++j) { v[j] = xr[64 * j]; s += (v[j].x * v[j].x + v[j].y * v[j].y) + (v[j].z * v[j].z + v[j].w * v[j].w); }
        const float rstd = 1.0f / sqrtf(wave_sum(s) * (1.f / D) + EPS);
#pragma unroll
        for (int j = 0; j < 4; ++j) v[j] = v[j] * rstd * gain[j];
        GAS unsigned long long* o8 = (GAS unsigned long long*)(a.H + (size_t)m * D) + F.lane;
#pragma unroll
        for (int j = 0; j < 4; ++j) o8[64 * j] = (unsigned long long)pk2(v[j].x, v[j].y) | ((unsigned long long)pk2(v[j].z, v[j].w) << 32);
        float dots[8];
#pragma unroll
        for (int g = 0; g < 8; ++g) { float d = 0.f;
#pragma unroll
            for (int j = 0; j < 4; ++j) { const f32x4 w = ((const LAS f32x4*)(WG + g * D))[64 * j + F.lane]; d += (v[j].x * w.x + v[j].y * w.y) + (v[j].z * w.z + v[j].w * w.w); }
            dots[g] = wave_sum(d); }
        if (F.lane == 0) {
#pragma unroll
            for (int h = 0; h < 4; ++h) { a.GATES[(size_t)m * 8 + h] = dots[h] + a.b_i[h]; a.GATES[(size_t)m * 8 + 4 + h] = logsig(dots[4 + h] + a.b_f[h]); }
        }
    }
}

struct MixArgs { const bf16* PROJ; const float* GATES; const float *cw, *cb, *mnorm; float* HRAW; bf16* MIXIN; };
__device__ __forceinline__ void mlstm_naive_unit(Frame& F, const MixArgs& a, int b, int h) {
    LAS float* ql = (LAS float*)(F.lds); LAS float* kl = ql + 64 * 128; LAS float* vl = kl + 64 * 128;
    LAS float* fi = vl + 64 * 128; LAS float* ff = fi + 64; LAS float* red = ff + 64; LAS float* redd = red + 2 * 4 * 128;
    const int tid = F.tid, e = tid & 127, dq = tid >> 7;
    const size_t rowbase = (size_t)b * SEQ;
    float C[32], n[32];
#pragma unroll
    for (int i = 0; i < 32; ++i) { C[i] = 0.f; n[i] = 0.f; }
    for (int chunk = 0; chunk < SEQ / 64; ++chunk) {
        __syncthreads();
        for (int i = 0; i < 16; ++i) {
            const int idx = tid + 512 * i, t = idx >> 7, c = idx & 127, tt = chunk * 64 + t;
            float qa = a.cb[h * 128 + c], ka = a.cb[512 + h * 128 + c];
#pragma unroll
            for (int j = 0; j < 4; ++j) { const int ts = tt - 3 + j;
                if (ts >= 0) { const bf16* pr = a.PROJ + (rowbase + ts) * NIN + h * 128 + c;
                    qa += a.cw[j * 1024 + h * 128 + c] * bf2f(pr[C_QM]); ka += a.cw[j * 1024 + 512 + h * 128 + c] * bf2f(pr[C_KM]); } }
            ql[idx] = qa * sigmoidf_(qa); kl[idx] = ka * sigmoidf_(ka) * 0.08838834764831845f;
            vl[idx] = bf2f(a.PROJ[(rowbase + tt) * NIN + C_VM + h * 128 + c]);
        }
        if (tid < 64) { const size_t r = rowbase + chunk * 64 + tid; fi[tid] = __expf(a.GATES[r * 8 + h]); ff[tid] = __expf(a.GATES[r * 8 + 4 + h]); }
        __syncthreads();
        for (int t = 0; t < 64; ++t) {
            const float fg = ff[t], ig = fi[t], ve = vl[t * 128 + e];
            float acc = 0.f, dacc = 0.f;
#pragma unroll
            for (int dd = 0; dd < 32; ++dd) { const float kd = kl[t * 128 + dq * 32 + dd], qd = ql[t * 128 + dq * 32 + dd];
                C[dd] = fg * C[dd] + (ig * kd) * ve; acc += C[dd] * qd; n[dd] = fg * n[dd] + ig * kd; dacc += n[dd] * qd; }
            LAS float* rb = red + (t & 1) * 512; LAS float* rd = redd + (t & 1) * 4;
            rb[dq * 128 + e] = acc; if (e == 0) rd[dq] = dacc;
            __syncthreads();
            if (tid < 128) { const float num = (rb[e] + rb[128 + e]) + (rb[256 + e] + rb[384 + e]); const float den = (rd[0] + rd[1]) + (rd[2] + rd[3]);
                a.HRAW[(rowbase + chunk * 64 + t) * 512 + h * 128 + e] = num / fmaxf(fabsf(den), 1.0f); }
        }
    }
    VM_WAIT(); __syncthreads(); __builtin_amdgcn_fence(__ATOMIC_ACQUIRE, "agent"); VM_WAIT();
    for (int rr = F.wave; rr < SEQ; rr += NWAVES) {
        const size_t r = rowbase + rr;
        const float h0 = a.HRAW[r * 512 + h * 128 + F.lane], h1 = a.HRAW[r * 512 + h * 128 + 64 + F.lane];
        const float rstd = 1.0f / sqrtf(wave_sum(h0 * h0 + h1 * h1) * (1.f / 128.f) + EPS);
        const float o0 = sigmoidf_(bf2f(a.PROJ[r * NIN + C_OM + h * 128 + F.lane])), o1 = sigmoidf_(bf2f(a.PROJ[r * NIN + C_OM + h * 128 + 64 + F.lane]));
        a.MIXIN[r * D + h * 128 + F.lane] = (bf16)f2bf(o0 * h0 * rstd * a.mnorm[h * 128 + F.lane]);
        a.MIXIN[r * D + h * 128 + 64 + F.lane] = (bf16)f2bf(o1 * h1 * rstd * a.mnorm[h * 128 + 64 + F.lane]);
    }
}
__device__ __forceinline__ void sb_naive_unit(Frame& F, const MixArgs& a, int b, int h, int qblk) {
    LAS float* Kl = (LAS float*)(F.lds); LAS float* Vl = Kl + 64 * 64;
    const int tid = F.tid, t = qblk * 512 + tid;
    const size_t rowbase = (size_t)b * SEQ;
    float q[64], o[64], rem = 0.f;
    { const bf16* qp = a.PROJ + (rowbase + t) * NIN + C_QS + h * 64;
#pragma unroll
      for (int d = 0; d < 64; ++d) { q[d] = bf2f(qp[d]) * 0.125f; o[d] = 0.f; } }
    for (int kt = qblk * 8 + 7; kt >= 0; --kt) {
        __syncthreads();
        for (int i = 0; i < 8; ++i) { const int idx = tid + 512 * i, s = idx >> 6, d = idx & 63; const bf16* pr = a.PROJ + (rowbase + kt * 64 + s) * NIN + h * 64 + d;
            Kl[idx] = bf2f(pr[C_KS]); Vl[idx] = bf2f(pr[C_VS]); }
        __syncthreads();
        if (kt * 64 < t) {
            for (int sl = 63; sl >= 0; --sl) {
                if (kt * 64 + sl < t) {
                    float z = 0.f;
#pragma unroll
                    for (int d4 = 0; d4 < 16; ++d4) { const f32x4 kv = ((const LAS f32x4*)(Kl + sl * 64))[d4]; z += (q[4 * d4] * kv.x + q[4 * d4 + 1] * kv.y) + (q[4 * d4 + 2] * kv.z + q[4 * d4 + 3] * kv.w); }
                    const float l = __logf(1.f + __expf(-fabsf(z)));
                    const float ls = fminf(z, 0.f) - l, l1 = fminf(-z, 0.f) - l;
                    const float at = __expf(ls + rem); rem += l1;
#pragma unroll
                    for (int d4 = 0; d4 < 16; ++d4) { const f32x4 vv = ((const LAS f32x4*)(Vl + sl * 64))[d4]; o[4 * d4] += at * vv.x; o[4 * d4 + 1] += at * vv.y; o[4 * d4 + 2] += at * vv.z; o[4 * d4 + 3] += at * vv.w; }
                }
            }
        }
    }
    GAS v4u* op = (GAS v4u*)(a.MIXIN + (rowbase + t) * D + 512 + h * 64);
#pragma unroll
    for (int i = 0; i < 8; ++i) { v4u w; w.x = pk2(o[8 * i], o[8 * i + 1]); w.y = pk2(o[8 * i + 2], o[8 * i + 3]); w.z = pk2(o[8 * i + 4], o[8 * i + 5]); w.w = pk2(o[8 * i + 6], o[8 * i + 7]); op[i] = w; }
}
__device__ __forceinline__ void p2_mixers_naive(Frame& F, const MixArgs& a) {
    const int bx = blockIdx.x;
    if (bx < 64) { mlstm_naive_unit(F, a, bx >> 2, bx & 3); }
    else { for (int u = bx - 64; u < 512; u += (F.G - 64)) { const int qblk = 3 - (u >> 7), bh = u & 127; sb_naive_unit(F, a, bh >> 3, bh & 7, qblk); } }
}

__device__ __forceinline__ void ld_bf16_row16(const bf16* row, int lane, f32x4 (&v)[4]) {
    const GAS unsigned long long* p = (const GAS unsigned long long*)row + lane;
#pragma unroll
    for (int j = 0; j < 4; ++j) { const unsigned long long w = p[64 * j]; const unsigned lo = (unsigned)w, hi = (unsigned)(w >> 32);
        v[j] = (f32x4){__uint_as_float(lo << 16), __uint_as_float(lo & 0xffff0000u), __uint_as_float(hi << 16), __uint_as_float(hi & 0xffff0000u)}; }
}
__device__ __forceinline__ float sumsq16(const f32x4 (&v)[4]) { float s = 0.f;
#pragma unroll
    for (int j = 0; j < 4; ++j) s += (v[j].x * v[j].x + v[j].y * v[j].y) + (v[j].z * v[j].z + v[j].w * v[j].w);
    return s; }
__device__ __forceinline__ void p3b_rows(Frame& F, const float* x, const bf16* MIX, const float* g1, const float* g2, float* out, bf16* H) {
    const int gw = F.vcu * NWAVES + F.wave, NGW = F.G * NWAVES;
    f32x4 ga[4], gb[4];
#pragma unroll
    for (int j = 0; j < 4; ++j) { ga[j] = ((const GAS f32x4*)g1)[64 * j + F.lane]; gb[j] = ((const GAS f32x4*)g2)[64 * j + F.lane]; }
    for (int m = gw; m < T; m += NGW) {
        f32x4 mv[4], xv[4]; ld_bf16_row16(MIX + (size_t)m * D, F.lane, mv);
        const GAS f32x4* xr = (const GAS f32x4*)(x + (size_t)m * D) + F.lane;
#pragma unroll
        for (int j = 0; j < 4; ++j) xv[j] = xr[64 * j];
        const float r1 = 1.0f / sqrtf(wave_sum(sumsq16(mv)) * (1.f / D) + EPS);
#pragma unroll
        for (int j = 0; j < 4; ++j) xv[j] = xv[j] + mv[j] * r1 * ga[j];
        GAS f32x4* orow = (GAS f32x4*)(out + (size_t)m * D) + F.lane;
#pragma unroll
        for (int j = 0; j < 4; ++j) orow[64 * j] = xv[j];
        const float r2 = 1.0f / sqrtf(wave_sum(sumsq16(xv)) * (1.f / D) + EPS);
        GAS unsigned long long* o8 = (GAS unsigned long long*)(H + (size_t)m * D) + F.lane;
#pragma unroll
        for (int j = 0; j < 4; ++j) { const f32x4 hv = xv[j] * r2 * gb[j]; o8[64 * j] = (unsigned long long)pk2(hv.x, hv.y) | ((unsigned long long)pk2(hv.z, hv.w) << 32); }
    }
}
__device__ __forceinline__ void p6_rows(Frame& F, const bf16* Y, const float* g3, float* out) {
    const int gw = F.vcu * NWAVES + F.wave, NGW = F.G * NWAVES;
    f32x4 ga[4];
#pragma unroll
    for (int j = 0; j < 4; ++j) ga[j] = ((const GAS f32x4*)g3)[64 * j + F.lane];
    for (int m = gw; m < T; m += NGW) {
        f32x4 yv[4]; ld_bf16_row16(Y + (size_t)m * D, F.lane, yv);
        GAS f32x4* orow = (GAS f32x4*)(out + (size_t)m * D) + F.lane;
        f32x4 xv[4];
#pragma unroll
        for (int j = 0; j < 4; ++j) xv[j] = orow[64 * j];
        const float r1 = 1.0f / sqrtf(wave_sum(sumsq16(yv)) * (1.f / D) + EPS);
#pragma unroll
        for (int j = 0; j < 4; ++j) orow[64 * j] = xv[j] + yv[j] * r1 * ga[j];
    }
}
__device__ __forceinline__ void p4b_fixup(Frame& F, const float* cw, const float* cb, const float* GFIRST, const float* GLAST, const float* UFIRST, bf16* ACT) {
    constexpr int C4 = DFF / 4, TOTAL = 512 * 2 * C4;
    for (int it = F.vcu * NWAVES * 64 + F.tid; it < TOTAL; it += F.G * NWAVES * 64) {
        const int c4 = it % C4, rs = it / C4, rr = rs & 1, s = rs >> 1; const bool first = (s & 31) == 0;
        const f32x4 z4 = {0.f, 0.f, 0.f, 0.f};
        const f32x4 g0 = *(const GAS f32x4*)(GFIRST + (size_t)(s * 2 + rr) * DFF + 4 * c4);
        f32x4 gm1, gm2;
        if (rr == 0) { gm1 = first ? z4 : *(const GAS f32x4*)(GLAST + (size_t)((s - 1) * 2 + 1) * DFF + 4 * c4); gm2 = first ? z4 : *(const GAS f32x4*)(GLAST + (size_t)((s - 1) * 2 + 0) * DFF + 4 * c4); }
        else { gm1 = *(const GAS f32x4*)(GFIRST + (size_t)(s * 2 + 0) * DFF + 4 * c4); gm2 = first ? z4 : *(const GAS f32x4*)(GLAST + (size_t)((s - 1) * 2 + 1) * DFF + 4 * c4); }
        const f32x4 w0 = *(const GAS f32x4*)(cw + 4 * c4), w1 = *(const GAS f32x4*)(cw + DFF + 4 * c4), w2 = *(const GAS f32x4*)(cw + 2 * DFF + 4 * c4), bb = *(const GAS f32x4*)(cb + 4 * c4);
        const f32x4 uu = *(const GAS f32x4*)(UFIRST + (size_t)(s * 2 + rr) * DFF + 4 * c4);
        const f32x4 cv = w2 * g0 + w1 * gm1 + w0 * gm2 + bb;
        const float a0 = pg8::gelu_tanh(cv.x) * uu.x, a1 = pg8::gelu_tanh(cv.y) * uu.y, a2 = pg8::gelu_tanh(cv.z) * uu.z, a3 = pg8::gelu_tanh(cv.w) * uu.w;
        *(GAS unsigned long long*)(ACT + (size_t)(64 * s + rr) * DFF + 4 * c4) = (unsigned long long)pk2(a0, a1) | ((unsigned long long)pk2(a2, a3) << 32);
    }
}

struct Args { const float* in[16]; float* out; unsigned char* ws; int ph_lo, ph_hi; };
constexpr int N_PHASES = 9;
__global__ void __launch_bounds__(NWAVES * 64, 2) mega_fwd(Args args) {
    extern __shared__ __attribute__((aligned(16))) unsigned char lds[];
    Frame F;
    F.lds = (LAS unsigned char*)lds;
    F.MISC = (volatile LAS unsigned*)(F.lds + MISC_OFF);
    F.tid = threadIdx.x; F.lane = F.tid & 63; F.wave = __builtin_amdgcn_readfirstlane(F.tid >> 6);
    F.G = gridDim.x; { const int bx = blockIdx.x; F.vcu = (F.G % 8 == 0) ? (bx % 8) * (F.G / 8) + bx / 8 : bx; }
    unsigned char* ws = args.ws;
    F.ctl = (gu32*)(ws + WS_CTL);
    const float* x = args.in[0]; const float* g_pre = args.in[1]; const float* w_in = args.in[2]; const float* mconv_w = args.in[3]; const float* mconv_b = args.in[4];
    const float* b_i = args.in[5]; const float* b_f = args.in[6]; const float* mnorm = args.in[7]; const float* w_out = args.in[8]; const float* g_postmix = args.in[9];
    const float* g_preffn = args.in[10]; const float* w_up = args.in[11]; const float* fconv_w = args.in[12]; const float* fconv_b = args.in[13]; const float* w_down = args.in[14];
    const float* g_postffn = args.in[15];
    bf16* WT_IN = (bf16*)(ws + WS_WIN); bf16* WT_OUT = (bf16*)(ws + WS_WOUT); bf16* WT_UP = (bf16*)(ws + WS_WUP); bf16* WT_DN = (bf16*)(ws + WS_WDN);
    float* GATES = (float*)(ws + WS_GATES); bf16* H = (bf16*)(ws + WS_H); bf16* PROJ = (bf16*)(ws + WS_PROJ); bf16* MIXIN = (bf16*)(ws + WS_MIXIN); bf16* MIX = (bf16*)(ws + WS_MIX);
    bf16* ACT = (bf16*)(ws + WS_ACT); float* GFIRST = (float*)(ws + WS_GFIRST); float* GLAST = (float*)(ws + WS_GLAST); float* UFIRST = (float*)(ws + WS_UFIRST); bf16* Y = (bf16*)(ws + WS_Y);
    for (int u = F.tid; u < (LDS_BYTES - LDSCTL_OFF) / 4; u += NWAVES * 64) ((LAS unsigned*)(F.lds + LDSCTL_OFF))[u] = 0u;
    __syncthreads();
    XcdBarrier bar = xcd_barrier_post((unsigned*)(F.ctl + CW_BAR), F.MISC + 8);
    const int lo = args.ph_lo, hi = args.ph_hi;
#define IN(k) (lo <= (k) && (k) < hi)
#define SEAM(k) do { if (IN(k) && IN((k) + 1)) xcd_barrier(bar); } while (0)

    if (IN(0)) { const P0Args a{x, g_pre, w_in, b_i, b_f, w_out, w_up, w_down, WT_IN, WT_OUT, WT_UP, WT_DN, H, GATES}; p0_prologue(F, a); }
    SEAM(0);
    if (IN(1)) { pg8::Gemm g{H, WT_IN, T, NIN, D}; pg8::StaticOrder S; S.init(T, NIN, F.G, (int)blockIdx.x);
        pg8::EpiBf16<0> E{PROJ, NIN, nullptr, 0, 0, 1.f};
        pg8::gemm_phase<pg8::EpiBf16<0>, pg8::StaticOrder, true, true>(F.lds + RING_OFF, g, S, E); }
    SEAM(1);
    if (IN(2)) { const MixArgs a{PROJ, GATES, mconv_w, mconv_b, mnorm, args.out, MIXIN}; p2_mixers_naive(F, a); }
    SEAM(2);
    if (IN(3)) { pg8::Gemm g{MIXIN, WT_OUT, T, D, D}; pg8::StaticOrder S; S.init(T, D, F.G, (int)blockIdx.x);
        pg8::EpiBf16<0> E{MIX, D, nullptr, 0, 0, 1.f};
        pg8::gemm_phase<pg8::EpiBf16<0>, pg8::StaticOrder, true, true>(F.lds + RING_OFF, g, S, E); }
    SEAM(3);
    if (IN(4)) p3b_rows(F, x, MIX, g_postmix, g_preffn, args.out, H);
    SEAM(4);
    if (IN(5)) { pg8::Gemm g{H, WT_UP, T, NUP, D}; pg8::StaticOrder S; S.init(T, NUP, F.G, (int)blockIdx.x);
        pg8::EpiGateUp E{ACT, fconv_w, fconv_b, GFIRST, GLAST, UFIRST};
        pg8::gemm_phase<pg8::EpiGateUp, pg8::StaticOrder, true, true>(F.lds + RING_OFF, g, S, E); }
    SEAM(5);
    if (IN(6)) p4b_fixup(F, fconv_w, fconv_b, GFIRST, GLAST, UFIRST, ACT);
    SEAM(6);
    if (IN(7)) { pg8::Gemm g{ACT, WT_DN, T, D, DFF}; pg8::StaticOrder S; S.init(T, D, F.G, (int)blockIdx.x);
        pg8::EpiBf16<0> E{Y, D, nullptr, 0, 0, 1.f};
        pg8::gemm_phase<pg8::EpiBf16<0>, pg8::StaticOrder, true, true>(F.lds + RING_OFF, g, S, E); }
    SEAM(7);
    if (IN(8)) p6_rows(F, Y, g_postffn, args.out);
#undef IN
#undef SEAM
}
}

#ifndef MK_N_LAUNCHES
#define MK_N_LAUNCHES 1
#endif
extern "C" void kernel_launch(void* const* d_in, const int* in_sizes, int n_in, void* d_out, int out_size, void* d_ws, size_t ws_size, hipStream_t stream) {
    using namespace mk;
    static int grid = 0;
    if (grid == 0) {
        if (n_in != 16 || in_sizes[0] != T * D || out_size != T * D || ws_size < WS_END) { fprintf(stderr, "kernel_launch: unexpected shapes / workspace (n_in %d, ws %zu); nothing launched\n", n_in, ws_size); grid = -1; return; }
        int dev = 0, cus = 0, per_cu = 0;
        if (hipGetDevice(&dev) != hipSuccess || hipDeviceGetAttribute(&cus, hipDeviceAttributeMultiprocessorCount, dev) != hipSuccess) { grid = -1; return; }
        if (hipFuncSetAttribute((const void*)mega_fwd, hipFuncAttributeMaxDynamicSharedMemorySize, LDS_BYTES) != hipSuccess) { fprintf(stderr, "kernel_launch: hipFuncSetAttribute failed\n"); grid = -1; return; }
        if (hipOccupancyMaxActiveBlocksPerMultiprocessor(&per_cu, (const void*)mega_fwd, NWAVES * 64, LDS_BYTES) != hipSuccess || per_cu < 1) { fprintf(stderr, "kernel_launch: occupancy query says %d blocks per CU\n", per_cu); (void)hipGetLastError(); grid = -1; return; }
        grid = cus;
    }
    if (grid < 0) return;
    if (hipMemsetAsync((char*)d_ws + WS_CTL, 0, CTL_ZERO_BYTES, stream) != hipSuccess) return;
    Args a{};
    for (int i = 0; i < 16; ++i) a.in[i] = (const float*)d_in[i];
    a.out = (float*)d_out; a.ws = (unsigned char*)d_ws;
#if MK_N_LAUNCHES == 1
    a.ph_lo = 0; a.ph_hi = N_PHASES;
    hipLaunchKernelGGL(mega_fwd, dim3(grid), dim3(NWAVES * 64), LDS_BYTES, stream, a);
#else
    for (int p = 0; p < N_PHASES; ++p) { a.ph_lo = p; a.ph_hi = p + 1; hipLaunchKernelGGL(mega_fwd, dim3(grid), dim3(NWAVES * 64), LDS_BYTES, stream, a); }
#endif
}
```

```cpp
#include <hip/hip_runtime.h>
#include <cstdio>
#include <cstdint>
namespace pg8 {
#define PG8_LAS __attribute__((address_space(3)))
typedef unsigned short bf16_t;
typedef short bf16x8 __attribute__((ext_vector_type(8)));
typedef float f32x4 __attribute__((ext_vector_type(4)));
typedef unsigned u32x4 __attribute__((ext_vector_type(4)));
constexpr int BM = 256, BK = 64, HALF = 128, HTB = HALF * BK * 2  , STAGE_BYTES = 8 * HTB, NXCD = 8, WGM = 8;

__host__ __device__ __forceinline__ int lds_byte(int r, int c) { const int st = (r >> 4) * 2 + (c >> 5), rr = r & 15, cc = c & 31, ob = rr * 64 + cc * 2; return st * 1024 + (ob ^ (((ob >> 9) & 1) << 5)); }
__host__ __device__ __forceinline__ void stage_rc(int b, int& R, int& C) { const int st = b / 1024, sb = b % 1024, swz = sb ^ (((sb >> 9) & 1) << 5); R = (st >> 1) * 16 + swz / 64; C = (st & 1) * 32 + (swz % 64) / 2; }
__host__ __device__ __forceinline__ int perm32(int rho) { const int n = rho >> 4, i = rho & 15; return 8 * (i >> 2) + 4 * n + (i & 3); }

struct Unit { int pm, pn; };
struct Gemm { const bf16_t* A; const bf16_t* Bt; int M, N, K; };

struct StaticOrder {
    int nM, nN, nwg, G, c;
    __host__ __device__ void init(int M, int N, int G_, int c_) { nM = M / BM; nN = N / BM; nwg = nM * nN; G = G_; c = c_; }
    __host__ __device__ bool next(int i, Unit& u) const {
        const long L = (long)i * G + c; if (L >= nwg) return false;
        int wgid = (int)L; { const int q = nwg / NXCD, r = nwg % NXCD, xcd = wgid % NXCD, off = wgid / NXCD; wgid = (xcd < r ? xcd * (q + 1) : r * (q + 1) + (xcd - r) * q) + off; }
        const int nig = WGM * nN, gid = wgid / nig, fm = gid * WGM, gsz = (nM - fm) < WGM ? (nM - fm) : WGM;
        u.pm = fm + ((wgid % nig) % gsz); u.pn = (wgid % nig) / gsz; return true;
    }
    __device__ __forceinline__ void a_ready(const Unit&) const {}
    __device__ __forceinline__ void done(const Unit&) const {}
};

__device__ __forceinline__ unsigned cvt_pk_bf16(float lo, float hi) { unsigned r; asm volatile("v_cvt_pk_bf16_f32 %0, %1, %2" : "=v"(r) : "v"(lo), "v"(hi)); return r; }
typedef float f32x2 __attribute__((ext_vector_type(2)));
__device__ __forceinline__ f32x2 gelu_pk(f32x2 v) {
    const f32x2 av = __builtin_elementwise_abs(v), d = av * 0.2316418882f + 1.0f;
    f32x2 t; t.x = __builtin_amdgcn_rcpf(d.x); t.y = __builtin_amdgcn_rcpf(d.y);
    f32x2 q = t * 0.5307027145f + (-0.7265760135f); q = q * t + 0.7107068705f; q = q * t + (-0.142248368f); q = q * t + 0.127414796f; q = q * t;
    const f32x2 s = (v * v) * (-0.72134752044f);
    f32x2 e; e.x = __builtin_amdgcn_exp2f(s.x); e.y = __builtin_amdgcn_exp2f(s.y);
    const f32x2 m = v * (q * e), r = v - m;
    f32x2 o; o.x = v.x < 0.f ? m.x : r.x; o.y = v.y < 0.f ? m.y : r.y; return o;
}

template <int ACT  > struct EpiBf16 {
    static constexpr bool PERM = true, AFTER_DRAIN = false; static_assert(ACT == 0 || ACT == 1, "EpiBf16: ACT is 0 (none) or 1 (gelu_pk)");
    bf16_t* O; int ldc; const float* bias; int split_cols; size_t split_stride; float scale0;
    __device__ __forceinline__ void operator()(const f32x4 (&acc)[2][2][4][2], const Unit& u, int wr, int wc, int fr, int fq) const {
        const int row0 = u.pm * BM + wr * 64 + fr; int colt = u.pn * BM; bf16_t* base = O;
        float sc = 1.f; if (split_cols) { const int t = colt / split_cols; base += (size_t)t * split_stride; colt -= t * split_cols; if (t == 0) sc = scale0; }
        const int col0 = colt + wc * 32 + 8 * fq, bcol0 = u.pn * BM + wc * 32 + 8 * fq;
        f32x4 bv[2][2];
#pragma unroll
        for (int bj = 0; bj < 2; ++bj)
#pragma unroll
            for (int n = 0; n < 2; ++n) bv[bj][n] = bias ? *(const f32x4*)(bias + bcol0 + bj * HALF + 4 * n) : (f32x4){0.f, 0.f, 0.f, 0.f};
#pragma unroll
        for (int ai = 0; ai < 2; ++ai)
#pragma unroll
            for (int m = 0; m < 4; ++m) { bf16_t* rowp = base + (size_t)(row0 + ai * HALF + m * 16) * ldc + col0;
#pragma unroll
                for (int bj = 0; bj < 2; ++bj) { f32x4 v0 = acc[ai][bj][m][0] + bv[bj][0], v1 = acc[ai][bj][m][1] + bv[bj][1];
                    if (ACT == 1) { f32x2 a = gelu_pk((f32x2){v0[0], v0[1]}), b = gelu_pk((f32x2){v0[2], v0[3]}), c = gelu_pk((f32x2){v1[0], v1[1]}), d = gelu_pk((f32x2){v1[2], v1[3]});
                        v0 = (f32x4){a.x, a.y, b.x, b.y}; v1 = (f32x4){c.x, c.y, d.x, d.y}; }
                    v0 = v0 * sc; v1 = v1 * sc; u32x4 w; w.x = cvt_pk_bf16(v0[0], v0[1]); w.y = cvt_pk_bf16(v0[2], v0[3]); w.z = cvt_pk_bf16(v1[0], v1[1]); w.w = cvt_pk_bf16(v1[2], v1[3]);
                    *(u32x4*)(rowp + bj * HALF) = w; } }
    }
};

__device__ __forceinline__ float gelu_tanh(float x) {
    const float y = 1.5957691216057308f * (x + 0.044715f * x * x * x);
    return x / (1.0f + __expf(-y));
}
struct EpiGateUp {
    static constexpr bool PERM = true, AFTER_DRAIN = false;
    static constexpr int DFF = 2816;
    bf16_t* ACT; const float* cw; const float* cb; float* GFIRST; float* GLAST; float* UFIRST;
    __device__ __forceinline__ void operator()(const f32x4 (&acc)[2][2][4][2], const Unit& u, int wr, int wc, int fr, int fq) const {
        const int lane = fq * 16 + fr;
        const int colg = u.pn * 128 + wc * 32 + 8 * fq;
        f32x4 w0[2], w1[2], w2[2], bb[2];
#pragma unroll
        for (int n = 0; n < 2; ++n) { w0[n] = *(const f32x4*)(cw + colg + 4 * n); w1[n] = *(const f32x4*)(cw + DFF + colg + 4 * n); w2[n] = *(const f32x4*)(cw + 2 * DFF + colg + 4 * n); bb[n] = *(const f32x4*)(cb + colg + 4 * n); }
        const int src1 = (lane & 48) | ((fr + 15) & 15), src2 = (lane & 48) | ((fr + 14) & 15);
#pragma unroll
        for (int ai = 0; ai < 2; ++ai) {
            f32x4 pp1[2] = {{0.f, 0.f, 0.f, 0.f}, {0.f, 0.f, 0.f, 0.f}}, pp2[2] = {{0.f, 0.f, 0.f, 0.f}, {0.f, 0.f, 0.f, 0.f}};
            const int slab = u.pm * 4 + ai * 2 + wr;
#pragma unroll
            for (int m = 0; m < 4; ++m) {
                f32x4 g[2], uu[2], p1[2], p2[2];
#pragma unroll
                for (int n = 0; n < 2; ++n) { g[n] = acc[ai][0][m][n]; uu[n] = acc[ai][1][m][n];
#pragma unroll
                    for (int j = 0; j < 4; ++j) { p1[n][j] = __shfl(g[n][j], src1); p2[n][j] = __shfl(g[n][j], src2); } }
                const size_t row = (size_t)(u.pm * BM + ai * HALF + wr * 64 + m * 16 + fr);
                u32x4 w;
                unsigned pk[4];
#pragma unroll
                for (int n = 0; n < 2; ++n) {
                    const f32x4 g1 = fr >= 1 ? p1[n] : pp1[n], g2 = fr >= 2 ? p2[n] : pp2[n];
                    const f32x4 cv = w2[n] * g[n] + w1[n] * g1 + w0[n] * g2 + bb[n];
                    float a[4];
#pragma unroll
                    for (int j = 0; j < 4; ++j) a[j] = gelu_tanh(cv[j]) * uu[n][j];
                    pk[2 * n] = cvt_pk_bf16(a[0], a[1]); pk[2 * n + 1] = cvt_pk_bf16(a[2], a[3]);
                }
                w.x = pk[0]; w.y = pk[1]; w.z = pk[2]; w.w = pk[3];
                if (m == 0 && fr < 2) {
                    float* gf = GFIRST + (size_t)(slab * 2 + fr) * DFF + colg; float* uf = UFIRST + (size_t)(slab * 2 + fr) * DFF + colg;
                    *(f32x4*)gf = g[0]; *(f32x4*)(gf + 4) = g[1]; *(f32x4*)uf = uu[0]; *(f32x4*)(uf + 4) = uu[1];
                } else {
                    *(u32x4*)(ACT + row * DFF + colg) = w;
                }
                if (m == 3 && fr >= 14) { float* gl = GLAST + (size_t)(slab * 2 + (fr - 14)) * DFF + colg; *(f32x4*)gl = g[0]; *(f32x4*)(gl + 4) = g[1]; }
#pragma unroll
                for (int n = 0; n < 2; ++n) { pp1[n] = p1[n]; pp2[n] = p2[n]; }
            }
        }
    }
};

struct EpiProj {
    static constexpr bool PERM = true, AFTER_DRAIN = false;
    static constexpr int LDC = 3584;
    bf16_t* O;
    __device__ __forceinline__ void operator()(const f32x4 (&acc)[2][2][4][2], const Unit& u, int wr, int wc, int fr, int fq) const {
        const int row0 = u.pm * BM + wr * 64 + fr, col0 = u.pn * BM + wc * 32 + 8 * fq;
        const float sc = (u.pn == 8 || u.pn == 9) ? 0.18033688011112042f : 1.0f;
#pragma unroll
        for (int ai = 0; ai < 2; ++ai)
#pragma unroll
            for (int m = 0; m < 4; ++m) { bf16_t* rowp = O + (size_t)(row0 + ai * HALF + m * 16) * LDC + col0;
#pragma unroll
                for (int bj = 0; bj < 2; ++bj) { const f32x4 v0 = acc[ai][bj][m][0] * sc, v1 = acc[ai][bj][m][1] * sc;
                    u32x4 w; w.x = cvt_pk_bf16(v0[0], v0[1]); w.y = cvt_pk_bf16(v0[2], v0[3]); w.z = cvt_pk_bf16(v1[0], v1[1]); w.w = cvt_pk_bf16(v1[2], v1[3]);
                    *(u32x4*)(rowp + bj * HALF) = w; } }
    }
};
template <class Epi, class Sched, bool ALIGN_EPI = false, bool SP2 = false>
__device__ __forceinline__ void gemm_phase(PG8_LAS unsigned char* lds, const Gemm g, const Sched& S, const Epi& E) {
    const int tid = threadIdx.x, wid = __builtin_amdgcn_readfirstlane(tid >> 6), lane = tid & 63, wr = wid >> 2, wc = wid & 3, fr = lane & 15, fq = lane >> 4;
    const int K = g.K, nt = K / BK;
    unsigned voffA[2], voffB[2];
#pragma unroll
    for (int i = 0; i < 2; ++i) { int R, C; stage_rc(tid * 16 + i * 8192, R, C); const int Rb = Epi::PERM ? ((R & ~31) + perm32(R & 31)) : R;
        voffA[i] = (unsigned)(R * K + C) * 2u; voffB[i] = (unsigned)(Rb * K + C) * 2u; }
    const size_t kstep = (size_t)(BK * 2);
    const size_t hstep = (size_t)HALF * K * 2;
    const size_t tstep = 2 * hstep;
    const unsigned ldsw = (unsigned)wid * 1024u;
    const int aoff = lds_byte(wr * 64 + fr, fq * 8), boff = lds_byte(wc * 32 + fr, fq * 8);
#define PG8_SA(b, h) (((b) * 2 + (h)) * HTB)
#define PG8_SB(b, h) ((4 + (b) * 2 + (h)) * HTB)
#define PG8_STAGE(bufoff, gbase, voff) do { _Pragma("unroll") for (int _i = 0; _i < 2; ++_i) \
        __builtin_amdgcn_global_load_lds((const unsigned*)((const char*)(gbase) + (voff)[_i]), (PG8_LAS unsigned*)(lds + (bufoff) + ldsw + _i * 8192), 16, 0, 0); } while (0)
#define PG8_LDA(dst, b, h) do { _Pragma("unroll") for (int m = 0; m < 4; ++m) _Pragma("unroll") for (int k = 0; k < 2; ++k) dst[m][k] = *(const PG8_LAS bf16x8*)(lds + PG8_SA(b, h) + aoff + m * 2048 + k * 1024); } while (0)
#define PG8_LDB(dst, b, h) do { _Pragma("unroll") for (int n = 0; n < 2; ++n) _Pragma("unroll") for (int k = 0; k < 2; ++k) dst[n][k] = *(const PG8_LAS bf16x8*)(lds + PG8_SB(b, h) + boff + n * 2048 + k * 1024); } while (0)
#define PG8_MMA(ai, bj, At, Bt) do { __builtin_amdgcn_s_setprio(1); _Pragma("unroll") for (int m = 0; m < 4; ++m) _Pragma("unroll") for (int n = 0; n < 2; ++n) _Pragma("unroll") for (int k = 0; k < 2; ++k) \
        acc[ai][bj][m][n] = __builtin_amdgcn_mfma_f32_16x16x32_bf16(Bt[n][k], At[m][k], acc[ai][bj][m][n], 0, 0, 0); __builtin_amdgcn_s_setprio(0); } while (0)
#define PG8_WAIT_V(n) asm volatile("s_waitcnt vmcnt(" #n ")" ::: "memory")
#define PG8_WAIT_L(n) asm volatile("s_waitcnt lgkmcnt(" #n ")" ::: "memory")
#define PG8_BAR __builtin_amdgcn_s_barrier()
#define PG8_SCHED __builtin_amdgcn_sched_barrier(0)
    Unit cur, nxt; int ui = 0;
    if (!S.next(0, cur)) return;
    f32x4 acc[2][2][4][2];
#pragma unroll
    for (int a = 0; a < 2; ++a)
#pragma unroll
        for (int b = 0; b < 2; ++b)
#pragma unroll
            for (int m = 0; m < 4; ++m)
#pragma unroll
                for (int n = 0; n < 2; ++n) acc[a][b][m][n] = (f32x4){0.f, 0.f, 0.f, 0.f};
    bf16x8 At[4][2], B0[2][2], B1[2][2];
    const char* cA = (const char*)g.A + (size_t)cur.pm * tstep; const char* cB = (const char*)g.Bt + (size_t)cur.pn * tstep;
    S.a_ready(cur);
    if constexpr (SP2) {
        PG8_STAGE(PG8_SB(0, 0), cB, voffB); PG8_STAGE(PG8_SB(0, 1), cB + hstep, voffB); PG8_STAGE(PG8_SA(0, 0), cA, voffA); PG8_STAGE(PG8_SA(0, 1), cA + hstep, voffA);
        if (wr == 1) PG8_BAR;
        PG8_WAIT_V(2); PG8_BAR;
        PG8_STAGE(PG8_SB(1, 0), cB + kstep, voffB); PG8_STAGE(PG8_SA(1, 0), cA + kstep, voffA); PG8_STAGE(PG8_SB(1, 1), cB + hstep + kstep, voffB);
        PG8_WAIT_V(6); PG8_BAR;
    } else {
        PG8_STAGE(PG8_SB(0, 0), cB, voffB); PG8_STAGE(PG8_SA(0, 0), cA, voffA); PG8_STAGE(PG8_SB(0, 1), cB + hstep, voffB); PG8_STAGE(PG8_SA(0, 1), cA + hstep, voffA);
        if (wr == 1) PG8_BAR;
        PG8_WAIT_V(4); PG8_BAR;
        PG8_STAGE(PG8_SB(1, 0), cB + kstep, voffB); PG8_STAGE(PG8_SA(1, 0), cA + kstep, voffA); PG8_STAGE(PG8_SB(1, 1), cB + hstep + kstep, voffB);
        PG8_WAIT_V(6); PG8_BAR;
    }
    for (;;) {
        const bool has_next = S.next(ui + 1, nxt);
        const char* nA = has_next ? (const char*)g.A + (size_t)nxt.pm * tstep : cA; const char* nB = has_next ? (const char*)g.Bt + (size_t)nxt.pn * tstep : cB;
        for (int t = 0; t < nt; t += 2) {
            const bool last = (t == nt - 2);
            const char* a1 = cA + (size_t)(t + 1) * kstep;
            const char* a2 = last ? nA : cA + (size_t)(t + 2) * kstep; const char* b2 = last ? nB : cB + (size_t)(t + 2) * kstep;
            const char* a3 = a2 + kstep; const char* b3 = b2 + kstep;
            if (last && has_next) S.a_ready(nxt);
            if constexpr (SP2) {
            PG8_LDB(B0, 0, 0); PG8_LDB(B1, 0, 1); PG8_SCHED; PG8_LDA(At, 0, 0); PG8_STAGE(PG8_SA(1, 1), a1 + hstep, voffA);
            PG8_WAIT_V(8); PG8_WAIT_L(0); PG8_BAR; PG8_MMA(0, 0, At, B0); PG8_MMA(0, 1, At, B1); PG8_BAR; PG8_SCHED;
            PG8_LDA(At, 0, 1); PG8_STAGE(PG8_SB(0, 0), b2, voffB); PG8_STAGE(PG8_SB(0, 1), b2 + hstep, voffB); PG8_STAGE(PG8_SA(0, 0), a2, voffA);
            PG8_WAIT_V(8); PG8_WAIT_L(0); PG8_BAR; PG8_MMA(1, 0, At, B0); PG8_MMA(1, 1, At, B1); PG8_BAR; PG8_SCHED;
            PG8_LDB(B0, 1, 0); PG8_LDB(B1, 1, 1); PG8_SCHED; PG8_LDA(At, 1, 0); PG8_STAGE(PG8_SA(0, 1), a2 + hstep, voffA);
            PG8_WAIT_V(8); PG8_WAIT_L(0); PG8_BAR; PG8_MMA(0, 0, At, B0); PG8_MMA(0, 1, At, B1); PG8_BAR; PG8_SCHED;
            PG8_LDA(At, 1, 1); PG8_STAGE(PG8_SB(1, 0), b3, voffB); PG8_STAGE(PG8_SB(1, 1), b3 + hstep, voffB); PG8_STAGE(PG8_SA(1, 0), a3, voffA);
            PG8_WAIT_V(8); PG8_WAIT_L(0); PG8_BAR; PG8_MMA(1, 0, At, B0); PG8_MMA(1, 1, At, B1); PG8_BAR; PG8_SCHED;
            } else {
            PG8_LDB(B0, 0, 0); PG8_SCHED; PG8_LDA(At, 0, 0); PG8_STAGE(PG8_SA(1, 1), a1 + hstep, voffA);
            PG8_WAIT_L(8); PG8_BAR; PG8_WAIT_L(0); PG8_MMA(0, 0, At, B0); PG8_BAR; PG8_SCHED;
            PG8_LDB(B1, 0, 1); PG8_STAGE(PG8_SB(0, 0), b2, voffB);
            PG8_BAR; PG8_WAIT_L(0); PG8_MMA(0, 1, At, B1); PG8_BAR;
            PG8_LDA(At, 0, 1); PG8_STAGE(PG8_SA(0, 0), a2, voffA);
            PG8_BAR; PG8_WAIT_L(0); PG8_MMA(1, 0, At, B0); PG8_BAR; PG8_SCHED;
            PG8_STAGE(PG8_SB(0, 1), b2 + hstep, voffB);
            PG8_WAIT_V(6); PG8_BAR; PG8_MMA(1, 1, At, B1); PG8_BAR;
            PG8_LDB(B0, 1, 0); PG8_SCHED; PG8_LDA(At, 1, 0); PG8_STAGE(PG8_SA(0, 1), a2 + hstep, voffA);
            PG8_WAIT_L(8); PG8_BAR; PG8_WAIT_L(0); PG8_MMA(0, 0, At, B0); PG8_BAR; PG8_SCHED;
            PG8_LDB(B1, 1, 1); PG8_STAGE(PG8_SB(1, 0), b3, voffB);
            PG8_BAR; PG8_WAIT_L(0); PG8_MMA(0, 1, At, B1); PG8_BAR;
            PG8_LDA(At, 1, 1); PG8_STAGE(PG8_SA(1, 0), a3, voffA);
            PG8_BAR; PG8_WAIT_L(0); PG8_MMA(1, 0, At, B0); PG8_BAR; PG8_SCHED;
            PG8_STAGE(PG8_SB(1, 1), b3 + hstep, voffB);
            PG8_WAIT_V(6); PG8_BAR; PG8_MMA(1, 1, At, B1); PG8_BAR;
            }
        }
        if constexpr (ALIGN_EPI) { if (wr == 0) PG8_BAR; }
        if constexpr (!Epi::AFTER_DRAIN) { E(acc, cur, wr, wc, fr, fq); S.done(cur); }
        if (!has_next) break;
#pragma unroll
        for (int a = 0; a < 2; ++a)
#pragma unroll
            for (int b = 0; b < 2; ++b)
#pragma unroll
                for (int m = 0; m < 4; ++m)
#pragma unroll
                    for (int n = 0; n < 2; ++n) acc[a][b][m][n] = (f32x4){0.f, 0.f, 0.f, 0.f};
        cur = nxt; cA = nA; cB = nB; ++ui;
        if constexpr (ALIGN_EPI) { if (wr == 1) PG8_BAR; }
    }
    PG8_WAIT_V(0);
    if constexpr (!ALIGN_EPI) { if (wr == 0) PG8_BAR; }
    PG8_BAR;
    if constexpr (Epi::AFTER_DRAIN) { E.fused(acc, cur, wr, wc, fr, fq, lds, wid, lane); S.done(cur); }
#undef PG8_SA
#undef PG8_SB
#undef PG8_STAGE
#undef PG8_LDA
#undef PG8_LDB
#undef PG8_MMA
#undef PG8_WAIT_V
#undef PG8_WAIT_L
#undef PG8_BAR
#undef PG8_SCHED
}
}
#define GAS __attribute__((address_space(1)))
#define LAS __attribute__((address_space(3)))
typedef unsigned short bf16;
typedef unsigned v4u __attribute__((ext_vector_type(4)));
typedef float f32x4 __attribute__((ext_vector_type(4)));
typedef short bf16x8 __attribute__((ext_vector_type(8)));
typedef GAS unsigned gu32;
typedef GAS unsigned long long gu64;
#define RLX_AGENT __ATOMIC_RELAXED, __HIP_MEMORY_SCOPE_AGENT
#define LDS_WAIT() asm volatile("s_waitcnt lgkmcnt(0)" ::: "memory")
#define VM_WAIT() asm volatile("s_waitcnt vmcnt(0)" ::: "memory")
__device__ __forceinline__ unsigned long long rt() { return __builtin_amdgcn_s_memrealtime(); }
__device__ __forceinline__ unsigned f2bf(float f) { unsigned u = __builtin_bit_cast(unsigned, f); return (u + 0x7fffu + ((u >> 16) & 1u)) >> 16; }
__device__ __forceinline__ unsigned pk2(float lo, float hi) { return f2bf(lo) | (f2bf(hi) << 16); }

#define XB_TMO      128
#define XB_XCNT(j)  (256  + 64 * (j))
#define XB_XSUB(j)  (1280 + 64 * (j))
#define XB_XGEN(j)  (2304 + 64 * (j))
#define XB_TOP      3328
#define XB_TOPGEN   3392
#define XCD_BAR_WORDS 3456
#define XB_SPIN_CAP (1u << 18)

__device__ __forceinline__ unsigned xb_ld(unsigned* p)              { return __hip_atomic_load(p, __ATOMIC_RELAXED, __HIP_MEMORY_SCOPE_AGENT); }
__device__ __forceinline__ unsigned xb_add(unsigned* p, unsigned v) { return __hip_atomic_fetch_add(p, v, __ATOMIC_RELAXED, __HIP_MEMORY_SCOPE_AGENT); }
__device__ __forceinline__ unsigned xb_xcc_id() { return (unsigned)__builtin_amdgcn_s_getreg((3 << 11) | 20) & 0xFu; }
#define XB_SPIN(cond, bar) do { unsigned _sp = 0; while (cond) { __builtin_amdgcn_s_sleep(1); \
    if ((++_sp & 255u) == 0u) { if (xb_ld(&(bar)[XB_TMO])) break; if (_sp > XB_SPIN_CAP) { atomicAdd(&(bar)[XB_TMO], 1u); break; } } } } while (0)

struct XcdBarrier {
    unsigned* bar; unsigned x;
    volatile LAS unsigned* st;
};

__device__ __forceinline__ XcdBarrier xcd_barrier_post(unsigned* bar, volatile LAS unsigned* st) {
    XcdBarrier b; b.bar = bar; b.x = xb_xcc_id(); b.st = st;
    if (threadIdx.x == 0) (void)xb_add(&bar[XB_XCNT(b.x)], 1u);
    return b;
}
__device__ __forceinline__ void xcd_barrier_complete(unsigned* bar, unsigned x, unsigned& nloc, unsigned& nx) {
    const unsigned G = gridDim.x * gridDim.y * gridDim.z;
    unsigned sum, cnt, mine, sp = 0u;
    for (;;) {
        sum = 0u; cnt = 0u; mine = 0u;
#pragma unroll
        for (unsigned j = 0; j < 16; ++j) { const unsigned c = xb_ld(&bar[XB_XCNT(j)]); sum += c; cnt += (c > 0u) ? 1u : 0u; mine = (j == x) ? c : mine; }
        if (sum == G) break;
        __builtin_amdgcn_s_sleep(1);
        if ((++sp & 255u) == 0u) { if (xb_ld(&bar[XB_TMO])) break; if (sp > XB_SPIN_CAP) { atomicAdd(&bar[XB_TMO], 1u); break; } }
    }
    nloc = mine > 0u ? mine : 1u; nx = cnt > 0u ? cnt : 1u;
}

__device__ __forceinline__ void xcd_barrier(const XcdBarrier& b) {
    asm volatile("s_waitcnt vmcnt(0)" ::: "memory");
    __syncthreads();
    if (threadIdx.x == 0) {
        unsigned* bar = b.bar;
        __builtin_amdgcn_s_waitcnt(0);
        unsigned nloc = b.st[0], nx = b.st[1];
        if (nloc == 0u) { xcd_barrier_complete(bar, b.x, nloc, nx); b.st[0] = nloc; b.st[1] = nx; }
        const unsigned old = xb_add(&bar[XB_XSUB(b.x)], 1u);
        const unsigned gen = old / nloc;
        if (old + 1u == (gen + 1u) * nloc) {
            __builtin_amdgcn_fence(__ATOMIC_RELEASE, "agent");
            asm volatile("s_waitcnt vmcnt(0)" ::: "memory");
            const unsigned og = xb_add(&bar[XB_TOP], 1u);
            const unsigned tg = og / nx;
            if (og + 1u == (tg + 1u) * nx) xb_add(&bar[XB_TOPGEN], 1u);
            else XB_SPIN(xb_ld(&bar[XB_TOPGEN]) == tg, bar);
            __builtin_amdgcn_fence(__ATOMIC_ACQUIRE, "agent");
            xb_add(&bar[XB_XGEN(b.x)], 1u);
            asm volatile("s_waitcnt vmcnt(0)" ::: "memory");
        } else {
            XB_SPIN(xb_ld(&bar[XB_XGEN(b.x)]) == gen, bar);
            __builtin_amdgcn_fence(__ATOMIC_ACQUIRE, "agent");
            asm volatile("s_waitcnt vmcnt(0)" ::: "memory");
        }
    }
    __syncthreads();
}
namespace mk {
constexpr int NWAVES = 8;
constexpr int BATCH = 16, SEQ = 2048, D = 1024, T = BATCH * SEQ;
constexpr int IN_COLS = 3592, NIN = 3584, DFF = 2816, NUP = 2 * DFF;
constexpr int C_QM = 0, C_KM = 512, C_VM = 1024, C_OM = 1536, C_QS = 2048, C_KS = 2560, C_VS = 3072;
constexpr float EPS = 1e-6f;
constexpr size_t MiB = 1u << 20;
constexpr size_t WS_CTL = 0, CTL_ZERO_BYTES = 1 * MiB;
constexpr size_t WS_WIN = 2 * MiB, WS_WOUT = 9 * MiB, WS_WUP = 11 * MiB, WS_WDN = 22 * MiB, WS_GATES = 28 * MiB;
constexpr size_t WS_H = 32 * MiB, WS_PROJ = 96 * MiB, WS_MIXIN = 320 * MiB, WS_MIX = 384 * MiB, WS_END = 448 * MiB;
constexpr size_t WS_ACT = 96 * MiB, WS_GFIRST = 272 * MiB, WS_GLAST = 283 * MiB, WS_UFIRST = 294 * MiB;
constexpr size_t WS_Y = 320 * MiB;
static_assert(WS_ACT + (size_t)T * DFF * 2 <= WS_GFIRST && WS_UFIRST + 11 * MiB <= WS_MIXIN, "ws map");
constexpr int CW_TMO = 0, CW_BAR = 4096;
constexpr int RING_OFF = 0, RING_BYTES = 131072, LDSCTL_OFF = RING_BYTES, MISC_OFF = LDSCTL_OFF + 320, LDS_BYTES = 147456;

struct Frame {
    LAS unsigned char* lds;
    volatile LAS unsigned* MISC;
    gu32* ctl;
    int tid, lane, wave, vcu, G;
};
__device__ __forceinline__ float wave_sum(float v) {
#pragma unroll
    for (int o = 1; o < 64; o <<= 1) v += __shfl_xor(v, o);
    return v;
}
__device__ __forceinline__ float bf2f(bf16 b) { return __uint_as_float((unsigned)b << 16); }
__device__ __forceinline__ float logsig(float x) { return fminf(x, 0.f) - __logf(1.f + __expf(-fabsf(x))); }
__device__ __forceinline__ float sigmoidf_(float x) { return 1.f / (1.f + __expf(-x)); }

__device__ __forceinline__ void transpose_item(const float* W, int ldw, int srccol0, bf16* WT, int K, int destrow0, int k0, LAS float* scr, int lane) {
#pragma unroll 8
    for (int i = 0; i < 32; ++i) { const int kk = 2 * i + (lane >> 5); scr[kk * 33 + (lane & 31)] = W[(size_t)(k0 + kk) * ldw + srccol0 + (lane & 31)]; }
    LDS_WAIT(); asm volatile("" ::: "memory");
    const int c = lane & 7;
#pragma unroll
    for (int j = 0; j < 4; ++j) { const int n = (lane >> 3) + 8 * j; const LAS float* s = scr + (8 * c) * 33 + n;
        v4u o; o.x = pk2(s[0 * 33], s[1 * 33]); o.y = pk2(s[2 * 33], s[3 * 33]); o.z = pk2(s[4 * 33], s[5 * 33]); o.w = pk2(s[6 * 33], s[7 * 33]);
        *(GAS v4u*)(WT + (size_t)(destrow0 + n) * K + k0 + 8 * c) = o; }
    LDS_WAIT(); asm volatile("" ::: "memory");
}
struct P0Args { const float *x, *g_pre, *w_in, *b_i, *b_f, *w_out, *w_up, *w_down; bf16 *WT_IN, *WT_OUT, *WT_UP, *WT_DN, *H; float* GATES; };
__device__ __forceinline__ void p0_prologue(Frame& F, const P0Args& a) {
    LAS float* scr = (LAS float*)(F.lds + RING_OFF + F.wave * 16384);
    const int gw = F.vcu * NWAVES + F.wave, NGW = F.G * NWAVES;
    constexpr int I_IN = 16 * (NIN / 32), I_OUT = 16 * 32, I_UP = 16 * (NUP / 32), I_DN = (DFF / 64) * 32;
    constexpr int NITEMS = I_IN + I_OUT + I_UP + I_DN;
    for (int it = gw; it < NITEMS; it += NGW) {
        int r = it;
        if (r < I_IN) { const int nblk = NIN / 32, kb = r / nblk, nb = r % nblk, n0 = 32 * nb; const int src = n0 < 2048 ? n0 : n0 + 8;
            transpose_item(a.w_in, IN_COLS, src, a.WT_IN, D, n0, 64 * kb, scr, F.lane); continue; }
        r -= I_IN;
        if (r < I_OUT) { const int kb = r / 32, nb = r % 32; transpose_item(a.w_out, D, 32 * nb, a.WT_OUT, D, 32 * nb, 64 * kb, scr, F.lane); continue; }
        r -= I_OUT;
        if (r < I_UP) { const int nblk = NUP / 32, kb = r / nblk, nb = r % nblk, n0 = 32 * nb, tj = n0 >> 8, w = n0 & 255; const int src = w < 128 ? 128 * tj + w : DFF + 128 * tj + (w - 128);
            transpose_item(a.w_up, NUP, src, a.WT_UP, D, n0, 64 * kb, scr, F.lane); continue; }
        r -= I_UP;
        { const int kb = r / 32, nb = r % 32; transpose_item(a.w_down, D, 32 * nb, a.WT_DN, DFF, 32 * nb, 64 * kb, scr, F.lane); }
    }
    __syncthreads();
    LAS float* WG = (LAS float*)(F.lds + RING_OFF);
    for (int i = F.tid; i < 8 * D; i += NWAVES * 64) { const int k = i >> 3, g = i & 7; WG[g * D + k] = a.w_in[(size_t)k * IN_COLS + 2048 + g]; }
    __syncthreads();
    f32x4 gain[4];
#pragma unroll
    for (int j = 0; j < 4; ++j) gain[j] = ((const GAS f32x4*)a.g_pre)[64 * j + F.lane];
    for (int m = gw; m < T; m += NGW) {
        const GAS f32x4* xr = (const GAS f32x4*)(a.x + (size_t)m * D) + F.lane;
        f32x4 v[4]; float s = 0.f;
#pragma unroll
        for (int j = 0; j < 4; ++j) { v[j] = xr[64 * j]; s += (v[j].x * v[j].x + v[j].y * v[j].y) + (v[j].z * v[j].z + v[j].w * v[j].w); }
        const float rstd = 1.0f / sqrtf(wave_sum(s) * (1.f / D) + EPS);
#pragma unroll
        for (int j = 0; j < 4; ++j) v[j] = v[j] * rstd * gain[j];
        GAS unsigned long long* o8 = (GAS unsigned long long*)(a.H + (size_t)m * D) + F.lane;
#pragma unroll
        for (int j = 0; j < 4; ++j) o8[64 * j] = (unsigned long long)pk2(v[j].x, v[j].y) | ((unsigned long long)pk2(v[j].z, v[j].w) << 32);
        float dots[8];
#pragma unroll
        for (int g = 0; g < 8; ++g) { float d = 0.f;
#pragma unroll
            for (int j = 0; j < 4; ++j) { const f32x4 w = ((const LAS f32x4*)(WG + g * D))[64 * j + F.lane]; d += (v[j].x * w.x + v[j].y * w.y) + (v[j].z * w.z + v[j].w * w.w); }
            dots[g] = wave_sum(d); }
        if (F.lane == 0) {
#pragma unroll
            for (int h = 0; h < 4; ++h) { a.GATES[(size_t)m * 8 + h] = dots[h] + a.b_i[h]; a.GATES[(size_t)m * 8 + 4 + h] = logsig(dots[4 + h] + a.b_f[h]); }
        }
    }
}

struct MixArgs { const bf16* PROJ; const float* GATES; const float *cw, *cb, *mnorm; float* HRAW; bf16* MIXIN; };
__device__ __forceinline__ void mlstm_naive_unit(Frame& F, const MixArgs& a, int b, int h) {
    LAS float* ql = (LAS float*)(F.lds); LAS float* kl = ql + 64 * 128; LAS float* vl = kl + 64 * 128;
    LAS float* fi = vl + 64 * 128; LAS float* ff = fi + 64; LAS float* red = ff + 64; LAS float* redd = red + 2 * 4 * 128;
    const int tid = F.tid, e = tid & 127, dq = tid >> 7;
    const size_t rowbase = (size_t)b * SEQ;
    float C[32], n[32];
#pragma unroll
    for (int i = 0; i < 32; ++i) { C[i] = 0.f; n[i] = 0.f; }
    for (int chunk = 0; chunk < SEQ / 64; ++chunk) {
        __syncthreads();
        for (int i = 0; i < 16; ++i) {
            const int idx = tid + 512 * i, t = idx >> 7, c = idx & 127, tt = chunk * 64 + t;
            float qa = a.cb[h * 128 + c], ka = a.cb[512 + h * 128 + c];
#pragma unroll
            for (int j = 0; j < 4; ++j) { const int ts = tt - 3 + j;
                if (ts >= 0) { const bf16* pr = a.PROJ + (rowbase + ts) * NIN + h * 128 + c;
                    qa += a.cw[j * 1024 + h * 128 + c] * bf2f(pr[C_QM]); ka += a.cw[j * 1024 + 512 + h * 128 + c] * bf2f(pr[C_KM]); } }
            ql[idx] = qa * sigmoidf_(qa); kl[idx] = ka * sigmoidf_(ka) * 0.08838834764831845f;
            vl[idx] = bf2f(a.PROJ[(rowbase + tt) * NIN + C_VM + h * 128 + c]);
        }
        if (tid < 64) { const size_t r = rowbase + chunk * 64 + tid; fi[tid] = __expf(a.GATES[r * 8 + h]); ff[tid] = __expf(a.GATES[r * 8 + 4 + h]); }
        __syncthreads();
        for (int t = 0; t < 64; ++t) {
            const float fg = ff[t], ig = fi[t], ve = vl[t * 128 + e];
            float acc = 0.f, dacc = 0.f;
#pragma unroll
            for (int dd = 0; dd < 32; ++dd) { const float kd = kl[t * 128 + dq * 32 + dd], qd = ql[t * 128 + dq * 32 + dd];
                C[dd] = fg * C[dd] + (ig * kd) * ve; acc += C[dd] * qd; n[dd] = fg * n[dd] + ig * kd; dacc += n[dd] * qd; }
            LAS float* rb = red + (t & 1) * 512; LAS float* rd = redd + (t & 1) * 4;
            rb[dq * 128 + e] = acc; if (e == 0) rd[dq] = dacc;
            __syncthreads();
            if (tid < 128) { const float num = (rb[e] + rb[128 + e]) + (rb[256 + e] + rb[384 + e]); const float den = (rd[0] + rd[1]) + (rd[2] + rd[3]);
                a.HRAW[(rowbase + chunk * 64 + t) * 512 + h * 128 + e] = num / fmaxf(fabsf(den), 1.0f); }
        }
    }
    VM_WAIT(); __syncthreads(); __builtin_amdgcn_fence(__ATOMIC_ACQUIRE, "agent"); VM_WAIT();
    for (int rr = F.wave; rr < SEQ; rr += NWAVES) {
        const size_t r = rowbase + rr;
        const float h0 = a.HRAW[r * 512 + h * 128 + F.lane], h1 = a.HRAW[r * 512 + h * 128 + 64 + F.lane];
        const float rstd = 1.0f / sqrtf(wave_sum(h0 * h0 + h1 * h1) * (1.f / 128.f) + EPS);
        const float o0 = sigmoidf_(bf2f(a.PROJ[r * NIN + C_OM + h * 128 + F.lane])), o1 = sigmoidf_(bf2f(a.PROJ[r * NIN + C_OM + h * 128 + 64 + F.lane]));
        a.MIXIN[r * D + h * 128 + F.lane] = (bf16)f2bf(o0 * h0 * rstd * a.mnorm[h * 128 + F.lane]);
        a.MIXIN[r * D + h * 128 + 64 + F.lane] = (bf16)f2bf(o1 * h1 * rstd * a.mnorm[h * 128 + 64 + F.lane]);
    }
}
__device__ __forceinline__ void sb_naive_unit(Frame& F, const MixArgs& a, int b, int h, int qblk) {
    LAS float* Kl = (LAS float*)(F.lds); LAS float* Vl = Kl + 64 * 64;
    const int tid = F.tid, t = qblk * 512 + tid;
    const size_t rowbase = (size_t)b * SEQ;
    float q[64], o[64], rem = 0.f;
    { const bf16* qp = a.PROJ + (rowbase + t) * NIN + C_QS + h * 64;
#pragma unroll
      for (int d = 0; d < 64; ++d) { q[d] = bf2f(qp[d]) * 0.6931471805599453f; o[d] = 0.f; } }
    for (int kt = qblk * 8 + 7; kt >= 0; --kt) {
        __syncthreads();
        for (int i = 0; i < 8; ++i) { const int idx = tid + 512 * i, s = idx >> 6, d = idx & 63; const bf16* pr = a.PROJ + (rowbase + kt * 64 + s) * NIN + h * 64 + d;
            Kl[idx] = bf2f(pr[C_KS]); Vl[idx] = bf2f(pr[C_VS]); }
        __syncthreads();
        if (kt * 64 < t) {
            for (int sl = 63; sl >= 0; --sl) {
                if (kt * 64 + sl < t) {
                    float z = 0.f;
#pragma unroll
                    for (int d4 = 0; d4 < 16; ++d4) { const f32x4 kv = ((const LAS f32x4*)(Kl + sl * 64))[d4]; z += (q[4 * d4] * kv.x + q[4 * d4 + 1] * kv.y) + (q[4 * d4 + 2] * kv.z + q[4 * d4 + 3] * kv.w); }
                    const float l = __logf(1.f + __expf(-fabsf(z)));
                    const float ls = fminf(z, 0.f) - l, l1 = fminf(-z, 0.f) - l;
                    const float at = __expf(ls + rem); rem += l1;
#pragma unroll
                    for (int d4 = 0; d4 < 16; ++d4) { const f32x4 vv = ((const LAS f32x4*)(Vl + sl * 64))[d4]; o[4 * d4] += at * vv.x; o[4 * d4 + 1] += at * vv.y; o[4 * d4 + 2] += at * vv.z; o[4 * d4 + 3] += at * vv.w; }
                }
            }
        }
    }
    GAS v4u* op = (GAS v4u*)(a.MIXIN + (rowbase + t) * D + 512 + h * 64);
#pragma unroll
    for (int i = 0; i < 8; ++i) { v4u w; w.x = pk2(o[8 * i], o[8 * i + 1]); w.y = pk2(o[8 * i + 2], o[8 * i + 3]); w.z = pk2(o[8 * i + 4], o[8 * i + 5]); w.w = pk2(o[8 * i + 6], o[8 * i + 7]); op[i] = w; }
}

typedef short v4i16_t __attribute__((ext_vector_type(4)));
typedef float f32x16 __attribute__((ext_vector_type(16)));
__device__ __forceinline__ v4i16_t tr16(const LAS unsigned char* p) { return __builtin_amdgcn_ds_read_tr16_b64_v4i16((LAS v4i16_t*)p); }
__device__ __forceinline__ bf16x8 cat8(v4i16_t a, v4i16_t b) { return (bf16x8){a[0], a[1], a[2], a[3], b[0], b[1], b[2], b[3]}; }
__device__ __forceinline__ unsigned cvtpk(float lo, float hi) { unsigned r; asm volatile("v_cvt_pk_bf16_f32 %0, %1, %2" : "=v"(r) : "v"(lo), "v"(hi)); return r; }
__device__ __forceinline__ bf16x8 pack8(const float* p) { v4u w; w.x = cvtpk(p[0], p[1]); w.y = cvtpk(p[2], p[3]); w.z = cvtpk(p[4], p[5]); w.w = cvtpk(p[6], p[7]); return __builtin_bit_cast(bf16x8, w); }
constexpr int SB_VRS = 192, SB_VBUF = 32 * SB_VRS;
__device__ __forceinline__ void sb_phase(Frame& F, const bf16* PROJ, bf16* MIXIN) {
    LAS unsigned char* vb = F.lds + RING_OFF + F.wave * (2 * SB_VBUF);
    const int lane = F.lane, tl = lane & 31, hh = lane >> 5;
    const int troff = (4 * hh + ((lane & 15) >> 2)) * SB_VRS + (16 * ((lane >> 4) & 1) + 4 * (lane & 3)) * 2;
    for (int bu = F.vcu; bu < 1024; bu += F.G) {
        const int bh = bu & 127, qi = (7 - (bu >> 7)) * 8 + F.wave, b = bh >> 3, h = bh & 7;
        const size_t rowbase = (size_t)b * SEQ;
        const bf16* kvbase = PROJ + rowbase * NIN + h * 64;
        bf16x8 qf[4], kf[4], kn[4]; v4u vr[4], vn[4];
        { const bf16* qp = kvbase + (size_t)(32 * qi + tl) * NIN + C_QS + 8 * hh;
#pragma unroll
          for (int s = 0; s < 4; ++s) qf[s] = *(const GAS bf16x8*)(qp + 16 * s); }
#define SB_LOADK(dst, kb) do { const bf16* kp_ = kvbase + (size_t)(32 * (kb) + tl) * NIN + C_KS + 8 * hh; _Pragma("unroll") for (int s = 0; s < 4; ++s) dst[s] = *(const GAS bf16x8*)(kp_ + 16 * s); } while (0)
#define SB_LOADV(dst, kb) do { _Pragma("unroll") for (int i = 0; i < 4; ++i) { const int idx_ = lane + 64 * i; dst[i] = *(const GAS v4u*)(kvbase + (size_t)(32 * (kb) + (idx_ >> 3)) * NIN + C_VS + 8 * (idx_ & 7)); } } while (0)
#define SB_WRITEV(buf, srcv) do { _Pragma("unroll") for (int i = 0; i < 4; ++i) { const int idx_ = lane + 64 * i; *(LAS v4u*)((buf) + (idx_ >> 3) * SB_VRS + 16 * (idx_ & 7)) = srcv[i]; } } while (0)
        SB_LOADK(kf, qi); SB_LOADV(vr, qi);
        SB_WRITEV(vb, vr);
        f32x16 o0, o1;
#pragma unroll
        for (int r = 0; r < 16; ++r) { o0[r] = 0.f; o1[r] = 0.f; }
        float carry = 1.f; int cur = 0;
        for (int kb = qi; kb >= 0; --kb) {
            if (kb > 0) { SB_LOADK(kn, kb - 1); SB_LOADV(vn, kb - 1); }
            f32x16 S;
#pragma unroll
            for (int r = 0; r < 16; ++r) S[r] = 0.f;
#pragma unroll
            for (int s = 0; s < 4; ++s) S = __builtin_amdgcn_mfma_f32_32x32x16_bf16(kf[s], qf[s], S, 0, 0, 0);
            float om[16], bt[16];
            const bool diag = (kb == qi);
#pragma unroll
            for (int r = 0; r < 16; ++r) {
                const float e = __builtin_amdgcn_exp2f(fminf(S[r], 100.f));
                float m_ = __builtin_amdgcn_rcpf(1.f + e), b_ = e * m_;
                if (diag) { const bool masked = ((r & 3) + 8 * (r >> 2) + 4 * hh) >= tl; m_ = masked ? 1.f : m_; b_ = masked ? 0.f : b_; }
                om[r] = m_; bt[r] = b_;
            }
            float xs[16], G[4], pG[4];
#pragma unroll
            for (int g = 0; g < 4; ++g) { xs[4 * g + 3] = 1.f; xs[4 * g + 2] = om[4 * g + 3]; xs[4 * g + 1] = xs[4 * g + 2] * om[4 * g + 2]; xs[4 * g] = xs[4 * g + 1] * om[4 * g + 1]; G[g] = xs[4 * g] * om[4 * g]; }
#pragma unroll
            for (int g = 0; g < 4; ++g) pG[g] = __shfl_xor(G[g], 32);
            float Sg[4]; Sg[3] = carry; Sg[2] = Sg[3] * (G[3] * pG[3]); Sg[1] = Sg[2] * (G[2] * pG[2]); Sg[0] = Sg[1] * (G[1] * pG[1]); carry = Sg[0] * (G[0] * pG[0]);
            float P[16];
#pragma unroll
            for (int g = 0; g < 4; ++g) { const float off = hh ? Sg[g] : Sg[g] * pG[g];
#pragma unroll
                for (int j = 0; j < 4; ++j) P[4 * g + j] = bt[4 * g + j] * (xs[4 * g + j] * off); }
            const bf16x8 pb0 = pack8(P), pb1 = pack8(P + 8);
            const LAS unsigned char* vbase = vb + cur * SB_VBUF + troff;
            { const bf16x8 a00 = cat8(tr16(vbase), tr16(vbase + 8 * SB_VRS)), a01 = cat8(tr16(vbase + 64), tr16(vbase + 8 * SB_VRS + 64));
              const bf16x8 a10 = cat8(tr16(vbase + 16 * SB_VRS), tr16(vbase + 24 * SB_VRS)), a11 = cat8(tr16(vbase + 16 * SB_VRS + 64), tr16(vbase + 24 * SB_VRS + 64));
              o0 = __builtin_amdgcn_mfma_f32_32x32x16_bf16(a00, pb0, o0, 0, 0, 0); o1 = __builtin_amdgcn_mfma_f32_32x32x16_bf16(a01, pb0, o1, 0, 0, 0);
              o0 = __builtin_amdgcn_mfma_f32_32x32x16_bf16(a10, pb1, o0, 0, 0, 0); o1 = __builtin_amdgcn_mfma_f32_32x32x16_bf16(a11, pb1, o1, 0, 0, 0); }
            if (__all(carry < 7.888609052210118e-31f)) break;
            if (kb > 0) { SB_WRITEV(vb + (cur ^ 1) * SB_VBUF, vn);
#pragma unroll
                for (int s = 0; s < 4; ++s) kf[s] = kn[s];
                cur ^= 1; }
        }
#undef SB_LOADK
#undef SB_LOADV
#undef SB_WRITEV
        bf16* orow = MIXIN + (rowbase + 32 * qi + tl) * D + 512 + h * 64 + 4 * hh;
#pragma unroll
        for (int g = 0; g < 4; ++g) {
            *(GAS unsigned long long*)(orow + 8 * g) = (unsigned long long)cvtpk(o0[4 * g], o0[4 * g + 1]) | ((unsigned long long)cvtpk(o0[4 * g + 2], o0[4 * g + 3]) << 32);
            *(GAS unsigned long long*)(orow + 32 + 8 * g) = (unsigned long long)cvtpk(o1[4 * g], o1[4 * g + 1]) | ((unsigned long long)cvtpk(o1[4 * g + 2], o1[4 * g + 3]) << 32);
        }
    }
}
__device__ __forceinline__ void p2_mixers_naive(Frame& F, const MixArgs& a) {
    const int bx = blockIdx.x;
    if (bx < 64) { mlstm_naive_unit(F, a, bx >> 2, bx & 3); __syncthreads(); }
#if defined(MK_SB_NAIVE)
    else { for (int u = bx - 64; u < 512; u += (F.G - 64)) { const int qblk = 3 - (u >> 7), bh = u & 127; sb_naive_unit(F, a, bh >> 3, bh & 7, qblk); } }
#else
    sb_phase(F, a.PROJ, a.MIXIN);
#endif
}

__device__ __forceinline__ void ld_bf16_row16(const bf16* row, int lane, f32x4 (&v)[4]) {
    const GAS unsigned long long* p = (const GAS unsigned long long*)row + lane;
#pragma unroll
    for (int j = 0; j < 4; ++j) { const unsigned long long w = p[64 * j]; const unsigned lo = (unsigned)w, hi = (unsigned)(w >> 32);
        v[j] = (f32x4){__uint_as_float(lo << 16), __uint_as_float(lo & 0xffff0000u), __uint_as_float(hi << 16), __uint_as_float(hi & 0xffff0000u)}; }
}
__device__ __forceinline__ float sumsq16(const f32x4 (&v)[4]) { float s = 0.f;
#pragma unroll
    for (int j = 0; j < 4; ++j) s += (v[j].x * v[j].x + v[j].y * v[j].y) + (v[j].z * v[j].z + v[j].w * v[j].w);
    return s; }
__device__ __forceinline__ void p3b_rows(Frame& F, const float* x, const bf16* MIX, const float* g1, const float* g2, float* out, bf16* H) {
    const int gw = F.vcu * NWAVES + F.wave, NGW = F.G * NWAVES;
    f32x4 ga[4], gb[4];
#pragma unroll
    for (int j = 0; j < 4; ++j) { ga[j] = ((const GAS f32x4*)g1)[64 * j + F.lane]; gb[j] = ((const GAS f32x4*)g2)[64 * j + F.lane]; }
    for (int m = gw; m < T; m += NGW) {
        f32x4 mv[4], xv[4]; ld_bf16_row16(MIX + (size_t)m * D, F.lane, mv);
        const GAS f32x4* xr = (const GAS f32x4*)(x + (size_t)m * D) + F.lane;
#pragma unroll
        for (int j = 0; j < 4; ++j) xv[j] = xr[64 * j];
        const float r1 = 1.0f / sqrtf(wave_sum(sumsq16(mv)) * (1.f / D) + EPS);
#pragma unroll
        for (int j = 0; j < 4; ++j) xv[j] = xv[j] + mv[j] * r1 * ga[j];
        GAS f32x4* orow = (GAS f32x4*)(out + (size_t)m * D) + F.lane;
#pragma unroll
        for (int j = 0; j < 4; ++j) orow[64 * j] = xv[j];
        const float r2 = 1.0f / sqrtf(wave_sum(sumsq16(xv)) * (1.f / D) + EPS);
        GAS unsigned long long* o8 = (GAS unsigned long long*)(H + (size_t)m * D) + F.lane;
#pragma unroll
        for (int j = 0; j < 4; ++j) { const f32x4 hv = xv[j] * r2 * gb[j]; o8[64 * j] = (unsigned long long)pk2(hv.x, hv.y) | ((unsigned long long)pk2(hv.z, hv.w) << 32); }
    }
}
__device__ __forceinline__ void p6_rows(Frame& F, const bf16* Y, const float* g3, float* out) {
    const int gw = F.vcu * NWAVES + F.wave, NGW = F.G * NWAVES;
    f32x4 ga[4];
#pragma unroll
    for (int j = 0; j < 4; ++j) ga[j] = ((const GAS f32x4*)g3)[64 * j + F.lane];
    for (int m = gw; m < T; m += NGW) {
        f32x4 yv[4]; ld_bf16_row16(Y + (size_t)m * D, F.lane, yv);
        GAS f32x4* orow = (GAS f32x4*)(out + (size_t)m * D) + F.lane;
        f32x4 xv[4];
#pragma unroll
        for (int j = 0; j < 4; ++j) xv[j] = orow[64 * j];
        const float r1 = 1.0f / sqrtf(wave_sum(sumsq16(yv)) * (1.f / D) + EPS);
#pragma unroll
        for (int j = 0; j < 4; ++j) orow[64 * j] = xv[j] + yv[j] * r1 * ga[j];
    }
}
__device__ __forceinline__ void p4b_fixup(Frame& F, const float* cw, const float* cb, const float* GFIRST, const float* GLAST, const float* UFIRST, bf16* ACT) {
    constexpr int C4 = DFF / 4, TOTAL = 512 * 2 * C4;
    for (int it = F.vcu * NWAVES * 64 + F.tid; it < TOTAL; it += F.G * NWAVES * 64) {
        const int c4 = it % C4, rs = it / C4, rr = rs & 1, s = rs >> 1; const bool first = (s & 31) == 0;
        const f32x4 z4 = {0.f, 0.f, 0.f, 0.f};
        const f32x4 g0 = *(const GAS f32x4*)(GFIRST + (size_t)(s * 2 + rr) * DFF + 4 * c4);
        f32x4 gm1, gm2;
        if (rr == 0) { gm1 = first ? z4 : *(const GAS f32x4*)(GLAST + (size_t)((s - 1) * 2 + 1) * DFF + 4 * c4); gm2 = first ? z4 : *(const GAS f32x4*)(GLAST + (size_t)((s - 1) * 2 + 0) * DFF + 4 * c4); }
        else { gm1 = *(const GAS f32x4*)(GFIRST + (size_t)(s * 2 + 0) * DFF + 4 * c4); gm2 = first ? z4 : *(const GAS f32x4*)(GLAST + (size_t)((s - 1) * 2 + 1) * DFF + 4 * c4); }
        const f32x4 w0 = *(const GAS f32x4*)(cw + 4 * c4), w1 = *(const GAS f32x4*)(cw + DFF + 4 * c4), w2 = *(const GAS f32x4*)(cw + 2 * DFF + 4 * c4), bb = *(const GAS f32x4*)(cb + 4 * c4);
        const f32x4 uu = *(const GAS f32x4*)(UFIRST + (size_t)(s * 2 + rr) * DFF + 4 * c4);
        const f32x4 cv = w2 * g0 + w1 * gm1 + w0 * gm2 + bb;
        const float a0 = pg8::gelu_tanh(cv.x) * uu.x, a1 = pg8::gelu_tanh(cv.y) * uu.y, a2 = pg8::gelu_tanh(cv.z) * uu.z, a3 = pg8::gelu_tanh(cv.w) * uu.w;
        *(GAS unsigned long long*)(ACT + (size_t)(64 * s + rr) * DFF + 4 * c4) = (unsigned long long)pk2(a0, a1) | ((unsigned long long)pk2(a2, a3) << 32);
    }
}

struct Args { const float* in[16]; float* out; unsigned char* ws; int ph_lo, ph_hi; };
constexpr int N_PHASES = 9;
__global__ void __launch_bounds__(NWAVES * 64, 2) mega_fwd(Args args) {
    extern __shared__ __attribute__((aligned(16))) unsigned char lds[];
    Frame F;
    F.lds = (LAS unsigned char*)lds;
    F.MISC = (volatile LAS unsigned*)(F.lds + MISC_OFF);
    F.tid = threadIdx.x; F.lane = F.tid & 63; F.wave = __builtin_amdgcn_readfirstlane(F.tid >> 6);
    F.G = gridDim.x; { const int bx = blockIdx.x; F.vcu = (F.G % 8 == 0) ? (bx % 8) * (F.G / 8) + bx / 8 : bx; }
    unsigned char* ws = args.ws;
    F.ctl = (gu32*)(ws + WS_CTL);
    const float* x = args.in[0]; const float* g_pre = args.in[1]; const float* w_in = args.in[2]; const float* mconv_w = args.in[3]; const float* mconv_b = args.in[4];
    const float* b_i = args.in[5]; const float* b_f = args.in[6]; const float* mnorm = args.in[7]; const float* w_out = args.in[8]; const float* g_postmix = args.in[9];
    const float* g_preffn = args.in[10]; const float* w_up = args.in[11]; const float* fconv_w = args.in[12]; const float* fconv_b = args.in[13]; const float* w_down = args.in[14];
    const float* g_postffn = args.in[15];
    bf16* WT_IN = (bf16*)(ws + WS_WIN); bf16* WT_OUT = (bf16*)(ws + WS_WOUT); bf16* WT_UP = (bf16*)(ws + WS_WUP); bf16* WT_DN = (bf16*)(ws + WS_WDN);
    float* GATES = (float*)(ws + WS_GATES); bf16* H = (bf16*)(ws + WS_H); bf16* PROJ = (bf16*)(ws + WS_PROJ); bf16* MIXIN = (bf16*)(ws + WS_MIXIN); bf16* MIX = (bf16*)(ws + WS_MIX);
    bf16* ACT = (bf16*)(ws + WS_ACT); float* GFIRST = (float*)(ws + WS_GFIRST); float* GLAST = (float*)(ws + WS_GLAST); float* UFIRST = (float*)(ws + WS_UFIRST); bf16* Y = (bf16*)(ws + WS_Y);
    for (int u = F.tid; u < (LDS_BYTES - LDSCTL_OFF) / 4; u += NWAVES * 64) ((LAS unsigned*)(F.lds + LDSCTL_OFF))[u] = 0u;
    __syncthreads();
    XcdBarrier bar = xcd_barrier_post((unsigned*)(F.ctl + CW_BAR), F.MISC + 8);
    const int lo = args.ph_lo, hi = args.ph_hi;
#define IN(k) (lo <= (k) && (k) < hi)
#define SEAM(k) do { if (IN(k) && IN((k) + 1)) xcd_barrier(bar); } while (0)

    if (IN(0)) { const P0Args a{x, g_pre, w_in, b_i, b_f, w_out, w_up, w_down, WT_IN, WT_OUT, WT_UP, WT_DN, H, GATES}; p0_prologue(F, a); }
    SEAM(0);
    if (IN(1)) { pg8::Gemm g{H, WT_IN, T, NIN, D}; pg8::StaticOrder S; S.init(T, NIN, F.G, (int)blockIdx.x);
        pg8::EpiProj E{PROJ};
        pg8::gemm_phase<pg8::EpiProj, pg8::StaticOrder, true, true>(F.lds + RING_OFF, g, S, E); }
    SEAM(1);
    if (IN(2)) { const MixArgs a{PROJ, GATES, mconv_w, mconv_b, mnorm, args.out, MIXIN}; p2_mixers_naive(F, a); }
    SEAM(2);
    if (IN(3)) { pg8::Gemm g{MIXIN, WT_OUT, T, D, D}; pg8::StaticOrder S; S.init(T, D, F.G, (int)blockIdx.x);
        pg8::EpiBf16<0> E{MIX, D, nullptr, 0, 0, 1.f};
        pg8::gemm_phase<pg8::EpiBf16<0>, pg8::StaticOrder, true, true>(F.lds + RING_OFF, g, S, E); }
    SEAM(3);
    if (IN(4)) p3b_rows(F, x, MIX, g_postmix, g_preffn, args.out, H);
    SEAM(4);
    if (IN(5)) { pg8::Gemm g{H, WT_UP, T, NUP, D}; pg8::StaticOrder S; S.init(T, NUP, F.G, (int)blockIdx.x);
        pg8::EpiGateUp E{ACT, fconv_w, fconv_b, GFIRST, GLAST, UFIRST};
        pg8::gemm_phase<pg8::EpiGateUp, pg8::StaticOrder, true, true>(F.lds + RING_OFF, g, S, E); }
    SEAM(5);
    if (IN(6)) p4b_fixup(F, fconv_w, fconv_b, GFIRST, GLAST, UFIRST, ACT);
    SEAM(6);
    if (IN(7)) { pg8::Gemm g{ACT, WT_DN, T, D, DFF}; pg8::StaticOrder S; S.init(T, D, F.G, (int)blockIdx.x);
        pg8::EpiBf16<0> E{Y, D, nullptr, 0, 0, 1.f};
        pg8::gemm_phase<pg8::EpiBf16<0>, pg8::StaticOrder, true, true>(F.lds + RING_OFF, g, S, E); }
    SEAM(7);
    if (IN(8)) p6_rows(F, Y, g_postffn, args.out);
#undef IN
#undef SEAM
}
}

#ifndef MK_N_LAUNCHES
#define MK_N_LAUNCHES 1
#endif
extern "C" void kernel_launch(void* const* d_in, const int* in_sizes, int n_in, void* d_out, int out_size, void* d_ws, size_t ws_size, hipStream_t stream) {
    using namespace mk;
    static int grid = 0;
    if (grid == 0) {
        if (n_in != 16 || in_sizes[0] != T * D || out_size != T * D || ws_size < WS_END) { fprintf(stderr, "kernel_launch: unexpected shapes / workspace (n_in %d, ws %zu); nothing launched\n", n_in, ws_size); grid = -1; return; }
        int dev = 0, cus = 0, per_cu = 0;
        if (hipGetDevice(&dev) != hipSuccess || hipDeviceGetAttribute(&cus, hipDeviceAttributeMultiprocessorCount, dev) != hipSuccess) { grid = -1; return; }
        if (hipFuncSetAttribute((const void*)mega_fwd, hipFuncAttributeMaxDynamicSharedMemorySize, LDS_BYTES) != hipSuccess) { fprintf(stderr, "kernel_launch: hipFuncSetAttribute failed\n"); grid = -1; return; }
        if (hipOccupancyMaxActiveBlocksPerMultiprocessor(&per_cu, (const void*)mega_fwd, NWAVES * 64, LDS_BYTES) != hipSuccess || per_cu < 1) { fprintf(stderr, "kernel_launch: occupancy query says %d blocks per CU\n", per_cu); (void)hipGetLastError(); grid = -1; return; }
        grid = cus;
    }
    if (grid < 0) return;
    if (hipMemsetAsync((char*)d_ws + WS_CTL, 0, CTL_ZERO_BYTES, stream) != hipSuccess) return;
    Args a{};
    for (int i = 0; i < 16; ++i) a.in[i] = (const float*)d_in[i];
    a.out = (float*)d_out; a.ws = (unsigned char*)d_ws;
#if MK_N_LAUNCHES == 1
    a.ph_lo = 0; a.ph_hi = N_PHASES;
    hipLaunchKernelGGL(mega_fwd, dim3(grid), dim3(NWAVES * 64), LDS_BYTES, stream, a);
#else
    for (int p = 0; p < N_PHASES; ++p) { a.ph_lo = p; a.ph_hi = p + 1; hipLaunchKernelGGL(mega_fwd, dim3(grid), dim3(NWAVES * 64), LDS_BYTES, stream, a); }
#endif
}
```

```cpp
#include <hip/hip_runtime.h>
#include <cstdio>
#include <cstdint>
namespace pg8 {
#define PG8_LAS __attribute__((address_space(3)))
typedef unsigned short bf16_t;
typedef short bf16x8 __attribute__((ext_vector_type(8)));
typedef float f32x4 __attribute__((ext_vector_type(4)));
typedef unsigned u32x4 __attribute__((ext_vector_type(4)));
constexpr int BM = 256, BK = 64, HALF = 128, HTB = HALF * BK * 2  , STAGE_BYTES = 8 * HTB, NXCD = 8, WGM = 8;

__host__ __device__ __forceinline__ int lds_byte(int r, int c) { const int st = (r >> 4) * 2 + (c >> 5), rr = r & 15, cc = c & 31, ob = rr * 64 + cc * 2; return st * 1024 + (ob ^ (((ob >> 9) & 1) << 5)); }
__host__ __device__ __forceinline__ void stage_rc(int b, int& R, int& C) { const int st = b / 1024, sb = b % 1024, swz = sb ^ (((sb >> 9) & 1) << 5); R = (st >> 1) * 16 + swz / 64; C = (st & 1) * 32 + (swz % 64) / 2; }
__host__ __device__ __forceinline__ int perm32(int rho) { const int n = rho >> 4, i = rho & 15; return 8 * (i >> 2) + 4 * n + (i & 3); }

struct Unit { int pm, pn; };
struct Gemm { const bf16_t* A; const bf16_t* Bt; int M, N, K; };

struct StaticOrder {
    int nM, nN, nwg, G, c;
    __host__ __device__ void init(int M, int N, int G_, int c_) { nM = M / BM; nN = N / BM; nwg = nM * nN; G = G_; c = c_; }
    __host__ __device__ bool next(int i, Unit& u) const {
        const long L = (long)i * G + c; if (L >= nwg) return false;
        int wgid = (int)L; { const int q = nwg / NXCD, r = nwg % NXCD, xcd = wgid % NXCD, off = wgid / NXCD; wgid = (xcd < r ? xcd * (q + 1) : r * (q + 1) + (xcd - r) * q) + off; }
        const int nig = WGM * nN, gid = wgid / nig, fm = gid * WGM, gsz = (nM - fm) < WGM ? (nM - fm) : WGM;
        u.pm = fm + ((wgid % nig) % gsz); u.pn = (wgid % nig) / gsz; return true;
    }
    __device__ __forceinline__ void a_ready(const Unit&) const {}
    __device__ __forceinline__ void done(const Unit&) const {}
};

__device__ __forceinline__ unsigned cvt_pk_bf16(float lo, float hi) { unsigned r; asm volatile("v_cvt_pk_bf16_f32 %0, %1, %2" : "=v"(r) : "v"(lo), "v"(hi)); return r; }
typedef float f32x2 __attribute__((ext_vector_type(2)));
__device__ __forceinline__ f32x2 gelu_pk(f32x2 v) {
    const f32x2 av = __builtin_elementwise_abs(v), d = av * 0.2316418882f + 1.0f;
    f32x2 t; t.x = __builtin_amdgcn_rcpf(d.x); t.y = __builtin_amdgcn_rcpf(d.y);
    f32x2 q = t * 0.5307027145f + (-0.7265760135f); q = q * t + 0.7107068705f; q = q * t + (-0.142248368f); q = q * t + 0.127414796f; q = q * t;
    const f32x2 s = (v * v) * (-0.72134752044f);
    f32x2 e; e.x = __builtin_amdgcn_exp2f(s.x); e.y = __builtin_amdgcn_exp2f(s.y);
    const f32x2 m = v * (q * e), r = v - m;
    f32x2 o; o.x = v.x < 0.f ? m.x : r.x; o.y = v.y < 0.f ? m.y : r.y; return o;
}

template <int ACT  > struct EpiBf16 {
    static constexpr bool PERM = true, AFTER_DRAIN = false; static_assert(ACT == 0 || ACT == 1, "EpiBf16: ACT is 0 (none) or 1 (gelu_pk)");
    bf16_t* O; int ldc; const float* bias; int split_cols; size_t split_stride; float scale0;
    __device__ __forceinline__ void operator()(const f32x4 (&acc)[2][2][4][2], const Unit& u, int wr, int wc, int fr, int fq) const {
        const int row0 = u.pm * BM + wr * 64 + fr; int colt = u.pn * BM; bf16_t* base = O;
        float sc = 1.f; if (split_cols) { const int t = colt / split_cols; base += (size_t)t * split_stride; colt -= t * split_cols; if (t == 0) sc = scale0; }
        const int col0 = colt + wc * 32 + 8 * fq, bcol0 = u.pn * BM + wc * 32 + 8 * fq;
        f32x4 bv[2][2];
#pragma unroll
        for (int bj = 0; bj < 2; ++bj)
#pragma unroll
            for (int n = 0; n < 2; ++n) bv[bj][n] = bias ? *(const f32x4*)(bias + bcol0 + bj * HALF + 4 * n) : (f32x4){0.f, 0.f, 0.f, 0.f};
#pragma unroll
        for (int ai = 0; ai < 2; ++ai)
#pragma unroll
            for (int m = 0; m < 4; ++m) { bf16_t* rowp = base + (size_t)(row0 + ai * HALF + m * 16) * ldc + col0;
#pragma unroll
                for (int bj = 0; bj < 2; ++bj) { f32x4 v0 = acc[ai][bj][m][0] + bv[bj][0], v1 = acc[ai][bj][m][1] + bv[bj][1];
                    if (ACT == 1) { f32x2 a = gelu_pk((f32x2){v0[0], v0[1]}), b = gelu_pk((f32x2){v0[2], v0[3]}), c = gelu_pk((f32x2){v1[0], v1[1]}), d = gelu_pk((f32x2){v1[2], v1[3]});
                        v0 = (f32x4){a.x, a.y, b.x, b.y}; v1 = (f32x4){c.x, c.y, d.x, d.y}; }
                    v0 = v0 * sc; v1 = v1 * sc; u32x4 w; w.x = cvt_pk_bf16(v0[0], v0[1]); w.y = cvt_pk_bf16(v0[2], v0[3]); w.z = cvt_pk_bf16(v1[0], v1[1]); w.w = cvt_pk_bf16(v1[2], v1[3]);
                    *(u32x4*)(rowp + bj * HALF) = w; } }
    }
};

__device__ __forceinline__ float gelu_tanh(float x) {
    const float y = 1.5957691216057308f * (x + 0.044715f * x * x * x);
    return x / (1.0f + __expf(-y));
}
struct EpiGateUp {
    static constexpr bool PERM = true, AFTER_DRAIN = false;
    static constexpr int DFF = 2816;
    bf16_t* ACT; const float* cw; const float* cb; float* GFIRST; float* GLAST; float* UFIRST;
    __device__ __forceinline__ void operator()(const f32x4 (&acc)[2][2][4][2], const Unit& u, int wr, int wc, int fr, int fq) const {
        const int lane = fq * 16 + fr;
        const int colg = u.pn * 128 + wc * 32 + 8 * fq;
        f32x4 w0[2], w1[2], w2[2], bb[2];
#pragma unroll
        for (int n = 0; n < 2; ++n) { w0[n] = *(const f32x4*)(cw + colg + 4 * n); w1[n] = *(const f32x4*)(cw + DFF + colg + 4 * n); w2[n] = *(const f32x4*)(cw + 2 * DFF + colg + 4 * n); bb[n] = *(const f32x4*)(cb + colg + 4 * n); }
        const int src1 = (lane & 48) | ((fr + 15) & 15), src2 = (lane & 48) | ((fr + 14) & 15);
#pragma unroll
        for (int ai = 0; ai < 2; ++ai) {
            f32x4 pp1[2] = {{0.f, 0.f, 0.f, 0.f}, {0.f, 0.f, 0.f, 0.f}}, pp2[2] = {{0.f, 0.f, 0.f, 0.f}, {0.f, 0.f, 0.f, 0.f}};
            const int slab = u.pm * 4 + ai * 2 + wr;
#pragma unroll
            for (int m = 0; m < 4; ++m) {
                f32x4 g[2], uu[2], p1[2], p2[2];
#pragma unroll
                for (int n = 0; n < 2; ++n) { g[n] = acc[ai][0][m][n]; uu[n] = acc[ai][1][m][n];
#pragma unroll
                    for (int j = 0; j < 4; ++j) { p1[n][j] = __shfl(g[n][j], src1); p2[n][j] = __shfl(g[n][j], src2); } }
                const size_t row = (size_t)(u.pm * BM + ai * HALF + wr * 64 + m * 16 + fr);
                u32x4 w;
                unsigned pk[4];
#pragma unroll
                for (int n = 0; n < 2; ++n) {
                    const f32x4 g1 = fr >= 1 ? p1[n] : pp1[n], g2 = fr >= 2 ? p2[n] : pp2[n];
                    const f32x4 cv = w2[n] * g[n] + w1[n] * g1 + w0[n] * g2 + bb[n];
                    float a[4];
#pragma unroll
                    for (int j = 0; j < 4; ++j) a[j] = gelu_tanh(cv[j]) * uu[n][j];
                    pk[2 * n] = cvt_pk_bf16(a[0], a[1]); pk[2 * n + 1] = cvt_pk_bf16(a[2], a[3]);
                }
                w.x = pk[0]; w.y = pk[1]; w.z = pk[2]; w.w = pk[3];
                if (m == 0 && fr < 2) {
                    float* gf = GFIRST + (size_t)(slab * 2 + fr) * DFF + colg; float* uf = UFIRST + (size_t)(slab * 2 + fr) * DFF + colg;
                    *(f32x4*)gf = g[0]; *(f32x4*)(gf + 4) = g[1]; *(f32x4*)uf = uu[0]; *(f32x4*)(uf + 4) = uu[1];
                } else {
                    *(u32x4*)(ACT + row * DFF + colg) = w;
                }
                if (m == 3 && fr >= 14) { float* gl = GLAST + (size_t)(slab * 2 + (fr - 14)) * DFF + colg; *(f32x4*)gl = g[0]; *(f32x4*)(gl + 4) = g[1]; }
#pragma unroll
                for (int n = 0; n < 2; ++n) { pp1[n] = p1[n]; pp2[n] = p2[n]; }
            }
        }
    }
};

struct EpiProj {
    static constexpr bool PERM = true, AFTER_DRAIN = false;
    static constexpr int LDC = 3584;
    bf16_t* O; const float* cw; const float* cb; float* QKFIRST; float* QKLAST;
    __device__ __forceinline__ void operator()(const f32x4 (&acc)[2][2][4][2], const Unit& u, int wr, int wc, int fr, int fq) const {
        if (u.pn < 4) {
            const int lane = fq * 16 + fr;
            const float ksc = (u.pn >= 2) ? 0.08838834764831845f : 1.0f;
            const int s1 = (lane & 48) | ((fr + 15) & 15), s2 = (lane & 48) | ((fr + 14) & 15), s3 = (lane & 48) | ((fr + 13) & 15);
#pragma unroll
            for (int bj = 0; bj < 2; ++bj)
#pragma unroll
                for (int n = 0; n < 2; ++n) {
                    const int colc = u.pn * BM + bj * HALF + wc * 32 + 8 * fq + 4 * n;
                    const f32x4 w0 = *(const f32x4*)(cw + colc), w1 = *(const f32x4*)(cw + 1024 + colc), w2 = *(const f32x4*)(cw + 2048 + colc), w3 = *(const f32x4*)(cw + 3072 + colc), bb = *(const f32x4*)(cb + colc);
#pragma unroll
                    for (int ai = 0; ai < 2; ++ai) {
                        f32x4 pp1 = {0.f, 0.f, 0.f, 0.f}, pp2 = pp1, pp3 = pp1;
                        const int slab = u.pm * 4 + ai * 2 + wr;
#pragma unroll
                        for (int m = 0; m < 4; ++m) {
                            const f32x4 g = acc[ai][bj][m][n]; f32x4 p1, p2, p3;
#pragma unroll
                            for (int j = 0; j < 4; ++j) { p1[j] = __shfl(g[j], s1); p2[j] = __shfl(g[j], s2); p3[j] = __shfl(g[j], s3); }
                            const f32x4 g1 = fr >= 1 ? p1 : pp1, g2 = fr >= 2 ? p2 : pp2, g3 = fr >= 3 ? p3 : pp3;
                            const f32x4 cv = w3 * g + w2 * g1 + w1 * g2 + w0 * g3 + bb;
                            float o[4];
#pragma unroll
                            for (int j = 0; j < 4; ++j) o[j] = cv[j] * ksc / (1.0f + __expf(-cv[j]));
                            const size_t row = (size_t)(u.pm * BM + ai * HALF + wr * 64 + m * 16 + fr);
                            if (m == 0 && fr < 3) *(f32x4*)(QKFIRST + (size_t)(slab * 3 + fr) * 1024 + colc) = g;
                            else { typedef unsigned u32x2v __attribute__((ext_vector_type(2))); u32x2v w; w.x = cvt_pk_bf16(o[0], o[1]); w.y = cvt_pk_bf16(o[2], o[3]); *(u32x2v*)(O + row * LDC + colc) = w; }
                            if (m == 3 && fr >= 13) *(f32x4*)(QKLAST + (size_t)(slab * 3 + (fr - 13)) * 1024 + colc) = g;
                            pp1 = p1; pp2 = p2; pp3 = p3;
                        }
                    }
                }
            return;
        }
        const int row0 = u.pm * BM + wr * 64 + fr, col0 = u.pn * BM + wc * 32 + 8 * fq;
        const float sc = (u.pn == 8 || u.pn == 9) ? 0.18033688011112042f : 1.0f;
#pragma unroll
        for (int ai = 0; ai < 2; ++ai)
#pragma unroll
            for (int m = 0; m < 4; ++m) { bf16_t* rowp = O + (size_t)(row0 + ai * HALF + m * 16) * LDC + col0;
#pragma unroll
                for (int bj = 0; bj < 2; ++bj) { const f32x4 v0 = acc[ai][bj][m][0] * sc, v1 = acc[ai][bj][m][1] * sc;
                    u32x4 w; w.x = cvt_pk_bf16(v0[0], v0[1]); w.y = cvt_pk_bf16(v0[2], v0[3]); w.z = cvt_pk_bf16(v1[0], v1[1]); w.w = cvt_pk_bf16(v1[2], v1[3]);
                    *(u32x4*)(rowp + bj * HALF) = w; } }
    }
};
template <class Epi, class Sched, bool ALIGN_EPI = false, bool SP2 = false>
__device__ __forceinline__ void gemm_phase(PG8_LAS unsigned char* lds, const Gemm g, const Sched& S, const Epi& E) {
    const int tid = threadIdx.x, wid = __builtin_amdgcn_readfirstlane(tid >> 6), lane = tid & 63, wr = wid >> 2, wc = wid & 3, fr = lane & 15, fq = lane >> 4;
    const int K = g.K, nt = K / BK;
    unsigned voffA[2], voffB[2];
#pragma unroll
    for (int i = 0; i < 2; ++i) { int R, C; stage_rc(tid * 16 + i * 8192, R, C); const int Rb = Epi::PERM ? ((R & ~31) + perm32(R & 31)) : R;
        voffA[i] = (unsigned)(R * K + C) * 2u; voffB[i] = (unsigned)(Rb * K + C) * 2u; }
    const size_t kstep = (size_t)(BK * 2);
    const size_t hstep = (size_t)HALF * K * 2;
    const size_t tstep = 2 * hstep;
    const unsigned ldsw = (unsigned)wid * 1024u;
    const int aoff = lds_byte(wr * 64 + fr, fq * 8), boff = lds_byte(wc * 32 + fr, fq * 8);
#define PG8_SA(b, h) (((b) * 2 + (h)) * HTB)
#define PG8_SB(b, h) ((4 + (b) * 2 + (h)) * HTB)
#define PG8_STAGE(bufoff, gbase, voff) do { _Pragma("unroll") for (int _i = 0; _i < 2; ++_i) \
        __builtin_amdgcn_global_load_lds((const unsigned*)((const char*)(gbase) + (voff)[_i]), (PG8_LAS unsigned*)(lds + (bufoff) + ldsw + _i * 8192), 16, 0, 0); } while (0)
#define PG8_LDA(dst, b, h) do { _Pragma("unroll") for (int m = 0; m < 4; ++m) _Pragma("unroll") for (int k = 0; k < 2; ++k) dst[m][k] = *(const PG8_LAS bf16x8*)(lds + PG8_SA(b, h) + aoff + m * 2048 + k * 1024); } while (0)
#define PG8_LDB(dst, b, h) do { _Pragma("unroll") for (int n = 0; n < 2; ++n) _Pragma("unroll") for (int k = 0; k < 2; ++k) dst[n][k] = *(const PG8_LAS bf16x8*)(lds + PG8_SB(b, h) + boff + n * 2048 + k * 1024); } while (0)
#define PG8_MMA(ai, bj, At, Bt) do { __builtin_amdgcn_s_setprio(1); _Pragma("unroll") for (int m = 0; m < 4; ++m) _Pragma("unroll") for (int n = 0; n < 2; ++n) _Pragma("unroll") for (int k = 0; k < 2; ++k) \
        acc[ai][bj][m][n] = __builtin_amdgcn_mfma_f32_16x16x32_bf16(Bt[n][k], At[m][k], acc[ai][bj][m][n], 0, 0, 0); __builtin_amdgcn_s_setprio(0); } while (0)
#define PG8_WAIT_V(n) asm volatile("s_waitcnt vmcnt(" #n ")" ::: "memory")
#define PG8_WAIT_L(n) asm volatile("s_waitcnt lgkmcnt(" #n ")" ::: "memory")
#define PG8_BAR __builtin_amdgcn_s_barrier()
#define PG8_SCHED __builtin_amdgcn_sched_barrier(0)
    Unit cur, nxt; int ui = 0;
    if (!S.next(0, cur)) return;
    f32x4 acc[2][2][4][2];
#pragma unroll
    for (int a = 0; a < 2; ++a)
#pragma unroll
        for (int b = 0; b < 2; ++b)
#pragma unroll
            for (int m = 0; m < 4; ++m)
#pragma unroll
                for (int n = 0; n < 2; ++n) acc[a][b][m][n] = (f32x4){0.f, 0.f, 0.f, 0.f};
    bf16x8 At[4][2], B0[2][2], B1[2][2];
    const char* cA = (const char*)g.A + (size_t)cur.pm * tstep; const char* cB = (const char*)g.Bt + (size_t)cur.pn * tstep;
    S.a_ready(cur);
    if constexpr (SP2) {
        PG8_STAGE(PG8_SB(0, 0), cB, voffB); PG8_STAGE(PG8_SB(0, 1), cB + hstep, voffB); PG8_STAGE(PG8_SA(0, 0), cA, voffA); PG8_STAGE(PG8_SA(0, 1), cA + hstep, voffA);
        if (wr == 1) PG8_BAR;
        PG8_WAIT_V(2); PG8_BAR;
        PG8_STAGE(PG8_SB(1, 0), cB + kstep, voffB); PG8_STAGE(PG8_SA(1, 0), cA + kstep, voffA); PG8_STAGE(PG8_SB(1, 1), cB + hstep + kstep, voffB);
        PG8_WAIT_V(6); PG8_BAR;
    } else {
        PG8_STAGE(PG8_SB(0, 0), cB, voffB); PG8_STAGE(PG8_SA(0, 0), cA, voffA); PG8_STAGE(PG8_SB(0, 1), cB + hstep, voffB); PG8_STAGE(PG8_SA(0, 1), cA + hstep, voffA);
        if (wr == 1) PG8_BAR;
        PG8_WAIT_V(4); PG8_BAR;
        PG8_STAGE(PG8_SB(1, 0), cB + kstep, voffB); PG8_STAGE(PG8_SA(1, 0), cA + kstep, voffA); PG8_STAGE(PG8_SB(1, 1), cB + hstep + kstep, voffB);
        PG8_WAIT_V(6); PG8_BAR;
    }
    for (;;) {
        const bool has_next = S.next(ui + 1, nxt);
        const char* nA = has_next ? (const char*)g.A + (size_t)nxt.pm * tstep : cA; const char* nB = has_next ? (const char*)g.Bt + (size_t)nxt.pn * tstep : cB;
        for (int t = 0; t < nt; t += 2) {
            const bool last = (t == nt - 2);
            const char* a1 = cA + (size_t)(t + 1) * kstep;
            const char* a2 = last ? nA : cA + (size_t)(t + 2) * kstep; const char* b2 = last ? nB : cB + (size_t)(t + 2) * kstep;
            const char* a3 = a2 + kstep; const char* b3 = b2 + kstep;
            if (last && has_next) S.a_ready(nxt);
            if constexpr (SP2) {
            PG8_LDB(B0, 0, 0); PG8_LDB(B1, 0, 1); PG8_SCHED; PG8_LDA(At, 0, 0); PG8_STAGE(PG8_SA(1, 1), a1 + hstep, voffA);
            PG8_WAIT_V(8); PG8_WAIT_L(0); PG8_BAR; PG8_MMA(0, 0, At, B0); PG8_MMA(0, 1, At, B1); PG8_BAR; PG8_SCHED;
            PG8_LDA(At, 0, 1); PG8_STAGE(PG8_SB(0, 0), b2, voffB); PG8_STAGE(PG8_SB(0, 1), b2 + hstep, voffB); PG8_STAGE(PG8_SA(0, 0), a2, voffA);
            PG8_WAIT_V(8); PG8_WAIT_L(0); PG8_BAR; PG8_MMA(1, 0, At, B0); PG8_MMA(1, 1, At, B1); PG8_BAR; PG8_SCHED;
            PG8_LDB(B0, 1, 0); PG8_LDB(B1, 1, 1); PG8_SCHED; PG8_LDA(At, 1, 0); PG8_STAGE(PG8_SA(0, 1), a2 + hstep, voffA);
            PG8_WAIT_V(8); PG8_WAIT_L(0); PG8_BAR; PG8_MMA(0, 0, At, B0); PG8_MMA(0, 1, At, B1); PG8_BAR; PG8_SCHED;
            PG8_LDA(At, 1, 1); PG8_STAGE(PG8_SB(1, 0), b3, voffB); PG8_STAGE(PG8_SB(1, 1), b3 + hstep, voffB); PG8_STAGE(PG8_SA(1, 0), a3, voffA);
            PG8_WAIT_V(8); PG8_WAIT_L(0); PG8_BAR; PG8_MMA(1, 0, At, B0); PG8_MMA(1, 1, At, B1); PG8_BAR; PG8_SCHED;
            } else {
            PG8_LDB(B0, 0, 0); PG8_SCHED; PG8_LDA(At, 0, 0); PG8_STAGE(PG8_SA(1, 1), a1 + hstep, voffA);
            PG8_WAIT_L(8); PG8_BAR; PG8_WAIT_L(0); PG8_MMA(0, 0, At, B0); PG8_BAR; PG8_SCHED;
            PG8_LDB(B1, 0, 1); PG8_STAGE(PG8_SB(0, 0), b2, voffB);
            PG8_BAR; PG8_WAIT_L(0); PG8_MMA(0, 1, At, B1); PG8_BAR;
            PG8_LDA(At, 0, 1); PG8_STAGE(PG8_SA(0, 0), a2, voffA);
            PG8_BAR; PG8_WAIT_L(0); PG8_MMA(1, 0, At, B0); PG8_BAR; PG8_SCHED;
            PG8_STAGE(PG8_SB(0, 1), b2 + hstep, voffB);
            PG8_WAIT_V(6); PG8_BAR; PG8_MMA(1, 1, At, B1); PG8_BAR;
            PG8_LDB(B0, 1, 0); PG8_SCHED; PG8_LDA(At, 1, 0); PG8_STAGE(PG8_SA(0, 1), a2 + hstep, voffA);
            PG8_WAIT_L(8); PG8_BAR; PG8_WAIT_L(0); PG8_MMA(0, 0, At, B0); PG8_BAR; PG8_SCHED;
            PG8_LDB(B1, 1, 1); PG8_STAGE(PG8_SB(1, 0), b3, voffB);
            PG8_BAR; PG8_WAIT_L(0); PG8_MMA(0, 1, At, B1); PG8_BAR;
            PG8_LDA(At, 1, 1); PG8_STAGE(PG8_SA(1, 0), a3, voffA);
            PG8_BAR; PG8_WAIT_L(0); PG8_MMA(1, 0, At, B0); PG8_BAR; PG8_SCHED;
            PG8_STAGE(PG8_SB(1, 1), b3 + hstep, voffB);
            PG8_WAIT_V(6); PG8_BAR; PG8_MMA(1, 1, At, B1); PG8_BAR;
            }
        }
        if constexpr (ALIGN_EPI) { if (wr == 0) PG8_BAR; }
        if constexpr (!Epi::AFTER_DRAIN) { E(acc, cur, wr, wc, fr, fq); S.done(cur); }
        if (!has_next) break;
#pragma unroll
        for (int a = 0; a < 2; ++a)
#pragma unroll
            for (int b = 0; b < 2; ++b)
#pragma unroll
                for (int m = 0; m < 4; ++m)
#pragma unroll
                    for (int n = 0; n < 2; ++n) acc[a][b][m][n] = (f32x4){0.f, 0.f, 0.f, 0.f};
        cur = nxt; cA = nA; cB = nB; ++ui;
        if constexpr (ALIGN_EPI) { if (wr == 1) PG8_BAR; }
    }
    PG8_WAIT_V(0);
    if constexpr (!ALIGN_EPI) { if (wr == 0) PG8_BAR; }
    PG8_BAR;
    if constexpr (Epi::AFTER_DRAIN) { E.fused(acc, cur, wr, wc, fr, fq, lds, wid, lane); S.done(cur); }
#undef PG8_SA
#undef PG8_SB
#undef PG8_STAGE
#undef PG8_LDA
#undef PG8_LDB
#undef PG8_MMA
#undef PG8_WAIT_V
#undef PG8_WAIT_L
#undef PG8_BAR
#undef PG8_SCHED
}
}
#define GAS __attribute__((address_space(1)))
#define LAS __attribute__((address_space(3)))
typedef unsigned short bf16;
typedef unsigned v4u __attribute__((ext_vector_type(4)));
typedef float f32x4 __attribute__((ext_vector_type(4)));
typedef short bf16x8 __attribute__((ext_vector_type(8)));
typedef GAS unsigned gu32;
typedef GAS unsigned long long gu64;
#define RLX_AGENT __ATOMIC_RELAXED, __HIP_MEMORY_SCOPE_AGENT
#define LDS_WAIT() asm volatile("s_waitcnt lgkmcnt(0)" ::: "memory")
#define VM_WAIT() asm volatile("s_waitcnt vmcnt(0)" ::: "memory")
__device__ __forceinline__ unsigned long long rt() { return __builtin_amdgcn_s_memrealtime(); }
__device__ __forceinline__ unsigned f2bf(float f) { unsigned u = __builtin_bit_cast(unsigned, f); return (u + 0x7fffu + ((u >> 16) & 1u)) >> 16; }
__device__ __forceinline__ unsigned pk2(float lo, float hi) { return f2bf(lo) | (f2bf(hi) << 16); }

#define XB_TMO      128
#define XB_XCNT(j)  (256  + 64 * (j))
#define XB_XSUB(j)  (1280 + 64 * (j))
#define XB_XGEN(j)  (2304 + 64 * (j))
#define XB_TOP      3328
#define XB_TOPGEN   3392
#define XCD_BAR_WORDS 3456
#define XB_SPIN_CAP (1u << 18)

__device__ __forceinline__ unsigned xb_ld(unsigned* p)              { return __hip_atomic_load(p, __ATOMIC_RELAXED, __HIP_MEMORY_SCOPE_AGENT); }
__device__ __forceinline__ unsigned xb_add(unsigned* p, unsigned v) { return __hip_atomic_fetch_add(p, v, __ATOMIC_RELAXED, __HIP_MEMORY_SCOPE_AGENT); }
__device__ __forceinline__ unsigned xb_xcc_id() { return (unsigned)__builtin_amdgcn_s_getreg((3 << 11) | 20) & 0xFu; }
#define XB_SPIN(cond, bar) do { unsigned _sp = 0; while (cond) { __builtin_amdgcn_s_sleep(1); \
    if ((++_sp & 255u) == 0u) { if (xb_ld(&(bar)[XB_TMO])) break; if (_sp > XB_SPIN_CAP) { atomicAdd(&(bar)[XB_TMO], 1u); break; } } } } while (0)

struct XcdBarrier {
    unsigned* bar; unsigned x;
    volatile LAS unsigned* st;
};

__device__ __forceinline__ XcdBarrier xcd_barrier_post(unsigned* bar, volatile LAS unsigned* st) {
    XcdBarrier b; b.bar = bar; b.x = xb_xcc_id(); b.st = st;
    if (threadIdx.x == 0) (void)xb_add(&bar[XB_XCNT(b.x)], 1u);
    return b;
}
__device__ __forceinline__ void xcd_barrier_complete(unsigned* bar, unsigned x, unsigned& nloc, unsigned& nx) {
    const unsigned G = gridDim.x * gridDim.y * gridDim.z;
    unsigned sum, cnt, mine, sp = 0u;
    for (;;) {
        sum = 0u; cnt = 0u; mine = 0u;
#pragma unroll
        for (unsigned j = 0; j < 16; ++j) { const unsigned c = xb_ld(&bar[XB_XCNT(j)]); sum += c; cnt += (c > 0u) ? 1u : 0u; mine = (j == x) ? c : mine; }
        if (sum == G) break;
        __builtin_amdgcn_s_sleep(1);
        if ((++sp & 255u) == 0u) { if (xb_ld(&bar[XB_TMO])) break; if (sp > XB_SPIN_CAP) { atomicAdd(&bar[XB_TMO], 1u); break; } }
    }
    nloc = mine > 0u ? mine : 1u; nx = cnt > 0u ? cnt : 1u;
}

__device__ __forceinline__ void xcd_barrier(const XcdBarrier& b) {
    asm volatile("s_waitcnt vmcnt(0)" ::: "memory");
    __syncthreads();
    if (threadIdx.x == 0) {
        unsigned* bar = b.bar;
        __builtin_amdgcn_s_waitcnt(0);
        unsigned nloc = b.st[0], nx = b.st[1];
        if (nloc == 0u) { xcd_barrier_complete(bar, b.x, nloc, nx); b.st[0] = nloc; b.st[1] = nx; }
        const unsigned old = xb_add(&bar[XB_XSUB(b.x)], 1u);
        const unsigned gen = old / nloc;
        if (old + 1u == (gen + 1u) * nloc) {
            __builtin_amdgcn_fence(__ATOMIC_RELEASE, "agent");
            asm volatile("s_waitcnt vmcnt(0)" ::: "memory");
            const unsigned og = xb_add(&bar[XB_TOP], 1u);
            const unsigned tg = og / nx;
            if (og + 1u == (tg + 1u) * nx) xb_add(&bar[XB_TOPGEN], 1u);
            else XB_SPIN(xb_ld(&bar[XB_TOPGEN]) == tg, bar);
            __builtin_amdgcn_fence(__ATOMIC_ACQUIRE, "agent");
            xb_add(&bar[XB_XGEN(b.x)], 1u);
            asm volatile("s_waitcnt vmcnt(0)" ::: "memory");
        } else {
            XB_SPIN(xb_ld(&bar[XB_XGEN(b.x)]) == gen, bar);
            __builtin_amdgcn_fence(__ATOMIC_ACQUIRE, "agent");
            asm volatile("s_waitcnt vmcnt(0)" ::: "memory");
        }
    }
    __syncthreads();
}
namespace mk {
constexpr int NWAVES = 8;
constexpr int BATCH = 16, SEQ = 2048, D = 1024, T = BATCH * SEQ;
constexpr int IN_COLS = 3592, NIN = 3584, DFF = 2816, NUP = 2 * DFF;
constexpr int C_QM = 0, C_KM = 512, C_VM = 1024, C_OM = 1536, C_QS = 2048, C_KS = 2560, C_VS = 3072;
constexpr float EPS = 1e-6f;
constexpr size_t MiB = 1u << 20;
constexpr size_t WS_CTL = 0, CTL_ZERO_BYTES = 1 * MiB;
constexpr size_t WS_WIN = 2 * MiB, WS_WOUT = 9 * MiB, WS_WUP = 11 * MiB, WS_WDN = 22 * MiB, WS_GATES = 28 * MiB;
constexpr size_t WS_H = 32 * MiB, WS_PROJ = 96 * MiB, WS_MIXIN = 320 * MiB, WS_MIX = 384 * MiB;
constexpr size_t WS_QKFIRST = 448 * MiB, WS_QKLAST = 454 * MiB, WS_DN = 460 * MiB, WS_NS = 461 * MiB, WS_SCAL = 462 * MiB, WS_MS = 462 * MiB + 65536, WS_END = 463 * MiB;
constexpr size_t WS_ACT = 96 * MiB, WS_GFIRST = 272 * MiB, WS_GLAST = 283 * MiB, WS_UFIRST = 294 * MiB;
constexpr size_t WS_Y = 320 * MiB;
static_assert(WS_ACT + (size_t)T * DFF * 2 <= WS_GFIRST && WS_UFIRST + 11 * MiB <= WS_MIXIN, "ws map");
constexpr int CW_TMO = 0, CW_BAR = 4096;
constexpr int RING_OFF = 0, RING_BYTES = 131072, LDSCTL_OFF = RING_BYTES, MISC_OFF = LDSCTL_OFF + 320, LDS_BYTES = 147456;

struct Frame {
    LAS unsigned char* lds;
    volatile LAS unsigned* MISC;
    gu32* ctl;
    int tid, lane, wave, vcu, G;
};
__device__ __forceinline__ float wave_sum(float v) {
#pragma unroll
    for (int o = 1; o < 64; o <<= 1) v += __shfl_xor(v, o);
    return v;
}
__device__ __forceinline__ float bf2f(bf16 b) { return __uint_as_float((unsigned)b << 16); }
__device__ __forceinline__ float logsig(float x) { return fminf(x, 0.f) - __logf(1.f + __expf(-fabsf(x))); }
__device__ __forceinline__ float sigmoidf_(float x) { return 1.f / (1.f + __expf(-x)); }

__device__ __forceinline__ void transpose_item(const float* W, int ldw, int srccol0, bf16* WT, int K, int destrow0, int k0, LAS float* scr, int lane) {
#pragma unroll 8
    for (int i = 0; i < 32; ++i) { const int kk = 2 * i + (lane >> 5); scr[kk * 33 + (lane & 31)] = W[(size_t)(k0 + kk) * ldw + srccol0 + (lane & 31)]; }
    LDS_WAIT(); asm volatile("" ::: "memory");
    const int c = lane & 7;
#pragma unroll
    for (int j = 0; j < 4; ++j) { const int n = (lane >> 3) + 8 * j; const LAS float* s = scr + (8 * c) * 33 + n;
        v4u o; o.x = pk2(s[0 * 33], s[1 * 33]); o.y = pk2(s[2 * 33], s[3 * 33]); o.z = pk2(s[4 * 33], s[5 * 33]); o.w = pk2(s[6 * 33], s[7 * 33]);
        *(GAS v4u*)(WT + (size_t)(destrow0 + n) * K + k0 + 8 * c) = o; }
    LDS_WAIT(); asm volatile("" ::: "memory");
}
struct P0Args { const float *x, *g_pre, *w_in, *b_i, *b_f, *w_out, *w_up, *w_down; bf16 *WT_IN, *WT_OUT, *WT_UP, *WT_DN, *H; float* GATES; };
__device__ __forceinline__ void p0_prologue(Frame& F, const P0Args& a) {
    LAS float* scr = (LAS float*)(F.lds + RING_OFF + F.wave * 16384);
    const int gw = F.vcu * NWAVES + F.wave, NGW = F.G * NWAVES;
    constexpr int I_IN = 16 * (NIN / 32), I_OUT = 16 * 32, I_UP = 16 * (NUP / 32), I_DN = (DFF / 64) * 32;
    constexpr int NITEMS = I_IN + I_OUT + I_UP + I_DN;
    for (int it = gw; it < NITEMS; it += NGW) {
        int r = it;
        if (r < I_IN) { const int nblk = NIN / 32, kb = r / nblk, nb = r % nblk, n0 = 32 * nb; const int src = n0 < 2048 ? n0 : n0 + 8;
            transpose_item(a.w_in, IN_COLS, src, a.WT_IN, D, n0, 64 * kb, scr, F.lane); continue; }
        r -= I_IN;
        if (r < I_OUT) { const int kb = r / 32, nb = r % 32; transpose_item(a.w_out, D, 32 * nb, a.WT_OUT, D, 32 * nb, 64 * kb, scr, F.lane); continue; }
        r -= I_OUT;
        if (r < I_UP) { const int nblk = NUP / 32, kb = r / nblk, nb = r % nblk, n0 = 32 * nb, tj = n0 >> 8, w = n0 & 255; const int src = w < 128 ? 128 * tj + w : DFF + 128 * tj + (w - 128);
            transpose_item(a.w_up, NUP, src, a.WT_UP, D, n0, 64 * kb, scr, F.lane); continue; }
        r -= I_UP;
        { const int kb = r / 32, nb = r % 32; transpose_item(a.w_down, D, 32 * nb, a.WT_DN, DFF, 32 * nb, 64 * kb, scr, F.lane); }
    }
    __syncthreads();
    LAS float* WG = (LAS float*)(F.lds + RING_OFF);
    for (int i = F.tid; i < 8 * D; i += NWAVES * 64) { const int k = i >> 3, g = i & 7; WG[g * D + k] = a.w_in[(size_t)k * IN_COLS + 2048 + g]; }
    __syncthreads();
    f32x4 gain[4];
#pragma unroll
    for (int j = 0; j < 4; ++j) gain[j] = ((const GAS f32x4*)a.g_pre)[64 * j + F.lane];
    for (int m = gw; m < T; m += NGW) {
        const GAS f32x4* xr = (const GAS f32x4*)(a.x + (size_t)m * D) + F.lane;
        f32x4 v[4]; float s = 0.f;
#pragma unroll
        for (int j = 0; j < 4; ++j) { v[j] = xr[64 * j]; s += (v[j].x * v[j].x + v[j].y * v[j].y) + (v[j].z * v[j].z + v[j].w * v[j].w); }
        const float rstd = 1.0f / sqrtf(wave_sum(s) * (1.f / D) + EPS);
#pragma unroll
        for (int j = 0; j < 4; ++j) v[j] = v[j] * rstd * gain[j];
        GAS unsigned long long* o8 = (GAS unsigned long long*)(a.H + (size_t)m * D) + F.lane;
#pragma unroll
        for (int j = 0; j < 4; ++j) o8[64 * j] = (unsigned long long)pk2(v[j].x, v[j].y) | ((unsigned long long)pk2(v[j].z, v[j].w) << 32);
        float dots[8];
#pragma unroll
        for (int g = 0; g < 8; ++g) { float d = 0.f;
#pragma unroll
            for (int j = 0; j < 4; ++j) { const f32x4 w = ((const LAS f32x4*)(WG + g * D))[64 * j + F.lane]; d += (v[j].x * w.x + v[j].y * w.y) + (v[j].z * w.z + v[j].w * w.w); }
            dots[g] = wave_sum(d); }
        if (F.lane == 0) {
#pragma unroll
            for (int h = 0; h < 4; ++h) { a.GATES[(size_t)m * 8 + h] = dots[h] + a.b_i[h]; a.GATES[(size_t)m * 8 + 4 + h] = logsig(dots[4 + h] + a.b_f[h]); }
        }
    }
}

struct MixArgs { const bf16* PROJ; const float* GATES; const float *cw, *cb, *mnorm; float* HRAW; bf16* MIXIN; const float *QKFIRST, *QKLAST; bf16 *DC, *CS; float *DN, *NS, *SCAL, *MS; };
__device__ __forceinline__ float patch_qk(const float* QKFIRST, const float* QKLAST, const float* cw, const float* cb, int slab, bool has_prev, int rr, int chn, float sc) {
    float x[6];
#pragma unroll
    for (int j = 0; j < 3; ++j) { x[j] = has_prev ? QKLAST[(size_t)((slab - 1) * 3 + j) * 1024 + chn] : 0.f; x[3 + j] = QKFIRST[(size_t)(slab * 3 + j) * 1024 + chn]; }
    float y = cb[chn];
#pragma unroll
    for (int j = 0; j < 4; ++j) { const float xv = rr == 0 ? x[j] : (rr == 1 ? x[j + 1] : x[j + 2]); y += cw[j * 1024 + chn] * xv; }
    return y * sc / (1.0f + __expf(-y));
}
__device__ __forceinline__ void mlstm_naive_unit(Frame& F, const MixArgs& a, int b, int h) {
    LAS float* ql = (LAS float*)(F.lds); LAS float* kl = ql + 64 * 128; LAS float* vl = kl + 64 * 128;
    LAS float* fi = vl + 64 * 128; LAS float* ff = fi + 64; LAS float* red = ff + 64; LAS float* redd = red + 2 * 4 * 128;
    const int tid = F.tid, e = tid & 127, dq = tid >> 7;
    const size_t rowbase = (size_t)b * SEQ;
    float C[32], n[32];
#pragma unroll
    for (int i = 0; i < 32; ++i) { C[i] = 0.f; n[i] = 0.f; }
    for (int chunk = 0; chunk < SEQ / 64; ++chunk) {
        __syncthreads();
        for (int i = 0; i < 16; ++i) {
            const int idx = tid + 512 * i, t = idx >> 7, c = idx & 127, tt = chunk * 64 + t;
            if (t >= 3) { const bf16* pr = a.PROJ + (rowbase + tt) * NIN + h * 128 + c; ql[idx] = bf2f(pr[C_QM]); kl[idx] = bf2f(pr[C_KM]); }
            else { const int slab = b * 32 + chunk; ql[idx] = patch_qk(a.QKFIRST, a.QKLAST, a.cw, a.cb, slab, chunk > 0, t, h * 128 + c, 1.0f); kl[idx] = patch_qk(a.QKFIRST, a.QKLAST, a.cw, a.cb, slab, chunk > 0, t, 512 + h * 128 + c, 0.08838834764831845f); }
            vl[idx] = bf2f(a.PROJ[(rowbase + tt) * NIN + C_VM + h * 128 + c]);
        }
        if (tid < 64) { const size_t r = rowbase + chunk * 64 + tid; fi[tid] = __expf(a.GATES[r * 8 + h]); ff[tid] = __expf(a.GATES[r * 8 + 4 + h]); }
        __syncthreads();
        for (int t = 0; t < 64; ++t) {
            const float fg = ff[t], ig = fi[t], ve = vl[t * 128 + e];
            float acc = 0.f, dacc = 0.f;
#pragma unroll
            for (int dd = 0; dd < 32; ++dd) { const float kd = kl[t * 128 + dq * 32 + dd], qd = ql[t * 128 + dq * 32 + dd];
                C[dd] = fg * C[dd] + (ig * kd) * ve; acc += C[dd] * qd; n[dd] = fg * n[dd] + ig * kd; dacc += n[dd] * qd; }
            LAS float* rb = red + (t & 1) * 512; LAS float* rd = redd + (t & 1) * 4;
            rb[dq * 128 + e] = acc; if (e == 0) rd[dq] = dacc;
            __syncthreads();
            if (tid < 128) { const float num = (rb[e] + rb[128 + e]) + (rb[256 + e] + rb[384 + e]); const float den = (rd[0] + rd[1]) + (rd[2] + rd[3]);
                a.HRAW[(rowbase + chunk * 64 + t) * 512 + h * 128 + e] = num / fmaxf(fabsf(den), 1.0f); }
        }
    }
    VM_WAIT(); __syncthreads(); __builtin_amdgcn_fence(__ATOMIC_ACQUIRE, "agent"); VM_WAIT();
    for (int rr = F.wave; rr < SEQ; rr += NWAVES) {
        const size_t r = rowbase + rr;
        const float h0 = a.HRAW[r * 512 + h * 128 + F.lane], h1 = a.HRAW[r * 512 + h * 128 + 64 + F.lane];
        const float rstd = 1.0f / sqrtf(wave_sum(h0 * h0 + h1 * h1) * (1.f / 128.f) + EPS);
        const float o0 = sigmoidf_(bf2f(a.PROJ[r * NIN + C_OM + h * 128 + F.lane])), o1 = sigmoidf_(bf2f(a.PROJ[r * NIN + C_OM + h * 128 + 64 + F.lane]));
        a.MIXIN[r * D + h * 128 + F.lane] = (bf16)f2bf(o0 * h0 * rstd * a.mnorm[h * 128 + F.lane]);
        a.MIXIN[r * D + h * 128 + 64 + F.lane] = (bf16)f2bf(o1 * h1 * rstd * a.mnorm[h * 128 + 64 + F.lane]);
    }
}
__device__ __forceinline__ void sb_naive_unit(Frame& F, const MixArgs& a, int b, int h, int qblk) {
    LAS float* Kl = (LAS float*)(F.lds); LAS float* Vl = Kl + 64 * 64;
    const int tid = F.tid, t = qblk * 512 + tid;
    const size_t rowbase = (size_t)b * SEQ;
    float q[64], o[64], rem = 0.f;
    { const bf16* qp = a.PROJ + (rowbase + t) * NIN + C_QS + h * 64;
#pragma unroll
      for (int d = 0; d < 64; ++d) { q[d] = bf2f(qp[d]) * 0.6931471805599453f; o[d] = 0.f; } }
    for (int kt = qblk * 8 + 7; kt >= 0; --kt) {
        __syncthreads();
        for (int i = 0; i < 8; ++i) { const int idx = tid + 512 * i, s = idx >> 6, d = idx & 63; const bf16* pr = a.PROJ + (rowbase + kt * 64 + s) * NIN + h * 64 + d;
            Kl[idx] = bf2f(pr[C_KS]); Vl[idx] = bf2f(pr[C_VS]); }
        __syncthreads();
        if (kt * 64 < t) {
            for (int sl = 63; sl >= 0; --sl) {
                if (kt * 64 + sl < t) {
                    float z = 0.f;
#pragma unroll
                    for (int d4 = 0; d4 < 16; ++d4) { const f32x4 kv = ((const LAS f32x4*)(Kl + sl * 64))[d4]; z += (q[4 * d4] * kv.x + q[4 * d4 + 1] * kv.y) + (q[4 * d4 + 2] * kv.z + q[4 * d4 + 3] * kv.w); }
                    const float l = __logf(1.f + __expf(-fabsf(z)));
                    const float ls = fminf(z, 0.f) - l, l1 = fminf(-z, 0.f) - l;
                    const float at = __expf(ls + rem); rem += l1;
#pragma unroll
                    for (int d4 = 0; d4 < 16; ++d4) { const f32x4 vv = ((const LAS f32x4*)(Vl + sl * 64))[d4]; o[4 * d4] += at * vv.x; o[4 * d4 + 1] += at * vv.y; o[4 * d4 + 2] += at * vv.z; o[4 * d4 + 3] += at * vv.w; }
                }
            }
        }
    }
    GAS v4u* op = (GAS v4u*)(a.MIXIN + (rowbase + t) * D + 512 + h * 64);
#pragma unroll
    for (int i = 0; i < 8; ++i) { v4u w; w.x = pk2(o[8 * i], o[8 * i + 1]); w.y = pk2(o[8 * i + 2], o[8 * i + 3]); w.z = pk2(o[8 * i + 4], o[8 * i + 5]); w.w = pk2(o[8 * i + 6], o[8 * i + 7]); op[i] = w; }
}

typedef short v4i16_t __attribute__((ext_vector_type(4)));
typedef float f32x16 __attribute__((ext_vector_type(16)));
__device__ __forceinline__ v4i16_t tr16(const LAS unsigned char* p) { return __builtin_amdgcn_ds_read_tr16_b64_v4i16((LAS v4i16_t*)p); }
__device__ __forceinline__ bf16x8 cat8(v4i16_t a, v4i16_t b) { return (bf16x8){a[0], a[1], a[2], a[3], b[0], b[1], b[2], b[3]}; }
typedef float f32x2_t __attribute__((ext_vector_type(2))); typedef __bf16 bf16x2_t __attribute__((ext_vector_type(2)));
__device__ __forceinline__ unsigned cvtpk(float lo, float hi) { f32x2_t v = {lo, hi}; bf16x2_t b = __builtin_convertvector(v, bf16x2_t); return __builtin_bit_cast(unsigned, b); }
__device__ __forceinline__ bf16x8 pack8(const float* p) { v4u w; w.x = cvtpk(p[0], p[1]); w.y = cvtpk(p[2], p[3]); w.z = cvtpk(p[4], p[5]); w.w = cvtpk(p[6], p[7]); return __builtin_bit_cast(bf16x8, w); }
constexpr int SB_VRS = 192, SB_VBUF = 32 * SB_VRS;
__device__ __forceinline__ void sb_phase(Frame& F, const bf16* PROJ, bf16* MIXIN) {
    LAS unsigned char* vb = F.lds + RING_OFF + F.wave * (2 * SB_VBUF);
    const int lane = F.lane, tl = lane & 31, hh = lane >> 5;
    const int troff = (4 * hh + ((lane & 15) >> 2)) * SB_VRS + (16 * ((lane >> 4) & 1) + 4 * (lane & 3)) * 2;
    for (int bu = F.vcu; bu < 1024; bu += F.G) {
        const int bh = bu & 127, qi = (7 - (bu >> 7)) * 8 + F.wave, b = bh >> 3, h = bh & 7;
        const size_t rowbase = (size_t)b * SEQ;
        const bf16* kvbase = PROJ + rowbase * NIN + h * 64;
        bf16x8 qf[4], kf[4], kn[4]; v4u vr[4], vn[4];
        { const bf16* qp = kvbase + (size_t)(32 * qi + tl) * NIN + C_QS + 8 * hh;
#pragma unroll
          for (int s = 0; s < 4; ++s) qf[s] = *(const GAS bf16x8*)(qp + 16 * s); }
#define SB_LOADK(dst, kb) do { const bf16* kp_ = kvbase + (size_t)(32 * (kb) + tl) * NIN + C_KS + 8 * hh; _Pragma("unroll") for (int s = 0; s < 4; ++s) dst[s] = *(const GAS bf16x8*)(kp_ + 16 * s); } while (0)
#define SB_LOADV(dst, kb) do { _Pragma("unroll") for (int i = 0; i < 4; ++i) { const int idx_ = lane + 64 * i; dst[i] = *(const GAS v4u*)(kvbase + (size_t)(32 * (kb) + (idx_ >> 3)) * NIN + C_VS + 8 * (idx_ & 7)); } } while (0)
#define SB_WRITEV(buf, srcv) do { _Pragma("unroll") for (int i = 0; i < 4; ++i) { const int idx_ = lane + 64 * i; *(LAS v4u*)((buf) + (idx_ >> 3) * SB_VRS + 16 * (idx_ & 7)) = srcv[i]; } } while (0)
        SB_LOADK(kf, qi); SB_LOADV(vr, qi);
        SB_WRITEV(vb, vr);
        f32x16 o0, o1;
#pragma unroll
        for (int r = 0; r < 16; ++r) { o0[r] = 0.f; o1[r] = 0.f; }
        float carry = 1.f; int cur = 0;
        for (int kb = qi; kb >= 0; --kb) {
            if (kb > 0) { SB_LOADK(kn, kb - 1); SB_LOADV(vn, kb - 1); }
            f32x16 S;
#pragma unroll
            for (int r = 0; r < 16; ++r) S[r] = 0.f;
#pragma unroll
            for (int s = 0; s < 4; ++s) S = __builtin_amdgcn_mfma_f32_32x32x16_bf16(kf[s], qf[s], S, 0, 0, 0);
            float om[16], bt[16];
            const bool diag = (kb == qi);
#pragma unroll
            for (int r = 0; r < 16; ++r) {
                const float e = __builtin_amdgcn_exp2f(fminf(S[r], 100.f));
                float m_ = __builtin_amdgcn_rcpf(1.f + e), b_ = e * m_;
                if (diag) { const bool masked = ((r & 3) + 8 * (r >> 2) + 4 * hh) >= tl; m_ = masked ? 1.f : m_; b_ = masked ? 0.f : b_; }
                om[r] = m_; bt[r] = b_;
            }
            float xs[16], G[4], pG[4];
#pragma unroll
            for (int g = 0; g < 4; ++g) { xs[4 * g + 3] = 1.f; xs[4 * g + 2] = om[4 * g + 3]; xs[4 * g + 1] = xs[4 * g + 2] * om[4 * g + 2]; xs[4 * g] = xs[4 * g + 1] * om[4 * g + 1]; G[g] = xs[4 * g] * om[4 * g]; }
#pragma unroll
            for (int g = 0; g < 4; ++g) pG[g] = __shfl_xor(G[g], 32);
            float Sg[4]; Sg[3] = carry; Sg[2] = Sg[3] * (G[3] * pG[3]); Sg[1] = Sg[2] * (G[2] * pG[2]); Sg[0] = Sg[1] * (G[1] * pG[1]); carry = Sg[0] * (G[0] * pG[0]);
            float P[16];
#pragma unroll
            for (int g = 0; g < 4; ++g) { const float off = hh ? Sg[g] : Sg[g] * pG[g];
#pragma unroll
                for (int j = 0; j < 4; ++j) P[4 * g + j] = bt[4 * g + j] * (xs[4 * g + j] * off); }
            const bf16x8 pb0 = pack8(P), pb1 = pack8(P + 8);
            const LAS unsigned char* vbase = vb + cur * SB_VBUF + troff;
            { const bf16x8 a00 = cat8(tr16(vbase), tr16(vbase + 8 * SB_VRS)), a01 = cat8(tr16(vbase + 64), tr16(vbase + 8 * SB_VRS + 64));
              const bf16x8 a10 = cat8(tr16(vbase + 16 * SB_VRS), tr16(vbase + 24 * SB_VRS)), a11 = cat8(tr16(vbase + 16 * SB_VRS + 64), tr16(vbase + 24 * SB_VRS + 64));
              o0 = __builtin_amdgcn_mfma_f32_32x32x16_bf16(a00, pb0, o0, 0, 0, 0); o1 = __builtin_amdgcn_mfma_f32_32x32x16_bf16(a01, pb0, o1, 0, 0, 0);
              o0 = __builtin_amdgcn_mfma_f32_32x32x16_bf16(a10, pb1, o0, 0, 0, 0); o1 = __builtin_amdgcn_mfma_f32_32x32x16_bf16(a11, pb1, o1, 0, 0, 0); }
            if (__all(carry < 7.888609052210118e-31f)) break;
            if (kb > 0) { SB_WRITEV(vb + (cur ^ 1) * SB_VBUF, vn);
#pragma unroll
                for (int s = 0; s < 4; ++s) kf[s] = kn[s];
                cur ^= 1; }
        }
#undef SB_LOADK
#undef SB_LOADV
#undef SB_WRITEV
        bf16* orow = MIXIN + (rowbase + 32 * qi + tl) * D + 512 + h * 64 + 4 * hh;
#pragma unroll
        for (int g = 0; g < 4; ++g) {
            *(GAS unsigned long long*)(orow + 8 * g) = (unsigned long long)cvtpk(o0[4 * g], o0[4 * g + 1]) | ((unsigned long long)cvtpk(o0[4 * g + 2], o0[4 * g + 3]) << 32);
            *(GAS unsigned long long*)(orow + 32 + 8 * g) = (unsigned long long)cvtpk(o1[4 * g], o1[4 * g + 1]) | ((unsigned long long)cvtpk(o1[4 * g + 2], o1[4 * g + 3]) << 32);
        }
    }
}

constexpr int ML_RST = 320, ML_RSR = 272;
__device__ __forceinline__ void ml_pass_a(Frame& F, const MixArgs& a) {
    LAS unsigned char* Kl = F.lds + RING_OFF; LAS unsigned char* Vw = Kl + 64 * ML_RST; LAS float* wk = (LAS float*)(Vw + 64 * ML_RST);
    const int tid = F.tid, lane = F.lane, w = F.wave, hh = lane >> 5;
    const int tro = (8 * hh + ((lane & 15) >> 2)) * ML_RST + (16 * ((lane >> 4) & 1) + 4 * (lane & 3)) * 2;
    for (int u = F.vcu; u < 2048; u += F.G) {
        const int bh = u >> 5, c = u & 31, b = bh >> 2, h = bh & 3;
        if (c == 31) continue;
        const size_t row0 = (size_t)b * SEQ + 64 * c;
        __syncthreads();
        if (w == 0) {
            const float lf = a.GATES[(row0 + lane) * 8 + 4 + h], li = a.GATES[(row0 + lane) * 8 + h];
            float bc = lf;
#pragma unroll
            for (int o = 1; o < 64; o <<= 1) { const float t_ = __shfl_up(bc, o); if (lane >= o) bc += t_; }
            const float av = li - bc; float mx = av;
#pragma unroll
            for (int o = 1; o < 64; o <<= 1) mx = fmaxf(mx, __shfl_xor(mx, o));
            wk[lane] = __expf(av - mx);
            if (lane == 63) { a.SCAL[2 * u] = bc; a.SCAL[2 * u + 1] = mx; }
        }
#pragma unroll
        for (int i = 0; i < 2; ++i) { const int idx = tid + 512 * i, s = idx >> 4, ch = idx & 15;
            if (s >= 3) *(LAS v4u*)(Kl + s * ML_RST + ch * 16) = *(const GAS v4u*)(a.PROJ + (row0 + s) * NIN + C_KM + h * 128 + ch * 8); }
        if (tid < 384) { const int rr = tid >> 7, d = tid & 127;
            *(LAS bf16*)(Kl + rr * ML_RST + d * 2) = (bf16)f2bf(patch_qk(a.QKFIRST, a.QKLAST, a.cw, a.cb, b * 32 + c, c > 0, rr, 512 + h * 128 + d, 0.08838834764831845f)); }
        __syncthreads();
#pragma unroll
        for (int i = 0; i < 2; ++i) { const int idx = tid + 512 * i, s = idx >> 4, ch = idx & 15;
            const v4u raw = *(const GAS v4u*)(a.PROJ + (row0 + s) * NIN + C_VM + h * 128 + ch * 8); const float ws = wk[s]; v4u o;
            o.x = pk2(__uint_as_float(raw.x << 16) * ws, __uint_as_float(raw.x & 0xffff0000u) * ws); o.y = pk2(__uint_as_float(raw.y << 16) * ws, __uint_as_float(raw.y & 0xffff0000u) * ws);
            o.z = pk2(__uint_as_float(raw.z << 16) * ws, __uint_as_float(raw.z & 0xffff0000u) * ws); o.w = pk2(__uint_as_float(raw.w << 16) * ws, __uint_as_float(raw.w & 0xffff0000u) * ws);
            *(LAS v4u*)(Vw + s * ML_RST + ch * 16) = o; }
        __syncthreads();
        if (tid < 128) { float acc = 0.f;
            for (int s = 0; s < 64; ++s) acc += wk[s] * bf2f(*(const LAS bf16*)(Kl + s * ML_RST + tid * 2));
            a.DN[(size_t)u * 128 + tid] = acc; }
        const int dt = w >> 1, et0 = 2 * (w & 1);
        f32x16 c0, c1;
#pragma unroll
        for (int r = 0; r < 16; ++r) { c0[r] = 0.f; c1[r] = 0.f; }
#pragma unroll
        for (int kk = 0; kk < 4; ++kk) {
            const LAS unsigned char* ka = Kl + tro + 16 * kk * ML_RST + dt * 64; const LAS unsigned char* va = Vw + tro + 16 * kk * ML_RST + et0 * 64;
            const bf16x8 A = cat8(tr16(ka), tr16(ka + 4 * ML_RST)), B0 = cat8(tr16(va), tr16(va + 4 * ML_RST)), B1 = cat8(tr16(va + 64), tr16(va + 4 * ML_RST + 64));
            c0 = __builtin_amdgcn_mfma_f32_32x32x16_bf16(A, B0, c0, 0, 0, 0); c1 = __builtin_amdgcn_mfma_f32_32x32x16_bf16(A, B1, c1, 0, 0, 0);
        }
        bf16* dcu = a.DC + (size_t)u * 16384;
#pragma unroll
        for (int g = 0; g < 4; ++g) {
            const int fo0 = (((et0 * 8 + 2 * dt + (g >> 1)) * 64) + (lane & 31) + 32 * (g & 1)) * 8 + 4 * hh, fo1 = fo0 + 8 * 64 * 8;
            *(GAS unsigned long long*)(dcu + fo0) = (unsigned long long)cvtpk(c0[4 * g], c0[4 * g + 1]) | ((unsigned long long)cvtpk(c0[4 * g + 2], c0[4 * g + 3]) << 32);
            *(GAS unsigned long long*)(dcu + fo1) = (unsigned long long)cvtpk(c1[4 * g], c1[4 * g + 1]) | ((unsigned long long)cvtpk(c1[4 * g + 2], c1[4 * g + 3]) << 32);
        }
    }
}
__device__ __forceinline__ void ml_pass_b(Frame& F, const MixArgs& a) {
    LAS float* scl = (LAS float*)(F.lds + RING_OFF);
    const int tid = F.tid;
    for (int u = F.vcu; u < 256; u += F.G) {
        const int bh = u >> 2, qtr = u & 3;
        __syncthreads();
        if (tid < 64) scl[tid] = a.SCAL[(size_t)bh * 64 + tid];
        __syncthreads();
        const size_t base = (size_t)bh * 32 * 16384 + qtr * 4096 + tid * 8;
        float C[8], nv = 0.f, ms = 0.f;
#pragma unroll
        for (int i = 0; i < 8; ++i) C[i] = 0.f;
        v4u ring[8];
#pragma unroll
        for (int i = 0; i < 8; ++i) ring[i] = *(const GAS v4u*)(a.DC + base + (size_t)i * 16384);
#pragma unroll
        for (int c = 0; c < 32; ++c) {
            v4u o; o.x = pk2(C[0], C[1]); o.y = pk2(C[2], C[3]); o.z = pk2(C[4], C[5]); o.w = pk2(C[6], C[7]);
            *(GAS v4u*)(a.CS + base + (size_t)c * 16384) = o;
            if (tid < 32) a.NS[(size_t)(bh * 32 + c) * 128 + qtr * 32 + tid] = nv;
            if (qtr == 0 && tid == 0) a.MS[bh * 32 + c] = ms;
            if (c < 31) {
                const float bl = scl[2 * c], pm = scl[2 * c + 1], M = fmaxf(pm, ms), sc = __expf(pm - M), dec = __expf(ms - M);
                ms = bl + M;
                const v4u d = ring[c & 7];
                if (c + 8 < 31) ring[c & 7] = *(const GAS v4u*)(a.DC + base + (size_t)(c + 8) * 16384);
                C[0] = dec * C[0] + sc * __uint_as_float(d.x << 16); C[1] = dec * C[1] + sc * __uint_as_float(d.x & 0xffff0000u);
                C[2] = dec * C[2] + sc * __uint_as_float(d.y << 16); C[3] = dec * C[3] + sc * __uint_as_float(d.y & 0xffff0000u);
                C[4] = dec * C[4] + sc * __uint_as_float(d.z << 16); C[5] = dec * C[5] + sc * __uint_as_float(d.z & 0xffff0000u);
                C[6] = dec * C[6] + sc * __uint_as_float(d.w << 16); C[7] = dec * C[7] + sc * __uint_as_float(d.w & 0xffff0000u);
                if (tid < 32) nv = dec * nv + sc * a.DN[(size_t)(bh * 32 + c) * 128 + qtr * 32 + tid];
            }
        }
    }
}
__device__ __forceinline__ void ml_pass_c(Frame& F, const MixArgs& a) {
    LAS unsigned char* Ql = F.lds + RING_OFF; LAS unsigned char* Kl = Ql + 64 * ML_RSR; LAS unsigned char* Vl = Kl + 64 * ML_RSR;
    LAS float* al = (LAS float*)(Vl + 64 * ML_RST); LAS float* Ml = al + 64; LAS float* wil = Ml + 64; LAS float* enm = wil + 64; LAS float* nl = enm + 64; LAS float* ssq = nl + 128;
    const int tid = F.tid, lane = F.lane, w = F.wave, hh = lane >> 5, tl = lane & 31;
    const int et = w & 3, tt = w >> 2, t = 32 * tt + tl;
    for (int u = F.vcu; u < 2048; u += F.G) {
        const int bh = u >> 5, c = u & 31, b = bh >> 2, h = bh & 3;
        const size_t row0 = (size_t)b * SEQ + 64 * c;
        __syncthreads();
        bf16x8 cf[8];
#pragma unroll
        for (int kk = 0; kk < 8; ++kk) cf[kk] = *(const GAS bf16x8*)(a.CS + (size_t)u * 16384 + ((et * 8 + kk) * 64 + lane) * 8);
        if (w == 0) {
            const float lf = a.GATES[(row0 + lane) * 8 + 4 + h], li = a.GATES[(row0 + lane) * 8 + h];
            float bc = lf;
#pragma unroll
            for (int o = 1; o < 64; o <<= 1) { const float t_ = __shfl_up(bc, o); if (lane >= o) bc += t_; }
            const float av = li - bc; float pm = av;
#pragma unroll
            for (int o = 1; o < 64; o <<= 1) { const float t_ = __shfl_up(pm, o); if (lane >= o) pm = fmaxf(pm, t_); }
            const float ms = a.MS[u], M = fmaxf(pm, ms);
            al[lane] = av; Ml[lane] = M; wil[lane] = __expf(ms - M); enm[lane] = __expf(-bc - M);
        }
        if (w == 1) { nl[lane] = a.NS[(size_t)u * 128 + lane]; nl[64 + lane] = a.NS[(size_t)u * 128 + 64 + lane]; }
#pragma unroll
        for (int i = 0; i < 2; ++i) { const int idx = tid + 512 * i, s = idx >> 4, ch = idx & 15; const bf16* pr = a.PROJ + (row0 + s) * NIN + h * 128 + ch * 8;
            if (s >= 3) { *(LAS v4u*)(Ql + s * ML_RSR + ch * 16) = *(const GAS v4u*)(pr + C_QM); *(LAS v4u*)(Kl + s * ML_RSR + ch * 16) = *(const GAS v4u*)(pr + C_KM); }
            *(LAS v4u*)(Vl + s * ML_RST + ch * 16) = *(const GAS v4u*)(pr + C_VM); }
        if (tid < 384) { const int rr = tid >> 7, d = tid & 127;
            *(LAS bf16*)(Ql + rr * ML_RSR + d * 2) = (bf16)f2bf(patch_qk(a.QKFIRST, a.QKLAST, a.cw, a.cb, b * 32 + c, c > 0, rr, h * 128 + d, 1.0f));
            *(LAS bf16*)(Kl + rr * ML_RSR + d * 2) = (bf16)f2bf(patch_qk(a.QKFIRST, a.QKLAST, a.cw, a.cb, b * 32 + c, c > 0, rr, 512 + h * 128 + d, 0.08838834764831845f)); }
        __syncthreads();
        bf16x8 qf[8];
#pragma unroll
        for (int kk = 0; kk < 8; ++kk) qf[kk] = *(const LAS bf16x8*)(Ql + t * ML_RSR + (16 * kk + 8 * hh) * 2);
        float qn = 0.f;
#pragma unroll
        for (int kk = 0; kk < 8; ++kk) { const f32x4 n0 = *(const LAS f32x4*)(nl + 16 * kk + 8 * hh), n1 = *(const LAS f32x4*)(nl + 16 * kk + 8 * hh + 4);
            qn += bf2f((bf16)qf[kk][0]) * n0.x + bf2f((bf16)qf[kk][1]) * n0.y + bf2f((bf16)qf[kk][2]) * n0.z + bf2f((bf16)qf[kk][3]) * n0.w
                + bf2f((bf16)qf[kk][4]) * n1.x + bf2f((bf16)qf[kk][5]) * n1.y + bf2f((bf16)qf[kk][6]) * n1.z + bf2f((bf16)qf[kk][7]) * n1.w; }
        qn += __shfl_xor(qn, 32);
        const float Mt = Ml[t], wi = wil[t];
        f32x16 numI; float dsum = 0.f;
#pragma unroll
        for (int r = 0; r < 16; ++r) numI[r] = 0.f;
        const int trq = (4 * hh + ((lane & 15) >> 2)) * ML_RST + (32 * et + 16 * ((lane >> 4) & 1) + 4 * (lane & 3)) * 2;
        for (int st = 0; st <= tt; ++st) {
            f32x16 S;
#pragma unroll
            for (int r = 0; r < 16; ++r) S[r] = 0.f;
#pragma unroll
            for (int kk = 0; kk < 8; ++kk) { const bf16x8 kfr = *(const LAS bf16x8*)(Kl + (32 * st + tl) * ML_RSR + (16 * kk + 8 * hh) * 2); S = __builtin_amdgcn_mfma_f32_32x32x16_bf16(kfr, qf[kk], S, 0, 0, 0); }
            float P[16];
            const bool diag = (st == tt);
#pragma unroll
            for (int g = 0; g < 4; ++g) { const f32x4 a4 = *(const LAS f32x4*)(al + 32 * st + 8 * g + 4 * hh);
#pragma unroll
                for (int j = 0; j < 4; ++j) { float p = S[4 * g + j] * __expf(a4[j] - Mt); if (diag && (8 * g + 4 * hh + j) > tl) p = 0.f; P[4 * g + j] = p; dsum += p; } }
            const bf16x8 pb0 = pack8(P), pb1 = pack8(P + 8);
            const LAS unsigned char* tv = Vl + 32 * st * ML_RST + trq;
            const bf16x8 A0 = cat8(tr16(tv), tr16(tv + 8 * ML_RST)), A1 = cat8(tr16(tv + 16 * ML_RST), tr16(tv + 24 * ML_RST));
            numI = __builtin_amdgcn_mfma_f32_32x32x16_bf16(A0, pb0, numI, 0, 0, 0); numI = __builtin_amdgcn_mfma_f32_32x32x16_bf16(A1, pb1, numI, 0, 0, 0);
        }
        dsum += __shfl_xor(dsum, 32);
        f32x16 qc;
#pragma unroll
        for (int r = 0; r < 16; ++r) qc[r] = 0.f;
#pragma unroll
        for (int kk = 0; kk < 8; ++kk) qc = __builtin_amdgcn_mfma_f32_32x32x16_bf16(cf[kk], qf[kk], qc, 0, 0, 0);
        const float den = dsum + wi * qn, rdn = 1.0f / fmaxf(fabsf(den), enm[t]);
        float hv[16], ss = 0.f;
#pragma unroll
        for (int r = 0; r < 16; ++r) { hv[r] = (numI[r] + wi * qc[r]) * rdn; ss += hv[r] * hv[r]; }
        ss += __shfl_xor(ss, 32);
        if (hh == 0) ssq[et * 64 + t] = ss;
        __syncthreads();
        const float rstd = 1.0f / sqrtf(((ssq[t] + ssq[64 + t]) + (ssq[128 + t] + ssq[192 + t])) * (1.f / 128.f) + EPS);
#pragma unroll
        for (int g = 0; g < 4; ++g) { const int e = h * 128 + 32 * et + 8 * g + 4 * hh;
            const unsigned long long ogw = *(const GAS unsigned long long*)(a.PROJ + (row0 + t) * NIN + C_OM + e); const unsigned lo = (unsigned)ogw, hi = (unsigned)(ogw >> 32);
            const f32x4 mn = *(const GAS f32x4*)(a.mnorm + e);
            const float o0 = sigmoidf_(__uint_as_float(lo << 16)) * hv[4 * g] * rstd * mn.x, o1 = sigmoidf_(__uint_as_float(lo & 0xffff0000u)) * hv[4 * g + 1] * rstd * mn.y;
            const float o2 = sigmoidf_(__uint_as_float(hi << 16)) * hv[4 * g + 2] * rstd * mn.z, o3 = sigmoidf_(__uint_as_float(hi & 0xffff0000u)) * hv[4 * g + 3] * rstd * mn.w;
            *(GAS unsigned long long*)(a.MIXIN + (row0 + t) * D + e) = (unsigned long long)cvtpk(o0, o1) | ((unsigned long long)cvtpk(o2, o3) << 32); }
    }
}
__device__ __forceinline__ void p2_mixers_naive(Frame& F, const MixArgs& a) {
    const int bx = blockIdx.x;
    if (bx < 64) { mlstm_naive_unit(F, a, bx >> 2, bx & 3); __syncthreads(); }
#if defined(MK_SB_NAIVE)
    else { for (int u = bx - 64; u < 512; u += (F.G - 64)) { const int qblk = 3 - (u >> 7), bh = u & 127; sb_naive_unit(F, a, bh >> 3, bh & 7, qblk); } }
#else
    sb_phase(F, a.PROJ, a.MIXIN);
#endif
}

__device__ __forceinline__ void ld_bf16_row16(const bf16* row, int lane, f32x4 (&v)[4]) {
    const GAS unsigned long long* p = (const GAS unsigned long long*)row + lane;
#pragma unroll
    for (int j = 0; j < 4; ++j) { const unsigned long long w = p[64 * j]; const unsigned lo = (unsigned)w, hi = (unsigned)(w >> 32);
        v[j] = (f32x4){__uint_as_float(lo << 16), __uint_as_float(lo & 0xffff0000u), __uint_as_float(hi << 16), __uint_as_float(hi & 0xffff0000u)}; }
}
__device__ __forceinline__ float sumsq16(const f32x4 (&v)[4]) { float s = 0.f;
#pragma unroll
    for (int j = 0; j < 4; ++j) s += (v[j].x * v[j].x + v[j].y * v[j].y) + (v[j].z * v[j].z + v[j].w * v[j].w);
    return s; }
__device__ __forceinline__ void p3b_rows(Frame& F, const float* x, const bf16* MIX, const float* g1, const float* g2, float* out, bf16* H) {
    const int gw = F.vcu * NWAVES + F.wave, NGW = F.G * NWAVES;
    f32x4 ga[4], gb[4];
#pragma unroll
    for (int j = 0; j < 4; ++j) { ga[j] = ((const GAS f32x4*)g1)[64 * j + F.lane]; gb[j] = ((const GAS f32x4*)g2)[64 * j + F.lane]; }
    for (int m = gw; m < T; m += NGW) {
        f32x4 mv[4], xv[4]; ld_bf16_row16(MIX + (size_t)m * D, F.lane, mv);
        const GAS f32x4* xr = (const GAS f32x4*)(x + (size_t)m * D) + F.lane;
#pragma unroll
        for (int j = 0; j < 4; ++j) xv[j] = xr[64 * j];
        const float r1 = 1.0f / sqrtf(wave_sum(sumsq16(mv)) * (1.f / D) + EPS);
#pragma unroll
        for (int j = 0; j < 4; ++j) xv[j] = xv[j] + mv[j] * r1 * ga[j];
        GAS f32x4* orow = (GAS f32x4*)(out + (size_t)m * D) + F.lane;
#pragma unroll
        for (int j = 0; j < 4; ++j) orow[64 * j] = xv[j];
        const float r2 = 1.0f / sqrtf(wave_sum(sumsq16(xv)) * (1.f / D) + EPS);
        GAS unsigned long long* o8 = (GAS unsigned long long*)(H + (size_t)m * D) + F.lane;
#pragma unroll
        for (int j = 0; j < 4; ++j) { const f32x4 hv = xv[j] * r2 * gb[j]; o8[64 * j] = (unsigned long long)pk2(hv.x, hv.y) | ((unsigned long long)pk2(hv.z, hv.w) << 32); }
    }
}
__device__ __forceinline__ void p6_rows(Frame& F, const bf16* Y, const float* g3, float* out) {
    const int gw = F.vcu * NWAVES + F.wave, NGW = F.G * NWAVES;
    f32x4 ga[4];
#pragma unroll
    for (int j = 0; j < 4; ++j) ga[j] = ((const GAS f32x4*)g3)[64 * j + F.lane];
    for (int m = gw; m < T; m += NGW) {
        f32x4 yv[4]; ld_bf16_row16(Y + (size_t)m * D, F.lane, yv);
        GAS f32x4* orow = (GAS f32x4*)(out + (size_t)m * D) + F.lane;
        f32x4 xv[4];
#pragma unroll
        for (int j = 0; j < 4; ++j) xv[j] = orow[64 * j];
        const float r1 = 1.0f / sqrtf(wave_sum(sumsq16(yv)) * (1.f / D) + EPS);
#pragma unroll
        for (int j = 0; j < 4; ++j) orow[64 * j] = xv[j] + yv[j] * r1 * ga[j];
    }
}
__device__ __forceinline__ void p4b_fixup(Frame& F, const float* cw, const float* cb, const float* GFIRST, const float* GLAST, const float* UFIRST, bf16* ACT) {
    constexpr int C4 = DFF / 4, TOTAL = 512 * 2 * C4;
    for (int it = F.vcu * NWAVES * 64 + F.tid; it < TOTAL; it += F.G * NWAVES * 64) {
        const int c4 = it % C4, rs = it / C4, rr = rs & 1, s = rs >> 1; const bool first = (s & 31) == 0;
        const f32x4 z4 = {0.f, 0.f, 0.f, 0.f};
        const f32x4 g0 = *(const GAS f32x4*)(GFIRST + (size_t)(s * 2 + rr) * DFF + 4 * c4);
        f32x4 gm1, gm2;
        if (rr == 0) { gm1 = first ? z4 : *(const GAS f32x4*)(GLAST + (size_t)((s - 1) * 2 + 1) * DFF + 4 * c4); gm2 = first ? z4 : *(const GAS f32x4*)(GLAST + (size_t)((s - 1) * 2 + 0) * DFF + 4 * c4); }
        else { gm1 = *(const GAS f32x4*)(GFIRST + (size_t)(s * 2 + 0) * DFF + 4 * c4); gm2 = first ? z4 : *(const GAS f32x4*)(GLAST + (size_t)((s - 1) * 2 + 1) * DFF + 4 * c4); }
        const f32x4 w0 = *(const GAS f32x4*)(cw + 4 * c4), w1 = *(const GAS f32x4*)(cw + DFF + 4 * c4), w2 = *(const GAS f32x4*)(cw + 2 * DFF + 4 * c4), bb = *(const GAS f32x4*)(cb + 4 * c4);
        const f32x4 uu = *(const GAS f32x4*)(UFIRST + (size_t)(s * 2 + rr) * DFF + 4 * c4);
        const f32x4 cv = w2 * g0 + w1 * gm1 + w0 * gm2 + bb;
        const float a0 = pg8::gelu_tanh(cv.x) * uu.x, a1 = pg8::gelu_tanh(cv.y) * uu.y, a2 = pg8::gelu_tanh(cv.z) * uu.z, a3 = pg8::gelu_tanh(cv.w) * uu.w;
        *(GAS unsigned long long*)(ACT + (size_t)(64 * s + rr) * DFF + 4 * c4) = (unsigned long long)pk2(a0, a1) | ((unsigned long long)pk2(a2, a3) << 32);
    }
}

struct Args { const float* in[16]; float* out; unsigned char* ws; int ph_lo, ph_hi; };
constexpr int N_PHASES = 9;
__global__ void __launch_bounds__(NWAVES * 64, 2) mega_fwd(Args args) {
    extern __shared__ __attribute__((aligned(16))) unsigned char lds[];
    Frame F;
    F.lds = (LAS unsigned char*)lds;
    F.MISC = (volatile LAS unsigned*)(F.lds + MISC_OFF);
    F.tid = threadIdx.x; F.lane = F.tid & 63; F.wave = __builtin_amdgcn_readfirstlane(F.tid >> 6);
    F.G = gridDim.x; { const int bx = blockIdx.x; F.vcu = (F.G % 8 == 0) ? (bx % 8) * (F.G / 8) + bx / 8 : bx; }
    unsigned char* ws = args.ws;
    F.ctl = (gu32*)(ws + WS_CTL);
    const float* x = args.in[0]; const float* g_pre = args.in[1]; const float* w_in = args.in[2]; const float* mconv_w = args.in[3]; const float* mconv_b = args.in[4];
    const float* b_i = args.in[5]; const float* b_f = args.in[6]; const float* mnorm = args.in[7]; const float* w_out = args.in[8]; const float* g_postmix = args.in[9];
    const float* g_preffn = args.in[10]; const float* w_up = args.in[11]; const float* fconv_w = args.in[12]; const float* fconv_b = args.in[13]; const float* w_down = args.in[14];
    const float* g_postffn = args.in[15];
    bf16* WT_IN = (bf16*)(ws + WS_WIN); bf16* WT_OUT = (bf16*)(ws + WS_WOUT); bf16* WT_UP = (bf16*)(ws + WS_WUP); bf16* WT_DN = (bf16*)(ws + WS_WDN);
    float* GATES = (float*)(ws + WS_GATES); bf16* H = (bf16*)(ws + WS_H); bf16* PROJ = (bf16*)(ws + WS_PROJ); bf16* MIXIN = (bf16*)(ws + WS_MIXIN); bf16* MIX = (bf16*)(ws + WS_MIX);
    float* QKFIRST = (float*)(ws + WS_QKFIRST); float* QKLAST = (float*)(ws + WS_QKLAST); float* DN = (float*)(ws + WS_DN); float* NS = (float*)(ws + WS_NS); float* SCAL = (float*)(ws + WS_SCAL); float* MS = (float*)(ws + WS_MS);
    bf16* ACT = (bf16*)(ws + WS_ACT); float* GFIRST = (float*)(ws + WS_GFIRST); float* GLAST = (float*)(ws + WS_GLAST); float* UFIRST = (float*)(ws + WS_UFIRST); bf16* Y = (bf16*)(ws + WS_Y);
    for (int u = F.tid; u < (LDS_BYTES - LDSCTL_OFF) / 4; u += NWAVES * 64) ((LAS unsigned*)(F.lds + LDSCTL_OFF))[u] = 0u;
    __syncthreads();
    XcdBarrier bar = xcd_barrier_post((unsigned*)(F.ctl + CW_BAR), F.MISC + 8);
    const int lo = args.ph_lo, hi = args.ph_hi;
#define IN(k) (lo <= (k) && (k) < hi)
#define SEAM(k) do { if (IN(k) && IN((k) + 1)) xcd_barrier(bar); } while (0)

    if (IN(0)) { const P0Args a{x, g_pre, w_in, b_i, b_f, w_out, w_up, w_down, WT_IN, WT_OUT, WT_UP, WT_DN, H, GATES}; p0_prologue(F, a); }
    SEAM(0);
    if (IN(1)) { pg8::Gemm g{H, WT_IN, T, NIN, D}; pg8::StaticOrder S; S.init(T, NIN, F.G, (int)blockIdx.x);
        pg8::EpiProj E{PROJ, mconv_w, mconv_b, QKFIRST, QKLAST};
        pg8::gemm_phase<pg8::EpiProj, pg8::StaticOrder, true, true>(F.lds + RING_OFF, g, S, E); }
    SEAM(1);
    {
        const MixArgs a{PROJ, GATES, mconv_w, mconv_b, mnorm, args.out, MIXIN, QKFIRST, QKLAST, (bf16*)args.out, (bf16*)args.out + (size_t)2048 * 16384, DN, NS, SCAL, MS};
#if defined(MK_MLSTM_NAIVE)
        if (IN(2)) p2_mixers_naive(F, a);
#else
        if (IN(2)) { ml_pass_a(F, a); xcd_barrier(bar); ml_pass_b(F, a); __syncthreads(); sb_phase(F, a.PROJ, a.MIXIN); xcd_barrier(bar); ml_pass_c(F, a); }
#endif
    }
    SEAM(2);
    if (IN(3)) { pg8::Gemm g{MIXIN, WT_OUT, T, D, D}; pg8::StaticOrder S; S.init(T, D, F.G, (int)blockIdx.x);
        pg8::EpiBf16<0> E{MIX, D, nullptr, 0, 0, 1.f};
        pg8::gemm_phase<pg8::EpiBf16<0>, pg8::StaticOrder, true, true>(F.lds + RING_OFF, g, S, E); }
    SEAM(3);
    if (IN(4)) p3b_rows(F, x, MIX, g_postmix, g_preffn, args.out, H);
    SEAM(4);
    if (IN(5)) { pg8::Gemm g{H, WT_UP, T, NUP, D}; pg8::StaticOrder S; S.init(T, NUP, F.G, (int)blockIdx.x);
        pg8::EpiGateUp E{ACT, fconv_w, fconv_b, GFIRST, GLAST, UFIRST};
        pg8::gemm_phase<pg8::EpiGateUp, pg8::StaticOrder, true, true>(F.lds + RING_OFF, g, S, E); }
    SEAM(5);
    if (IN(6)) p4b_fixup(F, fconv_w, fconv_b, GFIRST, GLAST, UFIRST, ACT);
    SEAM(6);
    if (IN(7)) { pg8::Gemm g{ACT, WT_DN, T, D, DFF}; pg8::StaticOrder S; S.init(T, D, F.G, (int)blockIdx.x);
        pg8::EpiBf16<0> E{Y, D, nullptr, 0, 0, 1.f};
        pg8::gemm_phase<pg8::EpiBf16<0>, pg8::StaticOrder, true, true>(F.lds + RING_OFF, g, S, E); }
    SEAM(7);
    if (IN(8)) p6_rows(F, Y, g_postffn, args.out);
#undef IN
#undef SEAM
}
}

#ifndef MK_N_LAUNCHES
#define MK_N_LAUNCHES 1
#endif
extern "C" void kernel_launch(void* const* d_in, const int* in_sizes, int n_in, void* d_out, int out_size, void* d_ws, size_t ws_size, hipStream_t stream) {
    using namespace mk;
    static int grid = 0;
    if (grid == 0) {
        if (n_in != 16 || in_sizes[0] != T * D || out_size != T * D || ws_size < WS_END) { fprintf(stderr, "kernel_launch: unexpected shapes / workspace (n_in %d, ws %zu); nothing launched\n", n_in, ws_size); grid = -1; return; }
        int dev = 0, cus = 0, per_cu = 0;
        if (hipGetDevice(&dev) != hipSuccess || hipDeviceGetAttribute(&cus, hipDeviceAttributeMultiprocessorCount, dev) != hipSuccess) { grid = -1; return; }
        if (hipFuncSetAttribute((const void*)mega_fwd, hipFuncAttributeMaxDynamicSharedMemorySize, LDS_BYTES) != hipSuccess) { fprintf(stderr, "kernel_launch: hipFuncSetAttribute failed\n"); grid = -1; return; }
        if (hipOccupancyMaxActiveBlocksPerMultiprocessor(&per_cu, (const void*)mega_fwd, NWAVES * 64, LDS_BYTES) != hipSuccess || per_cu < 1) { fprintf(stderr, "kernel_launch: occupancy query says %d blocks per CU\n", per_cu); (void)hipGetLastError(); grid = -1; return; }
        grid = cus;
    }
    if (grid < 0) return;
    if (hipMemsetAsync((char*)d_ws + WS_CTL, 0, CTL_ZERO_BYTES, stream) != hipSuccess) return;
    Args a{};
    for (int i = 0; i < 16; ++i) a.in[i] = (const float*)d_in[i];
    a.out = (float*)d_out; a.ws = (unsigned char*)d_ws;
#if MK_N_LAUNCHES == 1
    a.ph_lo = 0; a.ph_hi = N_PHASES;
    hipLaunchKernelGGL(mega_fwd, dim3(grid), dim3(NWAVES * 64), LDS_BYTES, stream, a);
#else
    for (int p = 0; p < N_PHASES; ++p) { a.ph_lo = p; a.ph_hi = p + 1; hipLaunchKernelGGL(mega_fwd, dim3(grid), dim3(NWAVES * 64), LDS_BYTES, stream, a); }
#endif
}
```

```cpp
#include <hip/hip_runtime.h>
#include <cstdio>
#include <cstdint>
namespace pg8 {
#define PG8_LAS __attribute__((address_space(3)))
typedef unsigned short bf16_t;
typedef short bf16x8 __attribute__((ext_vector_type(8)));
typedef float f32x4 __attribute__((ext_vector_type(4)));
typedef unsigned u32x4 __attribute__((ext_vector_type(4)));
constexpr int BM = 256, BK = 64, HALF = 128, HTB = HALF * BK * 2  , STAGE_BYTES = 8 * HTB, NXCD = 8, WGM = 8;

__host__ __device__ __forceinline__ int lds_byte(int r, int c) { const int st = (r >> 4) * 2 + (c >> 5), rr = r & 15, cc = c & 31, ob = rr * 64 + cc * 2; return st * 1024 + (ob ^ (((ob >> 9) & 1) << 5)); }
__host__ __device__ __forceinline__ void stage_rc(int b, int& R, int& C) { const int st = b / 1024, sb = b % 1024, swz = sb ^ (((sb >> 9) & 1) << 5); R = (st >> 1) * 16 + swz / 64; C = (st & 1) * 32 + (swz % 64) / 2; }
__host__ __device__ __forceinline__ int perm32(int rho) { const int n = rho >> 4, i = rho & 15; return 8 * (i >> 2) + 4 * n + (i & 3); }

struct Unit { int pm, pn; };
struct Gemm { const bf16_t* A; const bf16_t* Bt; int M, N, K; };

struct StaticOrder {
    int nM, nN, nwg, G, c, nrep;
    __host__ __device__ void init(int M, int N, int G_, int c_, int nrep_ = 1) { nM = M / BM; nN = N / BM; nwg = nM * nN; G = G_; c = c_; nrep = nrep_; }
    __host__ __device__ bool next(int i, Unit& u) const {
        const long L = (long)i * G + c; if (L >= (long)nwg * nrep) return false;
        int wgid = (int)(L % nwg); { const int q = nwg / NXCD, r = nwg % NXCD, xcd = wgid % NXCD, off = wgid / NXCD; wgid = (xcd < r ? xcd * (q + 1) : r * (q + 1) + (xcd - r) * q) + off; }
        const int nig = WGM * nN, gid = wgid / nig, fm = gid * WGM, gsz = (nM - fm) < WGM ? (nM - fm) : WGM;
        u.pm = fm + ((wgid % nig) % gsz); u.pn = (wgid % nig) / gsz; return true;
    }
    __device__ __forceinline__ void a_ready(const Unit&) const {}
    __device__ __forceinline__ void done(const Unit&) const {}
};

__device__ __forceinline__ unsigned cvt_pk_bf16(float lo, float hi) { unsigned r; asm volatile("v_cvt_pk_bf16_f32 %0, %1, %2" : "=v"(r) : "v"(lo), "v"(hi)); return r; }
typedef float f32x2 __attribute__((ext_vector_type(2)));
__device__ __forceinline__ f32x2 gelu_pk(f32x2 v) {
    const f32x2 av = __builtin_elementwise_abs(v), d = av * 0.2316418882f + 1.0f;
    f32x2 t; t.x = __builtin_amdgcn_rcpf(d.x); t.y = __builtin_amdgcn_rcpf(d.y);
    f32x2 q = t * 0.5307027145f + (-0.7265760135f); q = q * t + 0.7107068705f; q = q * t + (-0.142248368f); q = q * t + 0.127414796f; q = q * t;
    const f32x2 s = (v * v) * (-0.72134752044f);
    f32x2 e; e.x = __builtin_amdgcn_exp2f(s.x); e.y = __builtin_amdgcn_exp2f(s.y);
    const f32x2 m = v * (q * e), r = v - m;
    f32x2 o; o.x = v.x < 0.f ? m.x : r.x; o.y = v.y < 0.f ? m.y : r.y; return o;
}

template <int ACT  > struct EpiBf16 {
    static constexpr bool PERM = true, AFTER_DRAIN = false; static_assert(ACT == 0 || ACT == 1, "EpiBf16: ACT is 0 (none) or 1 (gelu_pk)");
    bf16_t* O; int ldc; const float* bias; int split_cols; size_t split_stride; float scale0;
    __device__ __forceinline__ void operator()(const f32x4 (&acc)[2][2][4][2], const Unit& u, int wr, int wc, int fr, int fq) const {
        const int row0 = u.pm * BM + wr * 64 + fr; int colt = u.pn * BM; bf16_t* base = O;
        float sc = 1.f; if (split_cols) { const int t = colt / split_cols; base += (size_t)t * split_stride; colt -= t * split_cols; if (t == 0) sc = scale0; }
        const int col0 = colt + wc * 32 + 8 * fq, bcol0 = u.pn * BM + wc * 32 + 8 * fq;
        f32x4 bv[2][2];
#pragma unroll
        for (int bj = 0; bj < 2; ++bj)
#pragma unroll
            for (int n = 0; n < 2; ++n) bv[bj][n] = bias ? *(const f32x4*)(bias + bcol0 + bj * HALF + 4 * n) : (f32x4){0.f, 0.f, 0.f, 0.f};
#pragma unroll
        for (int ai = 0; ai < 2; ++ai)
#pragma unroll
            for (int m = 0; m < 4; ++m) { bf16_t* rowp = base + (size_t)(row0 + ai * HALF + m * 16) * ldc + col0;
#pragma unroll
                for (int bj = 0; bj < 2; ++bj) { f32x4 v0 = acc[ai][bj][m][0] + bv[bj][0], v1 = acc[ai][bj][m][1] + bv[bj][1];
                    if (ACT == 1) { f32x2 a = gelu_pk((f32x2){v0[0], v0[1]}), b = gelu_pk((f32x2){v0[2], v0[3]}), c = gelu_pk((f32x2){v1[0], v1[1]}), d = gelu_pk((f32x2){v1[2], v1[3]});
                        v0 = (f32x4){a.x, a.y, b.x, b.y}; v1 = (f32x4){c.x, c.y, d.x, d.y}; }
                    v0 = v0 * sc; v1 = v1 * sc; u32x4 w; w.x = cvt_pk_bf16(v0[0], v0[1]); w.y = cvt_pk_bf16(v0[2], v0[3]); w.z = cvt_pk_bf16(v1[0], v1[1]); w.w = cvt_pk_bf16(v1[2], v1[3]);
                    *(u32x4*)(rowp + bj * HALF) = w; } }
    }
};

__device__ __forceinline__ float gelu_tanh(float x) {
    const float y = 1.5957691216057308f * (x + 0.044715f * x * x * x);
    return x / (1.0f + __expf(-y));
}
struct EpiGateUp {
    static constexpr bool PERM = true, AFTER_DRAIN = false;
    static constexpr int DFF = 2816;
    bf16_t* ACT; const float* cw; const float* cb; float* GFIRST; float* GLAST; float* UFIRST;
    __device__ __forceinline__ void operator()(const f32x4 (&acc)[2][2][4][2], const Unit& u, int wr, int wc, int fr, int fq) const {
        const int lane = fq * 16 + fr;
        const int colg = u.pn * 128 + wc * 32 + 8 * fq;
        f32x4 w0[2], w1[2], w2[2], bb[2];
#pragma unroll
        for (int n = 0; n < 2; ++n) { w0[n] = *(const f32x4*)(cw + colg + 4 * n); w1[n] = *(const f32x4*)(cw + DFF + colg + 4 * n); w2[n] = *(const f32x4*)(cw + 2 * DFF + colg + 4 * n); bb[n] = *(const f32x4*)(cb + colg + 4 * n); }
        const int src1 = (lane & 48) | ((fr + 15) & 15), src2 = (lane & 48) | ((fr + 14) & 15);
#pragma unroll
        for (int ai = 0; ai < 2; ++ai) {
            f32x4 pp1[2] = {{0.f, 0.f, 0.f, 0.f}, {0.f, 0.f, 0.f, 0.f}}, pp2[2] = {{0.f, 0.f, 0.f, 0.f}, {0.f, 0.f, 0.f, 0.f}};
            const int slab = u.pm * 4 + ai * 2 + wr;
#pragma unroll
            for (int m = 0; m < 4; ++m) {
                f32x4 g[2], uu[2], p1[2], p2[2];
#pragma unroll
                for (int n = 0; n < 2; ++n) { g[n] = acc[ai][0][m][n]; uu[n] = acc[ai][1][m][n];
#pragma unroll
                    for (int j = 0; j < 4; ++j) { p1[n][j] = __shfl(g[n][j], src1); p2[n][j] = __shfl(g[n][j], src2); } }
                const size_t row = (size_t)(u.pm * BM + ai * HALF + wr * 64 + m * 16 + fr);
                u32x4 w;
                unsigned pk[4];
#pragma unroll
                for (int n = 0; n < 2; ++n) {
                    const f32x4 g1 = fr >= 1 ? p1[n] : pp1[n], g2 = fr >= 2 ? p2[n] : pp2[n];
                    const f32x4 cv = w2[n] * g[n] + w1[n] * g1 + w0[n] * g2 + bb[n];
                    float a[4];
#pragma unroll
                    for (int j = 0; j < 4; ++j) a[j] = gelu_tanh(cv[j]) * uu[n][j];
                    pk[2 * n] = cvt_pk_bf16(a[0], a[1]); pk[2 * n + 1] = cvt_pk_bf16(a[2], a[3]);
                }
                w.x = pk[0]; w.y = pk[1]; w.z = pk[2]; w.w = pk[3];
                if (m == 0 && fr < 2) {
                    float* gf = GFIRST + (size_t)(slab * 2 + fr) * DFF + colg; float* uf = UFIRST + (size_t)(slab * 2 + fr) * DFF + colg;
                    *(f32x4*)gf = g[0]; *(f32x4*)(gf + 4) = g[1]; *(f32x4*)uf = uu[0]; *(f32x4*)(uf + 4) = uu[1];
                } else {
                    *(u32x4*)(ACT + row * DFF + colg) = w;
                }
                if (m == 3 && fr >= 14) { float* gl = GLAST + (size_t)(slab * 2 + (fr - 14)) * DFF + colg; *(f32x4*)gl = g[0]; *(f32x4*)(gl + 4) = g[1]; }
#pragma unroll
                for (int n = 0; n < 2; ++n) { pp1[n] = p1[n]; pp2[n] = p2[n]; }
            }
        }
    }
};

struct EpiProj {
    static constexpr bool PERM = true, AFTER_DRAIN = false;
    static constexpr int LDC = 3584;
    bf16_t* O; const float* cw; const float* cb; float* QKFIRST; float* QKLAST;
    __device__ __forceinline__ void operator()(const f32x4 (&acc)[2][2][4][2], const Unit& u, int wr, int wc, int fr, int fq) const {
        if (u.pn < 4) {
            const int lane = fq * 16 + fr;
            const float ksc = (u.pn >= 2) ? 0.08838834764831845f : 1.0f;
            const int s1 = (lane & 48) | ((fr + 15) & 15), s2 = (lane & 48) | ((fr + 14) & 15), s3 = (lane & 48) | ((fr + 13) & 15);
#pragma unroll
            for (int bj = 0; bj < 2; ++bj)
#pragma unroll
                for (int n = 0; n < 2; ++n) {
                    const int colc = u.pn * BM + bj * HALF + wc * 32 + 8 * fq + 4 * n;
                    const f32x4 w0 = *(const f32x4*)(cw + colc), w1 = *(const f32x4*)(cw + 1024 + colc), w2 = *(const f32x4*)(cw + 2048 + colc), w3 = *(const f32x4*)(cw + 3072 + colc), bb = *(const f32x4*)(cb + colc);
#pragma unroll
                    for (int ai = 0; ai < 2; ++ai) {
                        f32x4 pp1 = {0.f, 0.f, 0.f, 0.f}, pp2 = pp1, pp3 = pp1;
                        const int slab = u.pm * 4 + ai * 2 + wr;
#pragma unroll
                        for (int m = 0; m < 4; ++m) {
                            const f32x4 g = acc[ai][bj][m][n]; f32x4 p1, p2, p3;
#pragma unroll
                            for (int j = 0; j < 4; ++j) { p1[j] = __shfl(g[j], s1); p2[j] = __shfl(g[j], s2); p3[j] = __shfl(g[j], s3); }
                            const f32x4 g1 = fr >= 1 ? p1 : pp1, g2 = fr >= 2 ? p2 : pp2, g3 = fr >= 3 ? p3 : pp3;
                            const f32x4 cv = w3 * g + w2 * g1 + w1 * g2 + w0 * g3 + bb;
                            float o[4];
#pragma unroll
                            for (int j = 0; j < 4; ++j) o[j] = cv[j] * ksc / (1.0f + __expf(-cv[j]));
                            const size_t row = (size_t)(u.pm * BM + ai * HALF + wr * 64 + m * 16 + fr);
                            if (m == 0 && fr < 3) *(f32x4*)(QKFIRST + (size_t)(slab * 3 + fr) * 1024 + colc) = g;
                            else { typedef unsigned u32x2v __attribute__((ext_vector_type(2))); u32x2v w; w.x = cvt_pk_bf16(o[0], o[1]); w.y = cvt_pk_bf16(o[2], o[3]); *(u32x2v*)(O + row * LDC + colc) = w; }
                            if (m == 3 && fr >= 13) *(f32x4*)(QKLAST + (size_t)(slab * 3 + (fr - 13)) * 1024 + colc) = g;
                            pp1 = p1; pp2 = p2; pp3 = p3;
                        }
                    }
                }
            return;
        }
        const int row0 = u.pm * BM + wr * 64 + fr, col0 = u.pn * BM + wc * 32 + 8 * fq;
        const float sc = (u.pn == 8 || u.pn == 9) ? 0.18033688011112042f : 1.0f;
#pragma unroll
        for (int ai = 0; ai < 2; ++ai)
#pragma unroll
            for (int m = 0; m < 4; ++m) { bf16_t* rowp = O + (size_t)(row0 + ai * HALF + m * 16) * LDC + col0;
#pragma unroll
                for (int bj = 0; bj < 2; ++bj) { const f32x4 v0 = acc[ai][bj][m][0] * sc, v1 = acc[ai][bj][m][1] * sc;
                    u32x4 w; w.x = cvt_pk_bf16(v0[0], v0[1]); w.y = cvt_pk_bf16(v0[2], v0[3]); w.z = cvt_pk_bf16(v1[0], v1[1]); w.w = cvt_pk_bf16(v1[2], v1[3]);
                    *(u32x4*)(rowp + bj * HALF) = w; } }
    }
};
template <class Epi, class Sched, bool ALIGN_EPI = false, bool SP2 = false>
__device__ __forceinline__ void gemm_phase(PG8_LAS unsigned char* lds, const Gemm g, const Sched& S, const Epi& E) {
    const int tid = threadIdx.x, wid = __builtin_amdgcn_readfirstlane(tid >> 6), lane = tid & 63, wr = wid >> 2, wc = wid & 3, fr = lane & 15, fq = lane >> 4;
    const int K = g.K, nt = K / BK;
    unsigned voffA[2], voffB[2];
#pragma unroll
    for (int i = 0; i < 2; ++i) { int R, C; stage_rc(tid * 16 + i * 8192, R, C); const int Rb = Epi::PERM ? ((R & ~31) + perm32(R & 31)) : R;
        voffA[i] = (unsigned)(R * K + C) * 2u; voffB[i] = (unsigned)(Rb * K + C) * 2u; }
    const size_t kstep = (size_t)(BK * 2);
    const size_t hstep = (size_t)HALF * K * 2;
    const size_t tstep = 2 * hstep;
    const unsigned ldsw = (unsigned)wid * 1024u;
    const int aoff = lds_byte(wr * 64 + fr, fq * 8), boff = lds_byte(wc * 32 + fr, fq * 8);
#define PG8_SA(b, h) (((b) * 2 + (h)) * HTB)
#define PG8_SB(b, h) ((4 + (b) * 2 + (h)) * HTB)
#define PG8_STAGE(bufoff, gbase, voff) do { _Pragma("unroll") for (int _i = 0; _i < 2; ++_i) \
        __builtin_amdgcn_global_load_lds((const unsigned*)((const char*)(gbase) + (voff)[_i]), (PG8_LAS unsigned*)(lds + (bufoff) + ldsw + _i * 8192), 16, 0, 0); } while (0)
#define PG8_LDA(dst, b, h) do { _Pragma("unroll") for (int m = 0; m < 4; ++m) _Pragma("unroll") for (int k = 0; k < 2; ++k) dst[m][k] = *(const PG8_LAS bf16x8*)(lds + PG8_SA(b, h) + aoff + m * 2048 + k * 1024); } while (0)
#define PG8_LDB(dst, b, h) do { _Pragma("unroll") for (int n = 0; n < 2; ++n) _Pragma("unroll") for (int k = 0; k < 2; ++k) dst[n][k] = *(const PG8_LAS bf16x8*)(lds + PG8_SB(b, h) + boff + n * 2048 + k * 1024); } while (0)
#define PG8_MMA(ai, bj, At, Bt) do { __builtin_amdgcn_s_setprio(1); _Pragma("unroll") for (int m = 0; m < 4; ++m) _Pragma("unroll") for (int n = 0; n < 2; ++n) _Pragma("unroll") for (int k = 0; k < 2; ++k) \
        acc[ai][bj][m][n] = __builtin_amdgcn_mfma_f32_16x16x32_bf16(Bt[n][k], At[m][k], acc[ai][bj][m][n], 0, 0, 0); __builtin_amdgcn_s_setprio(0); } while (0)
#define PG8_WAIT_V(n) asm volatile("s_waitcnt vmcnt(" #n ")" ::: "memory")
#define PG8_WAIT_L(n) asm volatile("s_waitcnt lgkmcnt(" #n ")" ::: "memory")
#define PG8_BAR __builtin_amdgcn_s_barrier()
#define PG8_SCHED __builtin_amdgcn_sched_barrier(0)
    Unit cur, nxt; int ui = 0;
    if (!S.next(0, cur)) return;
    f32x4 acc[2][2][4][2];
#pragma unroll
    for (int a = 0; a < 2; ++a)
#pragma unroll
        for (int b = 0; b < 2; ++b)
#pragma unroll
            for (int m = 0; m < 4; ++m)
#pragma unroll
                for (int n = 0; n < 2; ++n) acc[a][b][m][n] = (f32x4){0.f, 0.f, 0.f, 0.f};
    bf16x8 At[4][2], B0[2][2], B1[2][2];
    const char* cA = (const char*)g.A + (size_t)cur.pm * tstep; const char* cB = (const char*)g.Bt + (size_t)cur.pn * tstep;
    S.a_ready(cur);
    if constexpr (SP2) {
        PG8_STAGE(PG8_SB(0, 0), cB, voffB); PG8_STAGE(PG8_SB(0, 1), cB + hstep, voffB); PG8_STAGE(PG8_SA(0, 0), cA, voffA); PG8_STAGE(PG8_SA(0, 1), cA + hstep, voffA);
        if (wr == 1) PG8_BAR;
        PG8_WAIT_V(2); PG8_BAR;
        PG8_STAGE(PG8_SB(1, 0), cB + kstep, voffB); PG8_STAGE(PG8_SA(1, 0), cA + kstep, voffA); PG8_STAGE(PG8_SB(1, 1), cB + hstep + kstep, voffB);
        PG8_WAIT_V(6); PG8_BAR;
    } else {
        PG8_STAGE(PG8_SB(0, 0), cB, voffB); PG8_STAGE(PG8_SA(0, 0), cA, voffA); PG8_STAGE(PG8_SB(0, 1), cB + hstep, voffB); PG8_STAGE(PG8_SA(0, 1), cA + hstep, voffA);
        if (wr == 1) PG8_BAR;
        PG8_WAIT_V(4); PG8_BAR;
        PG8_STAGE(PG8_SB(1, 0), cB + kstep, voffB); PG8_STAGE(PG8_SA(1, 0), cA + kstep, voffA); PG8_STAGE(PG8_SB(1, 1), cB + hstep + kstep, voffB);
        PG8_WAIT_V(6); PG8_BAR;
    }
    for (;;) {
        const bool has_next = S.next(ui + 1, nxt);
        const char* nA = has_next ? (const char*)g.A + (size_t)nxt.pm * tstep : cA; const char* nB = has_next ? (const char*)g.Bt + (size_t)nxt.pn * tstep : cB;
        for (int t = 0; t < nt; t += 2) {
            const bool last = (t == nt - 2);
            const char* a1 = cA + (size_t)(t + 1) * kstep;
            const char* a2 = last ? nA : cA + (size_t)(t + 2) * kstep; const char* b2 = last ? nB : cB + (size_t)(t + 2) * kstep;
            const char* a3 = a2 + kstep; const char* b3 = b2 + kstep;
            if (last && has_next) S.a_ready(nxt);
            if constexpr (SP2) {
            PG8_LDB(B0, 0, 0); PG8_LDB(B1, 0, 1); PG8_SCHED; PG8_LDA(At, 0, 0); PG8_STAGE(PG8_SA(1, 1), a1 + hstep, voffA);
            PG8_WAIT_V(8); PG8_WAIT_L(0); PG8_BAR; PG8_MMA(0, 0, At, B0); PG8_MMA(0, 1, At, B1); PG8_BAR; PG8_SCHED;
            PG8_LDA(At, 0, 1); PG8_STAGE(PG8_SB(0, 0), b2, voffB); PG8_STAGE(PG8_SB(0, 1), b2 + hstep, voffB); PG8_STAGE(PG8_SA(0, 0), a2, voffA);
            PG8_WAIT_V(8); PG8_WAIT_L(0); PG8_BAR; PG8_MMA(1, 0, At, B0); PG8_MMA(1, 1, At, B1); PG8_BAR; PG8_SCHED;
            PG8_LDB(B0, 1, 0); PG8_LDB(B1, 1, 1); PG8_SCHED; PG8_LDA(At, 1, 0); PG8_STAGE(PG8_SA(0, 1), a2 + hstep, voffA);
            PG8_WAIT_V(8); PG8_WAIT_L(0); PG8_BAR; PG8_MMA(0, 0, At, B0); PG8_MMA(0, 1, At, B1); PG8_BAR; PG8_SCHED;
            PG8_LDA(At, 1, 1); PG8_STAGE(PG8_SB(1, 0), b3, voffB); PG8_STAGE(PG8_SB(1, 1), b3 + hstep, voffB); PG8_STAGE(PG8_SA(1, 0), a3, voffA);
            PG8_WAIT_V(8); PG8_WAIT_L(0); PG8_BAR; PG8_MMA(1, 0, At, B0); PG8_MMA(1, 1, At, B1); PG8_BAR; PG8_SCHED;
            } else {
            PG8_LDB(B0, 0, 0); PG8_SCHED; PG8_LDA(At, 0, 0); PG8_STAGE(PG8_SA(1, 1), a1 + hstep, voffA);
            PG8_WAIT_L(8); PG8_BAR; PG8_WAIT_L(0); PG8_MMA(0, 0, At, B0); PG8_BAR; PG8_SCHED;
            PG8_LDB(B1, 0, 1); PG8_STAGE(PG8_SB(0, 0), b2, voffB);
            PG8_BAR; PG8_WAIT_L(0); PG8_MMA(0, 1, At, B1); PG8_BAR;
            PG8_LDA(At, 0, 1); PG8_STAGE(PG8_SA(0, 0), a2, voffA);
            PG8_BAR; PG8_WAIT_L(0); PG8_MMA(1, 0, At, B0); PG8_BAR; PG8_SCHED;
            PG8_STAGE(PG8_SB(0, 1), b2 + hstep, voffB);
            PG8_WAIT_V(6); PG8_BAR; PG8_MMA(1, 1, At, B1); PG8_BAR;
            PG8_LDB(B0, 1, 0); PG8_SCHED; PG8_LDA(At, 1, 0); PG8_STAGE(PG8_SA(0, 1), a2 + hstep, voffA);
            PG8_WAIT_L(8); PG8_BAR; PG8_WAIT_L(0); PG8_MMA(0, 0, At, B0); PG8_BAR; PG8_SCHED;
            PG8_LDB(B1, 1, 1); PG8_STAGE(PG8_SB(1, 0), b3, voffB);
            PG8_BAR; PG8_WAIT_L(0); PG8_MMA(0, 1, At, B1); PG8_BAR;
            PG8_LDA(At, 1, 1); PG8_STAGE(PG8_SA(1, 0), a3, voffA);
            PG8_BAR; PG8_WAIT_L(0); PG8_MMA(1, 0, At, B0); PG8_BAR; PG8_SCHED;
            PG8_STAGE(PG8_SB(1, 1), b3 + hstep, voffB);
            PG8_WAIT_V(6); PG8_BAR; PG8_MMA(1, 1, At, B1); PG8_BAR;
            }
        }
        if constexpr (ALIGN_EPI) { if (wr == 0) PG8_BAR; }
        if constexpr (!Epi::AFTER_DRAIN) { E(acc, cur, wr, wc, fr, fq); S.done(cur); }
        if (!has_next) break;
#pragma unroll
        for (int a = 0; a < 2; ++a)
#pragma unroll
            for (int b = 0; b < 2; ++b)
#pragma unroll
                for (int m = 0; m < 4; ++m)
#pragma unroll
                    for (int n = 0; n < 2; ++n) acc[a][b][m][n] = (f32x4){0.f, 0.f, 0.f, 0.f};
        cur = nxt; cA = nA; cB = nB; ++ui;
        if constexpr (ALIGN_EPI) { if (wr == 1) PG8_BAR; }
    }
    PG8_WAIT_V(0);
    if constexpr (!ALIGN_EPI) { if (wr == 0) PG8_BAR; }
    PG8_BAR;
    if constexpr (Epi::AFTER_DRAIN) { E.fused(acc, cur, wr, wc, fr, fq, lds, wid, lane); S.done(cur); }
#undef PG8_SA
#undef PG8_SB
#undef PG8_STAGE
#undef PG8_LDA
#undef PG8_LDB
#undef PG8_MMA
#undef PG8_WAIT_V
#undef PG8_WAIT_L
#undef PG8_BAR
#undef PG8_SCHED
}
}
#define GAS __attribute__((address_space(1)))
#define LAS __attribute__((address_space(3)))
typedef unsigned short bf16;
typedef unsigned v4u __attribute__((ext_vector_type(4)));
typedef float f32x4 __attribute__((ext_vector_type(4)));
typedef short bf16x8 __attribute__((ext_vector_type(8)));
typedef GAS unsigned gu32;
typedef GAS unsigned long long gu64;
#define RLX_AGENT __ATOMIC_RELAXED, __HIP_MEMORY_SCOPE_AGENT
#define LDS_WAIT() asm volatile("s_waitcnt lgkmcnt(0)" ::: "memory")
#define VM_WAIT() asm volatile("s_waitcnt vmcnt(0)" ::: "memory")
__device__ __forceinline__ unsigned long long rt() { return __builtin_amdgcn_s_memrealtime(); }
__device__ __forceinline__ unsigned f2bf(float f) { unsigned u = __builtin_bit_cast(unsigned, f); return (u + 0x7fffu + ((u >> 16) & 1u)) >> 16; }
__device__ __forceinline__ unsigned pk2(float lo, float hi) { return f2bf(lo) | (f2bf(hi) << 16); }

#define XB_TMO      128
#define XB_XCNT(j)  (256  + 64 * (j))
#define XB_XSUB(j)  (1280 + 64 * (j))
#define XB_XGEN(j)  (2304 + 64 * (j))
#define XB_TOP      3328
#define XB_TOPGEN   3392
#define XCD_BAR_WORDS 3456
#define XB_SPIN_CAP (1u << 18)

__device__ __forceinline__ unsigned xb_ld(unsigned* p)              { return __hip_atomic_load(p, __ATOMIC_RELAXED, __HIP_MEMORY_SCOPE_AGENT); }
__device__ __forceinline__ unsigned xb_add(unsigned* p, unsigned v) { return __hip_atomic_fetch_add(p, v, __ATOMIC_RELAXED, __HIP_MEMORY_SCOPE_AGENT); }
__device__ __forceinline__ unsigned xb_xcc_id() { return (unsigned)__builtin_amdgcn_s_getreg((3 << 11) | 20) & 0xFu; }
#define XB_SPIN(cond, bar) do { unsigned _sp = 0; while (cond) { __builtin_amdgcn_s_sleep(1); \
    if ((++_sp & 255u) == 0u) { if (xb_ld(&(bar)[XB_TMO])) break; if (_sp > XB_SPIN_CAP) { atomicAdd(&(bar)[XB_TMO], 1u); break; } } } } while (0)

struct XcdBarrier {
    unsigned* bar; unsigned x;
    volatile LAS unsigned* st;
};

__device__ __forceinline__ XcdBarrier xcd_barrier_post(unsigned* bar, volatile LAS unsigned* st) {
    XcdBarrier b; b.bar = bar; b.x = xb_xcc_id(); b.st = st;
    if (threadIdx.x == 0) (void)xb_add(&bar[XB_XCNT(b.x)], 1u);
    return b;
}
__device__ __forceinline__ void xcd_barrier_complete(unsigned* bar, unsigned x, unsigned& nloc, unsigned& nx) {
    const unsigned G = gridDim.x * gridDim.y * gridDim.z;
    unsigned sum, cnt, mine, sp = 0u;
    for (;;) {
        sum = 0u; cnt = 0u; mine = 0u;
#pragma unroll
        for (unsigned j = 0; j < 16; ++j) { const unsigned c = xb_ld(&bar[XB_XCNT(j)]); sum += c; cnt += (c > 0u) ? 1u : 0u; mine = (j == x) ? c : mine; }
        if (sum == G) break;
        __builtin_amdgcn_s_sleep(1);
        if ((++sp & 255u) == 0u) { if (xb_ld(&bar[XB_TMO])) break; if (sp > XB_SPIN_CAP) { atomicAdd(&bar[XB_TMO], 1u); break; } }
    }
    nloc = mine > 0u ? mine : 1u; nx = cnt > 0u ? cnt : 1u;
}

__device__ __forceinline__ void xcd_barrier(const XcdBarrier& b) {
    asm volatile("s_waitcnt vmcnt(0)" ::: "memory");
    __syncthreads();
    if (threadIdx.x == 0) {
        unsigned* bar = b.bar;
        __builtin_amdgcn_s_waitcnt(0);
        unsigned nloc = b.st[0], nx = b.st[1];
        if (nloc == 0u) { xcd_barrier_complete(bar, b.x, nloc, nx); b.st[0] = nloc; b.st[1] = nx; }
        const unsigned old = xb_add(&bar[XB_XSUB(b.x)], 1u);
        const unsigned gen = old / nloc;
        if (old + 1u == (gen + 1u) * nloc) {
            __builtin_amdgcn_fence(__ATOMIC_RELEASE, "agent");
            asm volatile("s_waitcnt vmcnt(0)" ::: "memory");
            const unsigned og = xb_add(&bar[XB_TOP], 1u);
            const unsigned tg = og / nx;
            if (og + 1u == (tg + 1u) * nx) xb_add(&bar[XB_TOPGEN], 1u);
            else XB_SPIN(xb_ld(&bar[XB_TOPGEN]) == tg, bar);
            __builtin_amdgcn_fence(__ATOMIC_ACQUIRE, "agent");
            xb_add(&bar[XB_XGEN(b.x)], 1u);
            asm volatile("s_waitcnt vmcnt(0)" ::: "memory");
        } else {
            XB_SPIN(xb_ld(&bar[XB_XGEN(b.x)]) == gen, bar);
            __builtin_amdgcn_fence(__ATOMIC_ACQUIRE, "agent");
            asm volatile("s_waitcnt vmcnt(0)" ::: "memory");
        }
    }
    __syncthreads();
}
namespace mk {
constexpr int NWAVES = 8;
constexpr int BATCH = 16, SEQ = 2048, D = 1024, T = BATCH * SEQ;
constexpr int IN_COLS = 3592, NIN = 3584, DFF = 2816, NUP = 2 * DFF;
constexpr int C_QM = 0, C_KM = 512, C_VM = 1024, C_OM = 1536, C_QS = 2048, C_KS = 2560, C_VS = 3072;
constexpr float EPS = 1e-6f;
constexpr size_t MiB = 1u << 20;
constexpr size_t WS_CTL = 0, CTL_ZERO_BYTES = 1 * MiB;
constexpr size_t WS_WIN = 2 * MiB, WS_WOUT = 9 * MiB, WS_WUP = 11 * MiB, WS_WDN = 22 * MiB, WS_GATES = 28 * MiB;
constexpr size_t WS_H = 32 * MiB, WS_PROJ = 96 * MiB, WS_MIXIN = 320 * MiB, WS_MIX = 384 * MiB;
constexpr size_t WS_QKFIRST = 448 * MiB, WS_QKLAST = 454 * MiB, WS_DN = 460 * MiB, WS_NS = 461 * MiB, WS_SCAL = 462 * MiB, WS_MS = 462 * MiB + 65536, WS_END = 463 * MiB;
constexpr size_t WS_ACT = 96 * MiB, WS_GFIRST = 272 * MiB, WS_GLAST = 283 * MiB, WS_UFIRST = 294 * MiB;
constexpr size_t WS_Y = 320 * MiB;
static_assert(WS_ACT + (size_t)T * DFF * 2 <= WS_GFIRST && WS_UFIRST + 11 * MiB <= WS_MIXIN, "ws map");
constexpr int CW_TMO = 0, CW_BAR = 4096;
constexpr int RING_OFF = 0, RING_BYTES = 131072, LDSCTL_OFF = RING_BYTES, MISC_OFF = LDSCTL_OFF + 320, LDS_BYTES = 147456;

struct Frame {
    LAS unsigned char* lds;
    volatile LAS unsigned* MISC;
    gu32* ctl;
    int tid, lane, wave, vcu, G;
};
__device__ __forceinline__ float wave_sum(float v) {
#pragma unroll
    for (int o = 1; o < 64; o <<= 1) v += __shfl_xor(v, o);
    return v;
}
__device__ __forceinline__ float bf2f(bf16 b) { return __uint_as_float((unsigned)b << 16); }
__device__ __forceinline__ float logsig(float x) { return fminf(x, 0.f) - __logf(1.f + __expf(-fabsf(x))); }
__device__ __forceinline__ float sigmoidf_(float x) { return 1.f / (1.f + __expf(-x)); }

__device__ __forceinline__ void ld_bf16_row16(const bf16* row, int lane, f32x4 (&v)[4]) {
    const GAS unsigned long long* p = (const GAS unsigned long long*)row + lane;
#pragma unroll
    for (int j = 0; j < 4; ++j) { const unsigned long long w = p[64 * j]; const unsigned lo = (unsigned)w, hi = (unsigned)(w >> 32);
        v[j] = (f32x4){__uint_as_float(lo << 16), __uint_as_float(lo & 0xffff0000u), __uint_as_float(hi << 16), __uint_as_float(hi & 0xffff0000u)}; }
}
__device__ __forceinline__ float sumsq16(const f32x4 (&v)[4]) { float s = 0.f;
#pragma unroll
    for (int j = 0; j < 4; ++j) s += (v[j].x * v[j].x + v[j].y * v[j].y) + (v[j].z * v[j].z + v[j].w * v[j].w);
    return s; }
__device__ __forceinline__ void transpose_item(const float* W, int ldw, int srccol0, bf16* WT, int K, int destrow0, int k0, LAS float* scr, int lane) {
    float tv[32];
#pragma unroll
    for (int i = 0; i < 32; ++i) tv[i] = W[(size_t)(k0 + 2 * i + (lane >> 5)) * ldw + srccol0 + (lane & 31)];
#pragma unroll
    for (int i = 0; i < 32; ++i) scr[(2 * i + (lane >> 5)) * 33 + (lane & 31)] = tv[i];
    LDS_WAIT(); asm volatile("" ::: "memory");
    const int c = lane & 7;
#pragma unroll
    for (int j = 0; j < 4; ++j) { const int n = (lane >> 3) + 8 * j; const LAS float* s = scr + (8 * c) * 33 + n;
        v4u o; o.x = pk2(s[0 * 33], s[1 * 33]); o.y = pk2(s[2 * 33], s[3 * 33]); o.z = pk2(s[4 * 33], s[5 * 33]); o.w = pk2(s[6 * 33], s[7 * 33]);
        *(GAS v4u*)(WT + (size_t)(destrow0 + n) * K + k0 + 8 * c) = o; }
    LDS_WAIT(); asm volatile("" ::: "memory");
}
struct P0Args { const float *x, *g_pre, *w_in, *b_i, *b_f, *w_out, *w_up, *w_down; bf16 *WT_IN, *WT_OUT, *WT_UP, *WT_DN, *H; float* GATES; };
__device__ __forceinline__ void p0_prologue(Frame& F, const P0Args& a) {
    LAS float* scr = (LAS float*)(F.lds + RING_OFF + F.wave * 16384);
    const int gw = F.vcu * NWAVES + F.wave, NGW = F.G * NWAVES;
    constexpr int I_IN = 16 * (NIN / 32), I_OUT = 16 * 32, I_UP = 16 * (NUP / 32), I_DN = (DFF / 64) * 32;
    constexpr int NITEMS = I_IN + I_OUT + I_UP + I_DN;
    for (int it = gw; it < NITEMS; it += NGW) {
        int r = it;
        if (r < I_IN) { const int nblk = NIN / 32, kb = r / nblk, nb = r % nblk, n0 = 32 * nb; const int src = n0 < 2048 ? n0 : n0 + 8;
            transpose_item(a.w_in, IN_COLS, src, a.WT_IN, D, n0, 64 * kb, scr, F.lane); continue; }
        r -= I_IN;
        if (r < I_OUT) { const int kb = r / 32, nb = r % 32; transpose_item(a.w_out, D, 32 * nb, a.WT_OUT, D, 32 * nb, 64 * kb, scr, F.lane); continue; }
        r -= I_OUT;
        if (r < I_UP) { const int nblk = NUP / 32, kb = r / nblk, nb = r % nblk, n0 = 32 * nb, tj = n0 >> 8, w = n0 & 255; const int src = w < 128 ? 128 * tj + w : DFF + 128 * tj + (w - 128);
            transpose_item(a.w_up, NUP, src, a.WT_UP, D, n0, 64 * kb, scr, F.lane); continue; }
        r -= I_UP;
        { const int kb = r / 32, nb = r % 32; transpose_item(a.w_down, D, 32 * nb, a.WT_DN, DFF, 32 * nb, 64 * kb, scr, F.lane); }
    }
    __syncthreads();
    LAS float* WG = (LAS float*)(F.lds + RING_OFF);
    for (int i = F.tid; i < 8 * D; i += NWAVES * 64) { const int k = i >> 3, g = i & 7; WG[g * D + k] = a.w_in[(size_t)k * IN_COLS + 2048 + g]; }
    __syncthreads();
    f32x4 gain[4];
#pragma unroll
    for (int j = 0; j < 4; ++j) gain[j] = ((const GAS f32x4*)a.g_pre)[64 * j + F.lane];
    const int lane = F.lane, b5 = lane >> 5, b4 = (lane >> 4) & 1, b3 = (lane >> 3) & 1, gsel = 4 * b5 + 2 * b4 + b3;
    const float gbias = gsel < 4 ? a.b_i[gsel] : a.b_f[gsel - 4];
    constexpr int RB = 4;
    for (int m0 = gw; m0 < T; m0 += NGW * RB) {
        f32x4 v[RB][4];
#pragma unroll
        for (int q = 0; q < RB; ++q) { const int m = m0 + NGW * q; if (m < T) { const GAS f32x4* xr = (const GAS f32x4*)(a.x + (size_t)m * D) + lane;
#pragma unroll
            for (int j = 0; j < 4; ++j) v[q][j] = xr[64 * j]; } }
#pragma unroll
        for (int q = 0; q < RB; ++q) { const int m = m0 + NGW * q; if (m < T) {
            const float rstd = 1.0f / sqrtf(wave_sum(sumsq16(v[q])) * (1.f / D) + EPS);
#pragma unroll
            for (int j = 0; j < 4; ++j) v[q][j] = v[q][j] * rstd * gain[j];
            GAS unsigned long long* o8 = (GAS unsigned long long*)(a.H + (size_t)m * D) + lane;
#pragma unroll
            for (int j = 0; j < 4; ++j) o8[64 * j] = (unsigned long long)pk2(v[q][j].x, v[q][j].y) | ((unsigned long long)pk2(v[q][j].z, v[q][j].w) << 32);
            float d[8];
#pragma unroll
            for (int g = 0; g < 8; ++g) { float s = 0.f;
#pragma unroll
                for (int j = 0; j < 4; ++j) { const f32x4 w = ((const LAS f32x4*)(WG + g * D))[64 * j + lane]; s += (v[q][j].x * w.x + v[q][j].y * w.y) + (v[q][j].z * w.z + v[q][j].w * w.w); }
                d[g] = s; }
            float e4[4], e2[2], e1;
#pragma unroll
            for (int k = 0; k < 4; ++k) { const float keep = b5 ? d[k + 4] : d[k], send = b5 ? d[k] : d[k + 4]; e4[k] = keep + __shfl_xor(send, 32); }
#pragma unroll
            for (int k = 0; k < 2; ++k) { const float keep = b4 ? e4[k + 2] : e4[k], send = b4 ? e4[k] : e4[k + 2]; e2[k] = keep + __shfl_xor(send, 16); }
            { const float keep = b3 ? e2[1] : e2[0], send = b3 ? e2[0] : e2[1]; e1 = keep + __shfl_xor(send, 8); }
            e1 += __shfl_xor(e1, 4); e1 += __shfl_xor(e1, 2); e1 += __shfl_xor(e1, 1);
            if ((lane & 7) == 0) { const float gv = e1 + gbias; a.GATES[(size_t)m * 8 + gsel] = gsel < 4 ? gv : logsig(gv); }
        } }
    }
}

struct MixArgs { const bf16* PROJ; const float* GATES; const float *cw, *cb, *mnorm; float* HRAW; bf16* MIXIN; const float *QKFIRST, *QKLAST; bf16 *DC, *CS; float *DN, *NS, *SCAL, *MS; };
__device__ __forceinline__ float patch_qk(const float* QKFIRST, const float* QKLAST, const float* cw, const float* cb, int slab, bool has_prev, int rr, int chn, float sc) {
    float x[6];
#pragma unroll
    for (int j = 0; j < 3; ++j) { x[j] = has_prev ? QKLAST[(size_t)((slab - 1) * 3 + j) * 1024 + chn] : 0.f; x[3 + j] = QKFIRST[(size_t)(slab * 3 + j) * 1024 + chn]; }
    float y = cb[chn];
#pragma unroll
    for (int j = 0; j < 4; ++j) { const float xv = rr == 0 ? x[j] : (rr == 1 ? x[j + 1] : x[j + 2]); y += cw[j * 1024 + chn] * xv; }
    return y * sc / (1.0f + __expf(-y));
}
__device__ __forceinline__ void mlstm_naive_unit(Frame& F, const MixArgs& a, int b, int h) {
    LAS float* ql = (LAS float*)(F.lds); LAS float* kl = ql + 64 * 128; LAS float* vl = kl + 64 * 128;
    LAS float* fi = vl + 64 * 128; LAS float* ff = fi + 64; LAS float* red = ff + 64; LAS float* redd = red + 2 * 4 * 128;
    const int tid = F.tid, e = tid & 127, dq = tid >> 7;
    const size_t rowbase = (size_t)b * SEQ;
    float C[32], n[32];
#pragma unroll
    for (int i = 0; i < 32; ++i) { C[i] = 0.f; n[i] = 0.f; }
    for (int chunk = 0; chunk < SEQ / 64; ++chunk) {
        __syncthreads();
        for (int i = 0; i < 16; ++i) {
            const int idx = tid + 512 * i, t = idx >> 7, c = idx & 127, tt = chunk * 64 + t;
            if (t >= 3) { const bf16* pr = a.PROJ + (rowbase + tt) * NIN + h * 128 + c; ql[idx] = bf2f(pr[C_QM]); kl[idx] = bf2f(pr[C_KM]); }
            else { const int slab = b * 32 + chunk; ql[idx] = patch_qk(a.QKFIRST, a.QKLAST, a.cw, a.cb, slab, chunk > 0, t, h * 128 + c, 1.0f); kl[idx] = patch_qk(a.QKFIRST, a.QKLAST, a.cw, a.cb, slab, chunk > 0, t, 512 + h * 128 + c, 0.08838834764831845f); }
            vl[idx] = bf2f(a.PROJ[(rowbase + tt) * NIN + C_VM + h * 128 + c]);
        }
        if (tid < 64) { const size_t r = rowbase + chunk * 64 + tid; fi[tid] = __expf(a.GATES[r * 8 + h]); ff[tid] = __expf(a.GATES[r * 8 + 4 + h]); }
        __syncthreads();
        for (int t = 0; t < 64; ++t) {
            const float fg = ff[t], ig = fi[t], ve = vl[t * 128 + e];
            float acc = 0.f, dacc = 0.f;
#pragma unroll
            for (int dd = 0; dd < 32; ++dd) { const float kd = kl[t * 128 + dq * 32 + dd], qd = ql[t * 128 + dq * 32 + dd];
                C[dd] = fg * C[dd] + (ig * kd) * ve; acc += C[dd] * qd; n[dd] = fg * n[dd] + ig * kd; dacc += n[dd] * qd; }
            LAS float* rb = red + (t & 1) * 512; LAS float* rd = redd + (t & 1) * 4;
            rb[dq * 128 + e] = acc; if (e == 0) rd[dq] = dacc;
            __syncthreads();
            if (tid < 128) { const float num = (rb[e] + rb[128 + e]) + (rb[256 + e] + rb[384 + e]); const float den = (rd[0] + rd[1]) + (rd[2] + rd[3]);
                a.HRAW[(rowbase + chunk * 64 + t) * 512 + h * 128 + e] = num / fmaxf(fabsf(den), 1.0f); }
        }
    }
    VM_WAIT(); __syncthreads(); __builtin_amdgcn_fence(__ATOMIC_ACQUIRE, "agent"); VM_WAIT();
    for (int rr = F.wave; rr < SEQ; rr += NWAVES) {
        const size_t r = rowbase + rr;
        const float h0 = a.HRAW[r * 512 + h * 128 + F.lane], h1 = a.HRAW[r * 512 + h * 128 + 64 + F.lane];
        const float rstd = 1.0f / sqrtf(wave_sum(h0 * h0 + h1 * h1) * (1.f / 128.f) + EPS);
        const float o0 = sigmoidf_(bf2f(a.PROJ[r * NIN + C_OM + h * 128 + F.lane])), o1 = sigmoidf_(bf2f(a.PROJ[r * NIN + C_OM + h * 128 + 64 + F.lane]));
        a.MIXIN[r * D + h * 128 + F.lane] = (bf16)f2bf(o0 * h0 * rstd * a.mnorm[h * 128 + F.lane]);
        a.MIXIN[r * D + h * 128 + 64 + F.lane] = (bf16)f2bf(o1 * h1 * rstd * a.mnorm[h * 128 + 64 + F.lane]);
    }
}
__device__ __forceinline__ void sb_naive_unit(Frame& F, const MixArgs& a, int b, int h, int qblk) {
    LAS float* Kl = (LAS float*)(F.lds); LAS float* Vl = Kl + 64 * 64;
    const int tid = F.tid, t = qblk * 512 + tid;
    const size_t rowbase = (size_t)b * SEQ;
    float q[64], o[64], rem = 0.f;
    { const bf16* qp = a.PROJ + (rowbase + t) * NIN + C_QS + h * 64;
#pragma unroll
      for (int d = 0; d < 64; ++d) { q[d] = bf2f(qp[d]) * 0.6931471805599453f; o[d] = 0.f; } }
    for (int kt = qblk * 8 + 7; kt >= 0; --kt) {
        __syncthreads();
        for (int i = 0; i < 8; ++i) { const int idx = tid + 512 * i, s = idx >> 6, d = idx & 63; const bf16* pr = a.PROJ + (rowbase + kt * 64 + s) * NIN + h * 64 + d;
            Kl[idx] = bf2f(pr[C_KS]); Vl[idx] = bf2f(pr[C_VS]); }
        __syncthreads();
        if (kt * 64 < t) {
            for (int sl = 63; sl >= 0; --sl) {
                if (kt * 64 + sl < t) {
                    float z = 0.f;
#pragma unroll
                    for (int d4 = 0; d4 < 16; ++d4) { const f32x4 kv = ((const LAS f32x4*)(Kl + sl * 64))[d4]; z += (q[4 * d4] * kv.x + q[4 * d4 + 1] * kv.y) + (q[4 * d4 + 2] * kv.z + q[4 * d4 + 3] * kv.w); }
                    const float l = __logf(1.f + __expf(-fabsf(z)));
                    const float ls = fminf(z, 0.f) - l, l1 = fminf(-z, 0.f) - l;
                    const float at = __expf(ls + rem); rem += l1;
#pragma unroll
                    for (int d4 = 0; d4 < 16; ++d4) { const f32x4 vv = ((const LAS f32x4*)(Vl + sl * 64))[d4]; o[4 * d4] += at * vv.x; o[4 * d4 + 1] += at * vv.y; o[4 * d4 + 2] += at * vv.z; o[4 * d4 + 3] += at * vv.w; }
                }
            }
        }
    }
    GAS v4u* op = (GAS v4u*)(a.MIXIN + (rowbase + t) * D + 512 + h * 64);
#pragma unroll
    for (int i = 0; i < 8; ++i) { v4u w; w.x = pk2(o[8 * i], o[8 * i + 1]); w.y = pk2(o[8 * i + 2], o[8 * i + 3]); w.z = pk2(o[8 * i + 4], o[8 * i + 5]); w.w = pk2(o[8 * i + 6], o[8 * i + 7]); op[i] = w; }
}

typedef short v4i16_t __attribute__((ext_vector_type(4)));
typedef float f32x16 __attribute__((ext_vector_type(16)));
__device__ __forceinline__ v4i16_t tr16(const LAS unsigned char* p) { return __builtin_amdgcn_ds_read_tr16_b64_v4i16((LAS v4i16_t*)p); }
__device__ __forceinline__ bf16x8 cat8(v4i16_t a, v4i16_t b) { return (bf16x8){a[0], a[1], a[2], a[3], b[0], b[1], b[2], b[3]}; }
typedef float f32x2_t __attribute__((ext_vector_type(2))); typedef __bf16 bf16x2_t __attribute__((ext_vector_type(2)));
__device__ __forceinline__ unsigned cvtpk(float lo, float hi) { f32x2_t v = {lo, hi}; bf16x2_t b = __builtin_convertvector(v, bf16x2_t); return __builtin_bit_cast(unsigned, b); }
__device__ __forceinline__ bf16x8 pack8(const float* p) { v4u w; w.x = cvtpk(p[0], p[1]); w.y = cvtpk(p[2], p[3]); w.z = cvtpk(p[4], p[5]); w.w = cvtpk(p[6], p[7]); return __builtin_bit_cast(bf16x8, w); }
constexpr int SB_VRS = 192, SB_VBUF = 32 * SB_VRS;
__device__ __forceinline__ void sb_phase(Frame& F, const bf16* PROJ, bf16* MIXIN) {
    LAS unsigned char* vb = F.lds + RING_OFF + F.wave * (2 * SB_VBUF);
    const int lane = F.lane, tl = lane & 31, hh = lane >> 5;
    const int troff = (4 * hh + ((lane & 15) >> 2)) * SB_VRS + (16 * ((lane >> 4) & 1) + 4 * (lane & 3)) * 2;
    for (int bu = F.vcu; bu < 1024; bu += F.G) {
        const int bh = bu & 127, qi = (7 - (bu >> 7)) * 8 + F.wave, b = bh >> 3, h = bh & 7;
        const size_t rowbase = (size_t)b * SEQ;
        const bf16* kvbase = PROJ + rowbase * NIN + h * 64;
        bf16x8 qf[4], kf[4], kn[4]; v4u vr[4], vn[4];
        { const bf16* qp = kvbase + (size_t)(32 * qi + tl) * NIN + C_QS + 8 * hh;
#pragma unroll
          for (int s = 0; s < 4; ++s) qf[s] = *(const GAS bf16x8*)(qp + 16 * s); }
#define SB_LOADK(dst, kb) do { const bf16* kp_ = kvbase + (size_t)(32 * (kb) + tl) * NIN + C_KS + 8 * hh; _Pragma("unroll") for (int s = 0; s < 4; ++s) dst[s] = *(const GAS bf16x8*)(kp_ + 16 * s); } while (0)
#define SB_LOADV(dst, kb) do { _Pragma("unroll") for (int i = 0; i < 4; ++i) { const int idx_ = lane + 64 * i; dst[i] = *(const GAS v4u*)(kvbase + (size_t)(32 * (kb) + (idx_ >> 3)) * NIN + C_VS + 8 * (idx_ & 7)); } } while (0)
#define SB_WRITEV(buf, srcv) do { _Pragma("unroll") for (int i = 0; i < 4; ++i) { const int idx_ = lane + 64 * i; *(LAS v4u*)((buf) + (idx_ >> 3) * SB_VRS + 16 * (idx_ & 7)) = srcv[i]; } } while (0)
        SB_LOADK(kf, qi); SB_LOADV(vr, qi);
        SB_WRITEV(vb, vr);
        f32x16 o0, o1;
#pragma unroll
        for (int r = 0; r < 16; ++r) { o0[r] = 0.f; o1[r] = 0.f; }
        float carry = 1.f; int cur = 0;
        for (int kb = qi; kb >= 0; --kb) {
            if (kb > 0) { SB_LOADK(kn, kb - 1); SB_LOADV(vn, kb - 1); }
            f32x16 S;
#pragma unroll
            for (int r = 0; r < 16; ++r) S[r] = 0.f;
#pragma unroll
            for (int s = 0; s < 4; ++s) S = __builtin_amdgcn_mfma_f32_32x32x16_bf16(kf[s], qf[s], S, 0, 0, 0);
            float om[16], bt[16];
            const bool diag = (kb == qi);
#pragma unroll
            for (int r = 0; r < 16; ++r) {
                const float e = __builtin_amdgcn_exp2f(fminf(S[r], 100.f));
                float m_ = __builtin_amdgcn_rcpf(1.f + e), b_ = e * m_;
                if (diag) { const bool masked = ((r & 3) + 8 * (r >> 2) + 4 * hh) >= tl; m_ = masked ? 1.f : m_; b_ = masked ? 0.f : b_; }
                om[r] = m_; bt[r] = b_;
            }
            float xs[16], G[4], pG[4];
#pragma unroll
            for (int g = 0; g < 4; ++g) { xs[4 * g + 3] = 1.f; xs[4 * g + 2] = om[4 * g + 3]; xs[4 * g + 1] = xs[4 * g + 2] * om[4 * g + 2]; xs[4 * g] = xs[4 * g + 1] * om[4 * g + 1]; G[g] = xs[4 * g] * om[4 * g]; }
#pragma unroll
            for (int g = 0; g < 4; ++g) pG[g] = __shfl_xor(G[g], 32);
            float Sg[4]; Sg[3] = carry; Sg[2] = Sg[3] * (G[3] * pG[3]); Sg[1] = Sg[2] * (G[2] * pG[2]); Sg[0] = Sg[1] * (G[1] * pG[1]); carry = Sg[0] * (G[0] * pG[0]);
            float P[16];
#pragma unroll
            for (int g = 0; g < 4; ++g) { const float off = hh ? Sg[g] : Sg[g] * pG[g];
#pragma unroll
                for (int j = 0; j < 4; ++j) P[4 * g + j] = bt[4 * g + j] * (xs[4 * g + j] * off); }
            const bf16x8 pb0 = pack8(P), pb1 = pack8(P + 8);
            const LAS unsigned char* vbase = vb + cur * SB_VBUF + troff;
            { const bf16x8 a00 = cat8(tr16(vbase), tr16(vbase + 8 * SB_VRS)), a01 = cat8(tr16(vbase + 64), tr16(vbase + 8 * SB_VRS + 64));
              const bf16x8 a10 = cat8(tr16(vbase + 16 * SB_VRS), tr16(vbase + 24 * SB_VRS)), a11 = cat8(tr16(vbase + 16 * SB_VRS + 64), tr16(vbase + 24 * SB_VRS + 64));
              o0 = __builtin_amdgcn_mfma_f32_32x32x16_bf16(a00, pb0, o0, 0, 0, 0); o1 = __builtin_amdgcn_mfma_f32_32x32x16_bf16(a01, pb0, o1, 0, 0, 0);
              o0 = __builtin_amdgcn_mfma_f32_32x32x16_bf16(a10, pb1, o0, 0, 0, 0); o1 = __builtin_amdgcn_mfma_f32_32x32x16_bf16(a11, pb1, o1, 0, 0, 0); }
            if (__all(carry < 7.888609052210118e-31f)) break;
            if (kb > 0) { SB_WRITEV(vb + (cur ^ 1) * SB_VBUF, vn);
#pragma unroll
                for (int s = 0; s < 4; ++s) kf[s] = kn[s];
                cur ^= 1; }
        }
#undef SB_LOADK
#undef SB_LOADV
#undef SB_WRITEV
        bf16* orow = MIXIN + (rowbase + 32 * qi + tl) * D + 512 + h * 64 + 4 * hh;
#pragma unroll
        for (int g = 0; g < 4; ++g) {
            *(GAS unsigned long long*)(orow + 8 * g) = (unsigned long long)cvtpk(o0[4 * g], o0[4 * g + 1]) | ((unsigned long long)cvtpk(o0[4 * g + 2], o0[4 * g + 3]) << 32);
            *(GAS unsigned long long*)(orow + 32 + 8 * g) = (unsigned long long)cvtpk(o1[4 * g], o1[4 * g + 1]) | ((unsigned long long)cvtpk(o1[4 * g + 2], o1[4 * g + 3]) << 32);
        }
    }
}

constexpr int ML_RST = 320, ML_RSR = 272;
__device__ __forceinline__ void ml_pass_a(Frame& F, const MixArgs& a) {
    LAS unsigned char* Kl = F.lds + RING_OFF; LAS unsigned char* Vw = Kl + 64 * ML_RST; LAS float* wk = (LAS float*)(Vw + 64 * ML_RST);
    const int tid = F.tid, lane = F.lane, w = F.wave, hh = lane >> 5;
    const int tro = (8 * hh + ((lane & 15) >> 2)) * ML_RST + (16 * ((lane >> 4) & 1) + 4 * (lane & 3)) * 2;
    for (int u = F.vcu; u < 2048; u += F.G) {
        const int bh = u >> 5, c = u & 31, b = bh >> 2, h = bh & 3;
        if (c == 31) continue;
        const size_t row0 = (size_t)b * SEQ + 64 * c;
        __syncthreads();
        if (w == 0) {
            const float lf = a.GATES[(row0 + lane) * 8 + 4 + h], li = a.GATES[(row0 + lane) * 8 + h];
            float bc = lf;
#pragma unroll
            for (int o = 1; o < 64; o <<= 1) { const float t_ = __shfl_up(bc, o); if (lane >= o) bc += t_; }
            const float av = li - bc; float mx = av;
#pragma unroll
            for (int o = 1; o < 64; o <<= 1) mx = fmaxf(mx, __shfl_xor(mx, o));
            wk[lane] = __expf(av - mx);
            if (lane == 63) { a.SCAL[2 * u] = bc; a.SCAL[2 * u + 1] = mx; }
        }
#pragma unroll
        for (int i = 0; i < 2; ++i) { const int idx = tid + 512 * i, s = idx >> 4, ch = idx & 15;
            if (s >= 3) *(LAS v4u*)(Kl + s * ML_RST + ch * 16) = *(const GAS v4u*)(a.PROJ + (row0 + s) * NIN + C_KM + h * 128 + ch * 8); }
        if (tid < 384) { const int rr = tid >> 7, d = tid & 127;
            *(LAS bf16*)(Kl + rr * ML_RST + d * 2) = (bf16)f2bf(patch_qk(a.QKFIRST, a.QKLAST, a.cw, a.cb, b * 32 + c, c > 0, rr, 512 + h * 128 + d, 0.08838834764831845f)); }
        __syncthreads();
#pragma unroll
        for (int i = 0; i < 2; ++i) { const int idx = tid + 512 * i, s = idx >> 4, ch = idx & 15;
            const v4u raw = *(const GAS v4u*)(a.PROJ + (row0 + s) * NIN + C_VM + h * 128 + ch * 8); const float ws = wk[s]; v4u o;
            o.x = pk2(__uint_as_float(raw.x << 16) * ws, __uint_as_float(raw.x & 0xffff0000u) * ws); o.y = pk2(__uint_as_float(raw.y << 16) * ws, __uint_as_float(raw.y & 0xffff0000u) * ws);
            o.z = pk2(__uint_as_float(raw.z << 16) * ws, __uint_as_float(raw.z & 0xffff0000u) * ws); o.w = pk2(__uint_as_float(raw.w << 16) * ws, __uint_as_float(raw.w & 0xffff0000u) * ws);
            *(LAS v4u*)(Vw + s * ML_RST + ch * 16) = o; }
        __syncthreads();
        if (tid < 128) { float acc = 0.f;
            for (int s = 0; s < 64; ++s) acc += wk[s] * bf2f(*(const LAS bf16*)(Kl + s * ML_RST + tid * 2));
            a.DN[(size_t)u * 128 + tid] = acc; }
        const int dt = w >> 1, et0 = 2 * (w & 1);
        f32x16 c0, c1;
#pragma unroll
        for (int r = 0; r < 16; ++r) { c0[r] = 0.f; c1[r] = 0.f; }
#pragma unroll
        for (int kk = 0; kk < 4; ++kk) {
            const LAS unsigned char* ka = Kl + tro + 16 * kk * ML_RST + dt * 64; const LAS unsigned char* va = Vw + tro + 16 * kk * ML_RST + et0 * 64;
            const bf16x8 A = cat8(tr16(ka), tr16(ka + 4 * ML_RST)), B0 = cat8(tr16(va), tr16(va + 4 * ML_RST)), B1 = cat8(tr16(va + 64), tr16(va + 4 * ML_RST + 64));
            c0 = __builtin_amdgcn_mfma_f32_32x32x16_bf16(A, B0, c0, 0, 0, 0); c1 = __builtin_amdgcn_mfma_f32_32x32x16_bf16(A, B1, c1, 0, 0, 0);
        }
        bf16* dcu = a.DC + (size_t)u * 16384;
#pragma unroll
        for (int g = 0; g < 4; ++g) {
            const int fo0 = (((et0 * 8 + 2 * dt + (g >> 1)) * 64) + (lane & 31) + 32 * (g & 1)) * 8 + 4 * hh, fo1 = fo0 + 8 * 64 * 8;
            *(GAS unsigned long long*)(dcu + fo0) = (unsigned long long)cvtpk(c0[4 * g], c0[4 * g + 1]) | ((unsigned long long)cvtpk(c0[4 * g + 2], c0[4 * g + 3]) << 32);
            *(GAS unsigned long long*)(dcu + fo1) = (unsigned long long)cvtpk(c1[4 * g], c1[4 * g + 1]) | ((unsigned long long)cvtpk(c1[4 * g + 2], c1[4 * g + 3]) << 32);
        }
    }
}
__device__ __forceinline__ void ml_pass_b(Frame& F, const MixArgs& a) {
    LAS float* scl = (LAS float*)(F.lds + RING_OFF);
    const int tid = F.tid;
    for (int u = F.vcu; u < 256; u += F.G) {
        const int bh = u >> 2, qtr = u & 3;
        __syncthreads();
        if (tid < 64) scl[tid] = a.SCAL[(size_t)bh * 64 + tid];
        __syncthreads();
        const size_t base = (size_t)bh * 32 * 16384 + qtr * 4096 + tid * 8;
        float C[8], nv = 0.f, ms = 0.f;
#pragma unroll
        for (int i = 0; i < 8; ++i) C[i] = 0.f;
        v4u ring[8];
#pragma unroll
        for (int i = 0; i < 8; ++i) ring[i] = *(const GAS v4u*)(a.DC + base + (size_t)i * 16384);
#pragma unroll
        for (int c = 0; c < 32; ++c) {
            v4u o; o.x = pk2(C[0], C[1]); o.y = pk2(C[2], C[3]); o.z = pk2(C[4], C[5]); o.w = pk2(C[6], C[7]);
            *(GAS v4u*)(a.CS + base + (size_t)c * 16384) = o;
            if (tid < 32) a.NS[(size_t)(bh * 32 + c) * 128 + qtr * 32 + tid] = nv;
            if (qtr == 0 && tid == 0) a.MS[bh * 32 + c] = ms;
            if (c < 31) {
                const float bl = scl[2 * c], pm = scl[2 * c + 1], M = fmaxf(pm, ms), sc = __expf(pm - M), dec = __expf(ms - M);
                ms = bl + M;
                const v4u d = ring[c & 7];
                if (c + 8 < 31) ring[c & 7] = *(const GAS v4u*)(a.DC + base + (size_t)(c + 8) * 16384);
                C[0] = dec * C[0] + sc * __uint_as_float(d.x << 16); C[1] = dec * C[1] + sc * __uint_as_float(d.x & 0xffff0000u);
                C[2] = dec * C[2] + sc * __uint_as_float(d.y << 16); C[3] = dec * C[3] + sc * __uint_as_float(d.y & 0xffff0000u);
                C[4] = dec * C[4] + sc * __uint_as_float(d.z << 16); C[5] = dec * C[5] + sc * __uint_as_float(d.z & 0xffff0000u);
                C[6] = dec * C[6] + sc * __uint_as_float(d.w << 16); C[7] = dec * C[7] + sc * __uint_as_float(d.w & 0xffff0000u);
                if (tid < 32) nv = dec * nv + sc * a.DN[(size_t)(bh * 32 + c) * 128 + qtr * 32 + tid];
            }
        }
    }
}
__device__ __forceinline__ void ml_pass_c(Frame& F, const MixArgs& a) {
    LAS unsigned char* Ql = F.lds + RING_OFF; LAS unsigned char* Kl = Ql + 64 * ML_RSR; LAS unsigned char* Vl = Kl + 64 * ML_RSR;
    LAS float* al = (LAS float*)(Vl + 64 * ML_RST); LAS float* Ml = al + 64; LAS float* wil = Ml + 64; LAS float* enm = wil + 64; LAS float* nl = enm + 64; LAS float* ssq = nl + 128;
    const int tid = F.tid, lane = F.lane, w = F.wave, hh = lane >> 5, tl = lane & 31;
    const int et = w & 3, tt = w >> 2, t = 32 * tt + tl;
    for (int u = F.vcu; u < 2048; u += F.G) {
        const int bh = u >> 5, c = u & 31, b = bh >> 2, h = bh & 3;
        const size_t row0 = (size_t)b * SEQ + 64 * c;
        __syncthreads();
        bf16x8 cf[8];
#pragma unroll
        for (int kk = 0; kk < 8; ++kk) cf[kk] = *(const GAS bf16x8*)(a.CS + (size_t)u * 16384 + ((et * 8 + kk) * 64 + lane) * 8);
        if (w == 0) {
            const float lf = a.GATES[(row0 + lane) * 8 + 4 + h], li = a.GATES[(row0 + lane) * 8 + h];
            float bc = lf;
#pragma unroll
            for (int o = 1; o < 64; o <<= 1) { const float t_ = __shfl_up(bc, o); if (lane >= o) bc += t_; }
            const float av = li - bc; float pm = av;
#pragma unroll
            for (int o = 1; o < 64; o <<= 1) { const float t_ = __shfl_up(pm, o); if (lane >= o) pm = fmaxf(pm, t_); }
            const float ms = a.MS[u], M = fmaxf(pm, ms);
            al[lane] = av; Ml[lane] = M; wil[lane] = __expf(ms - M); enm[lane] = __expf(-bc - M);
        }
        if (w == 1) { nl[lane] = a.NS[(size_t)u * 128 + lane]; nl[64 + lane] = a.NS[(size_t)u * 128 + 64 + lane]; }
#pragma unroll
        for (int i = 0; i < 2; ++i) { const int idx = tid + 512 * i, s = idx >> 4, ch = idx & 15; const bf16* pr = a.PROJ + (row0 + s) * NIN + h * 128 + ch * 8;
            if (s >= 3) { *(LAS v4u*)(Ql + s * ML_RSR + ch * 16) = *(const GAS v4u*)(pr + C_QM); *(LAS v4u*)(Kl + s * ML_RSR + ch * 16) = *(const GAS v4u*)(pr + C_KM); }
            *(LAS v4u*)(Vl + s * ML_RST + ch * 16) = *(const GAS v4u*)(pr + C_VM); }
        if (tid < 384) { const int rr = tid >> 7, d = tid & 127;
            *(LAS bf16*)(Ql + rr * ML_RSR + d * 2) = (bf16)f2bf(patch_qk(a.QKFIRST, a.QKLAST, a.cw, a.cb, b * 32 + c, c > 0, rr, h * 128 + d, 1.0f));
            *(LAS bf16*)(Kl + rr * ML_RSR + d * 2) = (bf16)f2bf(patch_qk(a.QKFIRST, a.QKLAST, a.cw, a.cb, b * 32 + c, c > 0, rr, 512 + h * 128 + d, 0.08838834764831845f)); }
        __syncthreads();
        bf16x8 qf[8];
#pragma unroll
        for (int kk = 0; kk < 8; ++kk) qf[kk] = *(const LAS bf16x8*)(Ql + t * ML_RSR + (16 * kk + 8 * hh) * 2);
        float qn = 0.f;
#pragma unroll
        for (int kk = 0; kk < 8; ++kk) { const f32x4 n0 = *(const LAS f32x4*)(nl + 16 * kk + 8 * hh), n1 = *(const LAS f32x4*)(nl + 16 * kk + 8 * hh + 4);
            qn += bf2f((bf16)qf[kk][0]) * n0.x + bf2f((bf16)qf[kk][1]) * n0.y + bf2f((bf16)qf[kk][2]) * n0.z + bf2f((bf16)qf[kk][3]) * n0.w
                + bf2f((bf16)qf[kk][4]) * n1.x + bf2f((bf16)qf[kk][5]) * n1.y + bf2f((bf16)qf[kk][6]) * n1.z + bf2f((bf16)qf[kk][7]) * n1.w; }
        qn += __shfl_xor(qn, 32);
        const float Mt = Ml[t], wi = wil[t];
        f32x16 numI; float dsum = 0.f;
#pragma unroll
        for (int r = 0; r < 16; ++r) numI[r] = 0.f;
        const int trq = (4 * hh + ((lane & 15) >> 2)) * ML_RST + (32 * et + 16 * ((lane >> 4) & 1) + 4 * (lane & 3)) * 2;
        for (int st = 0; st <= tt; ++st) {
            f32x16 S;
#pragma unroll
            for (int r = 0; r < 16; ++r) S[r] = 0.f;
#pragma unroll
            for (int kk = 0; kk < 8; ++kk) { const bf16x8 kfr = *(const LAS bf16x8*)(Kl + (32 * st + tl) * ML_RSR + (16 * kk + 8 * hh) * 2); S = __builtin_amdgcn_mfma_f32_32x32x16_bf16(kfr, qf[kk], S, 0, 0, 0); }
            float P[16];
            const bool diag = (st == tt);
#pragma unroll
            for (int g = 0; g < 4; ++g) { const f32x4 a4 = *(const LAS f32x4*)(al + 32 * st + 8 * g + 4 * hh);
#pragma unroll
                for (int j = 0; j < 4; ++j) { float p = S[4 * g + j] * __expf(a4[j] - Mt); if (diag && (8 * g + 4 * hh + j) > tl) p = 0.f; P[4 * g + j] = p; dsum += p; } }
            const bf16x8 pb0 = pack8(P), pb1 = pack8(P + 8);
            const LAS unsigned char* tv = Vl + 32 * st * ML_RST + trq;
            const bf16x8 A0 = cat8(tr16(tv), tr16(tv + 8 * ML_RST)), A1 = cat8(tr16(tv + 16 * ML_RST), tr16(tv + 24 * ML_RST));
            numI = __builtin_amdgcn_mfma_f32_32x32x16_bf16(A0, pb0, numI, 0, 0, 0); numI = __builtin_amdgcn_mfma_f32_32x32x16_bf16(A1, pb1, numI, 0, 0, 0);
        }
        dsum += __shfl_xor(dsum, 32);
        f32x16 qc;
#pragma unroll
        for (int r = 0; r < 16; ++r) qc[r] = 0.f;
#pragma unroll
        for (int kk = 0; kk < 8; ++kk) qc = __builtin_amdgcn_mfma_f32_32x32x16_bf16(cf[kk], qf[kk], qc, 0, 0, 0);
        const float den = dsum + wi * qn, rdn = 1.0f / fmaxf(fabsf(den), enm[t]);
        float hv[16], ss = 0.f;
#pragma unroll
        for (int r = 0; r < 16; ++r) { hv[r] = (numI[r] + wi * qc[r]) * rdn; ss += hv[r] * hv[r]; }
        ss += __shfl_xor(ss, 32);
        if (hh == 0) ssq[et * 64 + t] = ss;
        __syncthreads();
        const float rstd = 1.0f / sqrtf(((ssq[t] + ssq[64 + t]) + (ssq[128 + t] + ssq[192 + t])) * (1.f / 128.f) + EPS);
#pragma unroll
        for (int g = 0; g < 4; ++g) { const int e = h * 128 + 32 * et + 8 * g + 4 * hh;
            const unsigned long long ogw = *(const GAS unsigned long long*)(a.PROJ + (row0 + t) * NIN + C_OM + e); const unsigned lo = (unsigned)ogw, hi = (unsigned)(ogw >> 32);
            const f32x4 mn = *(const GAS f32x4*)(a.mnorm + e);
            const float o0 = sigmoidf_(__uint_as_float(lo << 16)) * hv[4 * g] * rstd * mn.x, o1 = sigmoidf_(__uint_as_float(lo & 0xffff0000u)) * hv[4 * g + 1] * rstd * mn.y;
            const float o2 = sigmoidf_(__uint_as_float(hi << 16)) * hv[4 * g + 2] * rstd * mn.z, o3 = sigmoidf_(__uint_as_float(hi & 0xffff0000u)) * hv[4 * g + 3] * rstd * mn.w;
            *(GAS unsigned long long*)(a.MIXIN + (row0 + t) * D + e) = (unsigned long long)cvtpk(o0, o1) | ((unsigned long long)cvtpk(o2, o3) << 32); }
    }
}
__device__ __forceinline__ void p2_mixers_naive(Frame& F, const MixArgs& a) {
    const int bx = blockIdx.x;
    if (bx < 64) { mlstm_naive_unit(F, a, bx >> 2, bx & 3); __syncthreads(); }
#if defined(MK_SB_NAIVE)
    else { for (int u = bx - 64; u < 512; u += (F.G - 64)) { const int qblk = 3 - (u >> 7), bh = u & 127; sb_naive_unit(F, a, bh >> 3, bh & 7, qblk); } }
#else
    sb_phase(F, a.PROJ, a.MIXIN);
#endif
}

__device__ __forceinline__ void p3b_rows(Frame& F, const float* x, const bf16* MIX, const float* g1, const float* g2, float* out, bf16* H) {
    const int gw = F.vcu * NWAVES + F.wave, NGW = F.G * NWAVES;
    f32x4 ga[4], gb[4];
#pragma unroll
    for (int j = 0; j < 4; ++j) { ga[j] = ((const GAS f32x4*)g1)[64 * j + F.lane]; gb[j] = ((const GAS f32x4*)g2)[64 * j + F.lane]; }
    constexpr int RB = 4;
    for (int m0 = gw; m0 < T; m0 += NGW * RB) {
        f32x4 mv[RB][4], xv[RB][4];
#pragma unroll
        for (int q = 0; q < RB; ++q) { const int m = m0 + NGW * q; if (m < T) { ld_bf16_row16(MIX + (size_t)m * D, F.lane, mv[q]);
            const GAS f32x4* xr = (const GAS f32x4*)(x + (size_t)m * D) + F.lane;
#pragma unroll
            for (int j = 0; j < 4; ++j) xv[q][j] = xr[64 * j]; } }
#pragma unroll
        for (int q = 0; q < RB; ++q) { const int m = m0 + NGW * q; if (m < T) {
            const float r1 = 1.0f / sqrtf(wave_sum(sumsq16(mv[q])) * (1.f / D) + EPS);
#pragma unroll
            for (int j = 0; j < 4; ++j) xv[q][j] = xv[q][j] + mv[q][j] * r1 * ga[j];
            GAS f32x4* orow = (GAS f32x4*)(out + (size_t)m * D) + F.lane;
#pragma unroll
            for (int j = 0; j < 4; ++j) orow[64 * j] = xv[q][j];
            const float r2 = 1.0f / sqrtf(wave_sum(sumsq16(xv[q])) * (1.f / D) + EPS);
            GAS unsigned long long* o8 = (GAS unsigned long long*)(H + (size_t)m * D) + F.lane;
#pragma unroll
            for (int j = 0; j < 4; ++j) { const f32x4 hv = xv[q][j] * r2 * gb[j]; o8[64 * j] = (unsigned long long)pk2(hv.x, hv.y) | ((unsigned long long)pk2(hv.z, hv.w) << 32); }
        } }
    }
}
__device__ __forceinline__ void p6_rows(Frame& F, const bf16* Y, const float* g3, float* out) {
    const int gw = F.vcu * NWAVES + F.wave, NGW = F.G * NWAVES;
    f32x4 ga[4];
#pragma unroll
    for (int j = 0; j < 4; ++j) ga[j] = ((const GAS f32x4*)g3)[64 * j + F.lane];
    constexpr int RB = 4;
    for (int m0 = gw; m0 < T; m0 += NGW * RB) {
        f32x4 yv[RB][4], xv[RB][4];
#pragma unroll
        for (int q = 0; q < RB; ++q) { const int m = m0 + NGW * q; if (m < T) { ld_bf16_row16(Y + (size_t)m * D, F.lane, yv[q]);
            const GAS f32x4* orow = (const GAS f32x4*)(out + (size_t)m * D) + F.lane;
#pragma unroll
            for (int j = 0; j < 4; ++j) xv[q][j] = orow[64 * j]; } }
#pragma unroll
        for (int q = 0; q < RB; ++q) { const int m = m0 + NGW * q; if (m < T) {
            const float r1 = 1.0f / sqrtf(wave_sum(sumsq16(yv[q])) * (1.f / D) + EPS);
            GAS f32x4* orow = (GAS f32x4*)(out + (size_t)m * D) + F.lane;
#pragma unroll
            for (int j = 0; j < 4; ++j) orow[64 * j] = xv[q][j] + yv[q][j] * r1 * ga[j];
        } }
    }
}
__device__ __forceinline__ void p4b_fixup(Frame& F, const float* cw, const float* cb, const float* GFIRST, const float* GLAST, const float* UFIRST, bf16* ACT) {
    constexpr int C4 = DFF / 4, TOTAL = 512 * 2 * C4;
    for (int it = F.vcu * NWAVES * 64 + F.tid; it < TOTAL; it += F.G * NWAVES * 64) {
        const int c4 = it % C4, rs = it / C4, rr = rs & 1, s = rs >> 1; const bool first = (s & 31) == 0;
        const f32x4 z4 = {0.f, 0.f, 0.f, 0.f};
        const f32x4 g0 = *(const GAS f32x4*)(GFIRST + (size_t)(s * 2 + rr) * DFF + 4 * c4);
        f32x4 gm1, gm2;
        if (rr == 0) { gm1 = first ? z4 : *(const GAS f32x4*)(GLAST + (size_t)((s - 1) * 2 + 1) * DFF + 4 * c4); gm2 = first ? z4 : *(const GAS f32x4*)(GLAST + (size_t)((s - 1) * 2 + 0) * DFF + 4 * c4); }
        else { gm1 = *(const GAS f32x4*)(GFIRST + (size_t)(s * 2 + 0) * DFF + 4 * c4); gm2 = first ? z4 : *(const GAS f32x4*)(GLAST + (size_t)((s - 1) * 2 + 1) * DFF + 4 * c4); }
        const f32x4 w0 = *(const GAS f32x4*)(cw + 4 * c4), w1 = *(const GAS f32x4*)(cw + DFF + 4 * c4), w2 = *(const GAS f32x4*)(cw + 2 * DFF + 4 * c4), bb = *(const GAS f32x4*)(cb + 4 * c4);
        const f32x4 uu = *(const GAS f32x4*)(UFIRST + (size_t)(s * 2 + rr) * DFF + 4 * c4);
        const f32x4 cv = w2 * g0 + w1 * gm1 + w0 * gm2 + bb;
        const float a0 = pg8::gelu_tanh(cv.x) * uu.x, a1 = pg8::gelu_tanh(cv.y) * uu.y, a2 = pg8::gelu_tanh(cv.z) * uu.z, a3 = pg8::gelu_tanh(cv.w) * uu.w;
        *(GAS unsigned long long*)(ACT + (size_t)(64 * s + rr) * DFF + 4 * c4) = (unsigned long long)pk2(a0, a1) | ((unsigned long long)pk2(a2, a3) << 32);
    }
}

struct Args { const float* in[16]; float* out; unsigned char* ws; int ph_lo, ph_hi; };
constexpr int N_PHASES = 9;
__global__ void __launch_bounds__(NWAVES * 64, 2) mega_fwd(Args args) {
    extern __shared__ __attribute__((aligned(16))) unsigned char lds[];
    Frame F;
    F.lds = (LAS unsigned char*)lds;
    F.MISC = (volatile LAS unsigned*)(F.lds + MISC_OFF);
    F.tid = threadIdx.x; F.lane = F.tid & 63; F.wave = __builtin_amdgcn_readfirstlane(F.tid >> 6);
    F.G = gridDim.x; { const int bx = blockIdx.x; F.vcu = (F.G % 8 == 0) ? (bx % 8) * (F.G / 8) + bx / 8 : bx; }
    unsigned char* ws = args.ws;
    F.ctl = (gu32*)(ws + WS_CTL);
    const float* x = args.in[0]; const float* g_pre = args.in[1]; const float* w_in = args.in[2]; const float* mconv_w = args.in[3]; const float* mconv_b = args.in[4];
    const float* b_i = args.in[5]; const float* b_f = args.in[6]; const float* mnorm = args.in[7]; const float* w_out = args.in[8]; const float* g_postmix = args.in[9];
    const float* g_preffn = args.in[10]; const float* w_up = args.in[11]; const float* fconv_w = args.in[12]; const float* fconv_b = args.in[13]; const float* w_down = args.in[14];
    const float* g_postffn = args.in[15];
    bf16* WT_IN = (bf16*)(ws + WS_WIN); bf16* WT_OUT = (bf16*)(ws + WS_WOUT); bf16* WT_UP = (bf16*)(ws + WS_WUP); bf16* WT_DN = (bf16*)(ws + WS_WDN);
    float* GATES = (float*)(ws + WS_GATES); bf16* H = (bf16*)(ws + WS_H); bf16* PROJ = (bf16*)(ws + WS_PROJ); bf16* MIXIN = (bf16*)(ws + WS_MIXIN); bf16* MIX = (bf16*)(ws + WS_MIX);
    float* QKFIRST = (float*)(ws + WS_QKFIRST); float* QKLAST = (float*)(ws + WS_QKLAST); float* DN = (float*)(ws + WS_DN); float* NS = (float*)(ws + WS_NS); float* SCAL = (float*)(ws + WS_SCAL); float* MS = (float*)(ws + WS_MS);
    bf16* ACT = (bf16*)(ws + WS_ACT); float* GFIRST = (float*)(ws + WS_GFIRST); float* GLAST = (float*)(ws + WS_GLAST); float* UFIRST = (float*)(ws + WS_UFIRST); bf16* Y = (bf16*)(ws + WS_Y);
    for (int u = F.tid; u < (LDS_BYTES - LDSCTL_OFF) / 4; u += NWAVES * 64) ((LAS unsigned*)(F.lds + LDSCTL_OFF))[u] = 0u;
    __syncthreads();
    XcdBarrier bar = xcd_barrier_post((unsigned*)(F.ctl + CW_BAR), F.MISC + 8);
    const int lo = args.ph_lo, hi = args.ph_hi;
#define IN(k) (lo <= (k) && (k) < hi)
#define SEAM(k) do { if (IN(k) && IN((k) + 1)) xcd_barrier(bar); } while (0)
#ifndef MK_PROBE_MASK
#define MK_PROBE_MASK 0
#endif
#define REPS(k) _Pragma("nounroll") for (int rep_ = 0; rep_ < ((((MK_PROBE_MASK) >> (k)) & 1) ? 2 : 1); ++rep_)
#define GREPS(k) ((((MK_PROBE_MASK) >> (k)) & 1) ? 2 : 1)
#define REPBAR() do { if (rep_) xcd_barrier(bar); } while (0)

    if (IN(0)) REPS(0) { REPBAR(); const P0Args a{x, g_pre, w_in, b_i, b_f, w_out, w_up, w_down, WT_IN, WT_OUT, WT_UP, WT_DN, H, GATES}; p0_prologue(F, a); }
    SEAM(0);
    if (IN(1)) { pg8::Gemm g{H, WT_IN, T, NIN, D}; pg8::StaticOrder S; S.init(T, NIN, F.G, (int)blockIdx.x, GREPS(1));
        pg8::EpiProj E{PROJ, mconv_w, mconv_b, QKFIRST, QKLAST};
        pg8::gemm_phase<pg8::EpiProj, pg8::StaticOrder, true, true>(F.lds + RING_OFF, g, S, E); }
    SEAM(1);
    {
        const MixArgs a{PROJ, GATES, mconv_w, mconv_b, mnorm, args.out, MIXIN, QKFIRST, QKLAST, (bf16*)args.out, (bf16*)args.out + (size_t)2048 * 16384, DN, NS, SCAL, MS};
#if defined(MK_MLSTM_NAIVE)
        if (IN(2)) p2_mixers_naive(F, a);
#else
        if (IN(2)) REPS(2) { REPBAR(); ml_pass_a(F, a); xcd_barrier(bar); ml_pass_b(F, a); __syncthreads(); sb_phase(F, a.PROJ, a.MIXIN); xcd_barrier(bar); ml_pass_c(F, a); }
#endif
    }
    SEAM(2);
    if (IN(3)) { pg8::Gemm g{MIXIN, WT_OUT, T, D, D}; pg8::StaticOrder S; S.init(T, D, F.G, (int)blockIdx.x, GREPS(3));
        pg8::EpiBf16<0> E{MIX, D, nullptr, 0, 0, 1.f};
        pg8::gemm_phase<pg8::EpiBf16<0>, pg8::StaticOrder, true, true>(F.lds + RING_OFF, g, S, E); }
    SEAM(3);
    if (IN(4)) REPS(4) { REPBAR(); p3b_rows(F, x, MIX, g_postmix, g_preffn, args.out, H); }
    SEAM(4);
    if (IN(5)) { pg8::Gemm g{H, WT_UP, T, NUP, D}; pg8::StaticOrder S; S.init(T, NUP, F.G, (int)blockIdx.x, GREPS(5));
        pg8::EpiGateUp E{ACT, fconv_w, fconv_b, GFIRST, GLAST, UFIRST};
        pg8::gemm_phase<pg8::EpiGateUp, pg8::StaticOrder, true, true>(F.lds + RING_OFF, g, S, E); }
    SEAM(5);
    if (IN(6)) REPS(6) { REPBAR(); p4b_fixup(F, fconv_w, fconv_b, GFIRST, GLAST, UFIRST, ACT); }
    SEAM(6);
    if (IN(7)) { pg8::Gemm g{ACT, WT_DN, T, D, DFF}; pg8::StaticOrder S; S.init(T, D, F.G, (int)blockIdx.x, GREPS(7));
        pg8::EpiBf16<0> E{Y, D, nullptr, 0, 0, 1.f};
        pg8::gemm_phase<pg8::EpiBf16<0>, pg8::StaticOrder, true, true>(F.lds + RING_OFF, g, S, E); }
    SEAM(7);
    if (IN(8)) p6_rows(F, Y, g_postffn, args.out);
#undef IN
#undef SEAM
}
}

#ifndef MK_N_LAUNCHES
#define MK_N_LAUNCHES 1
#endif
extern "C" void kernel_launch(void* const* d_in, const int* in_sizes, int n_in, void* d_out, int out_size, void* d_ws, size_t ws_size, hipStream_t stream) {
    using namespace mk;
    static int grid = 0;
    if (grid == 0) {
        if (n_in != 16 || in_sizes[0] != T * D || out_size != T * D || ws_size < WS_END) { fprintf(stderr, "kernel_launch: unexpected shapes / workspace (n_in %d, ws %zu); nothing launched\n", n_in, ws_size); grid = -1; return; }
        int dev = 0, cus = 0, per_cu = 0;
        if (hipGetDevice(&dev) != hipSuccess || hipDeviceGetAttribute(&cus, hipDeviceAttributeMultiprocessorCount, dev) != hipSuccess) { grid = -1; return; }
        if (hipFuncSetAttribute((const void*)mega_fwd, hipFuncAttributeMaxDynamicSharedMemorySize, LDS_BYTES) != hipSuccess) { fprintf(stderr, "kernel_launch: hipFuncSetAttribute failed\n"); grid = -1; return; }
        if (hipOccupancyMaxActiveBlocksPerMultiprocessor(&per_cu, (const void*)mega_fwd, NWAVES * 64, LDS_BYTES) != hipSuccess || per_cu < 1) { fprintf(stderr, "kernel_launch: occupancy query says %d blocks per CU\n", per_cu); (void)hipGetLastError(); grid = -1; return; }
        grid = cus;
    }
    if (grid < 0) return;
    if (hipMemsetAsync((char*)d_ws + WS_CTL, 0, CTL_ZERO_BYTES, stream) != hipSuccess) return;
    Args a{};
    for (int i = 0; i < 16; ++i) a.in[i] = (const float*)d_in[i];
    a.out = (float*)d_out; a.ws = (unsigned char*)d_ws;
#if MK_N_LAUNCHES == 1
    a.ph_lo = 0; a.ph_hi = N_PHASES;
    hipLaunchKernelGGL(mega_fwd, dim3(grid), dim3(NWAVES * 64), LDS_BYTES, stream, a);
#else
    for (int p = 0; p < N_PHASES; ++p) { a.ph_lo = p; a.ph_hi = p + 1; hipLaunchKernelGGL(mega_fwd, dim3(grid), dim3(NWAVES * 64), LDS_BYTES, stream, a); }
#endif
}
```

```cpp
#include <hip/hip_runtime.h>
#include <cstdio>
#include <cstdint>
namespace pg8 {
#define PG8_LAS __attribute__((address_space(3)))
typedef unsigned short bf16_t;
typedef short bf16x8 __attribute__((ext_vector_type(8)));
typedef float f32x4 __attribute__((ext_vector_type(4)));
typedef unsigned u32x4 __attribute__((ext_vector_type(4)));
constexpr int BM = 256, BK = 64, HALF = 128, HTB = HALF * BK * 2  , STAGE_BYTES = 8 * HTB, NXCD = 8, WGM = 8;

__host__ __device__ __forceinline__ int lds_byte(int r, int c) { const int st = (r >> 4) * 2 + (c >> 5), rr = r & 15, cc = c & 31, ob = rr * 64 + cc * 2; return st * 1024 + (ob ^ (((ob >> 9) & 1) << 5)); }
__host__ __device__ __forceinline__ void stage_rc(int b, int& R, int& C) { const int st = b / 1024, sb = b % 1024, swz = sb ^ (((sb >> 9) & 1) << 5); R = (st >> 1) * 16 + swz / 64; C = (st & 1) * 32 + (swz % 64) / 2; }
__host__ __device__ __forceinline__ int perm32(int rho) { const int n = rho >> 4, i = rho & 15; return 8 * (i >> 2) + 4 * n + (i & 3); }

struct Unit { int pm, pn; };
struct Gemm { const bf16_t* A; const bf16_t* Bt; int M, N, K; };

struct StaticOrder {
    int nM, nN, nwg, G, c, nrep;
    __host__ __device__ void init(int M, int N, int G_, int c_, int nrep_ = 1) { nM = M / BM; nN = N / BM; nwg = nM * nN; G = G_; c = c_; nrep = nrep_; }
    __host__ __device__ bool next(int i, Unit& u) const {
        const long L = (long)i * G + c; if (L >= (long)nwg * nrep) return false;
        int wgid = (int)(L % nwg); { const int q = nwg / NXCD, r = nwg % NXCD, xcd = wgid % NXCD, off = wgid / NXCD; wgid = (xcd < r ? xcd * (q + 1) : r * (q + 1) + (xcd - r) * q) + off; }
        const int nig = WGM * nN, gid = wgid / nig, fm = gid * WGM, gsz = (nM - fm) < WGM ? (nM - fm) : WGM;
        u.pm = fm + ((wgid % nig) % gsz); u.pn = (wgid % nig) / gsz; return true;
    }
    __device__ __forceinline__ void a_ready(const Unit&) const {}
    __device__ __forceinline__ void done(const Unit&) const {}
};

__device__ __forceinline__ unsigned cvt_pk_bf16(float lo, float hi) { unsigned r; asm volatile("v_cvt_pk_bf16_f32 %0, %1, %2" : "=v"(r) : "v"(lo), "v"(hi)); return r; }
typedef float f32x2 __attribute__((ext_vector_type(2)));
__device__ __forceinline__ f32x2 gelu_pk(f32x2 v) {
    const f32x2 av = __builtin_elementwise_abs(v), d = av * 0.2316418882f + 1.0f;
    f32x2 t; t.x = __builtin_amdgcn_rcpf(d.x); t.y = __builtin_amdgcn_rcpf(d.y);
    f32x2 q = t * 0.5307027145f + (-0.7265760135f); q = q * t + 0.7107068705f; q = q * t + (-0.142248368f); q = q * t + 0.127414796f; q = q * t;
    const f32x2 s = (v * v) * (-0.72134752044f);
    f32x2 e; e.x = __builtin_amdgcn_exp2f(s.x); e.y = __builtin_amdgcn_exp2f(s.y);
    const f32x2 m = v * (q * e), r = v - m;
    f32x2 o; o.x = v.x < 0.f ? m.x : r.x; o.y = v.y < 0.f ? m.y : r.y; return o;
}

template <int ACT  > struct EpiBf16 {
    static constexpr bool PERM = true, AFTER_DRAIN = false; static_assert(ACT == 0 || ACT == 1, "EpiBf16: ACT is 0 (none) or 1 (gelu_pk)");
    bf16_t* O; int ldc; const float* bias; int split_cols; size_t split_stride; float scale0;
    __device__ __forceinline__ void operator()(const f32x4 (&acc)[2][2][4][2], const Unit& u, int wr, int wc, int fr, int fq) const {
        const int row0 = u.pm * BM + wr * 64 + fr; int colt = u.pn * BM; bf16_t* base = O;
        float sc = 1.f; if (split_cols) { const int t = colt / split_cols; base += (size_t)t * split_stride; colt -= t * split_cols; if (t == 0) sc = scale0; }
        const int col0 = colt + wc * 32 + 8 * fq, bcol0 = u.pn * BM + wc * 32 + 8 * fq;
        f32x4 bv[2][2];
#pragma unroll
        for (int bj = 0; bj < 2; ++bj)
#pragma unroll
            for (int n = 0; n < 2; ++n) bv[bj][n] = bias ? *(const f32x4*)(bias + bcol0 + bj * HALF + 4 * n) : (f32x4){0.f, 0.f, 0.f, 0.f};
#pragma unroll
        for (int ai = 0; ai < 2; ++ai)
#pragma unroll
            for (int m = 0; m < 4; ++m) { bf16_t* rowp = base + (size_t)(row0 + ai * HALF + m * 16) * ldc + col0;
#pragma unroll
                for (int bj = 0; bj < 2; ++bj) { f32x4 v0 = acc[ai][bj][m][0] + bv[bj][0], v1 = acc[ai][bj][m][1] + bv[bj][1];
                    if (ACT == 1) { f32x2 a = gelu_pk((f32x2){v0[0], v0[1]}), b = gelu_pk((f32x2){v0[2], v0[3]}), c = gelu_pk((f32x2){v1[0], v1[1]}), d = gelu_pk((f32x2){v1[2], v1[3]});
                        v0 = (f32x4){a.x, a.y, b.x, b.y}; v1 = (f32x4){c.x, c.y, d.x, d.y}; }
                    v0 = v0 * sc; v1 = v1 * sc; u32x4 w; w.x = cvt_pk_bf16(v0[0], v0[1]); w.y = cvt_pk_bf16(v0[2], v0[3]); w.z = cvt_pk_bf16(v1[0], v1[1]); w.w = cvt_pk_bf16(v1[2], v1[3]);
                    *(u32x4*)(rowp + bj * HALF) = w; } }
    }
};

__device__ __forceinline__ float gelu_tanh(float x) {
    const float y = 1.5957691216057308f * (x + 0.044715f * x * x * x);
    return x / (1.0f + __expf(-y));
}
struct EpiGateUp {
    static constexpr bool PERM = true, AFTER_DRAIN = false;
    static constexpr int DFF = 2816;
    bf16_t* ACT; const float* cw; const float* cb; float* GFIRST; float* GLAST; float* UFIRST;
    __device__ __forceinline__ void operator()(const f32x4 (&acc)[2][2][4][2], const Unit& u, int wr, int wc, int fr, int fq) const {
        const int lane = fq * 16 + fr;
        const int colg = u.pn * 128 + wc * 32 + 8 * fq;
        f32x4 w0[2], w1[2], w2[2], bb[2];
#pragma unroll
        for (int n = 0; n < 2; ++n) { w0[n] = *(const f32x4*)(cw + colg + 4 * n); w1[n] = *(const f32x4*)(cw + DFF + colg + 4 * n); w2[n] = *(const f32x4*)(cw + 2 * DFF + colg + 4 * n); bb[n] = *(const f32x4*)(cb + colg + 4 * n); }
        const int src1 = (lane & 48) | ((fr + 15) & 15), src2 = (lane & 48) | ((fr + 14) & 15);
#pragma unroll
        for (int ai = 0; ai < 2; ++ai) {
            f32x4 pp1[2] = {{0.f, 0.f, 0.f, 0.f}, {0.f, 0.f, 0.f, 0.f}}, pp2[2] = {{0.f, 0.f, 0.f, 0.f}, {0.f, 0.f, 0.f, 0.f}};
            const int slab = u.pm * 4 + ai * 2 + wr;
#pragma unroll
            for (int m = 0; m < 4; ++m) {
                f32x4 g[2], uu[2], p1[2], p2[2];
#pragma unroll
                for (int n = 0; n < 2; ++n) { g[n] = acc[ai][0][m][n]; uu[n] = acc[ai][1][m][n];
#pragma unroll
                    for (int j = 0; j < 4; ++j) { p1[n][j] = __shfl(g[n][j], src1); p2[n][j] = __shfl(g[n][j], src2); } }
                const size_t row = (size_t)(u.pm * BM + ai * HALF + wr * 64 + m * 16 + fr);
                u32x4 w;
                unsigned pk[4];
#pragma unroll
                for (int n = 0; n < 2; ++n) {
                    const f32x4 g1 = fr >= 1 ? p1[n] : pp1[n], g2 = fr >= 2 ? p2[n] : pp2[n];
                    const f32x4 cv = w2[n] * g[n] + w1[n] * g1 + w0[n] * g2 + bb[n];
                    float a[4];
#pragma unroll
                    for (int j = 0; j < 4; ++j) a[j] = gelu_tanh(cv[j]) * uu[n][j];
                    pk[2 * n] = cvt_pk_bf16(a[0], a[1]); pk[2 * n + 1] = cvt_pk_bf16(a[2], a[3]);
                }
                w.x = pk[0]; w.y = pk[1]; w.z = pk[2]; w.w = pk[3];
                if (m == 0 && fr < 2) {
                    float* gf = GFIRST + (size_t)(slab * 2 + fr) * DFF + colg; float* uf = UFIRST + (size_t)(slab * 2 + fr) * DFF + colg;
                    *(f32x4*)gf = g[0]; *(f32x4*)(gf + 4) = g[1]; *(f32x4*)uf = uu[0]; *(f32x4*)(uf + 4) = uu[1];
                } else {
                    *(u32x4*)(ACT + row * DFF + colg) = w;
                }
                if (m == 3 && fr >= 14) { float* gl = GLAST + (size_t)(slab * 2 + (fr - 14)) * DFF + colg; *(f32x4*)gl = g[0]; *(f32x4*)(gl + 4) = g[1]; }
#pragma unroll
                for (int n = 0; n < 2; ++n) { pp1[n] = p1[n]; pp2[n] = p2[n]; }
            }
        }
    }
};

struct EpiProj {
    static constexpr bool PERM = true, AFTER_DRAIN = false;
    static constexpr int LDC = 3584;
    bf16_t* O; const float* cw; const float* cb; float* QKFIRST; float* QKLAST;
    __device__ __forceinline__ void operator()(const f32x4 (&acc)[2][2][4][2], const Unit& u, int wr, int wc, int fr, int fq) const {
        if (u.pn < 4) {
            const int lane = fq * 16 + fr;
            const float ksc = (u.pn >= 2) ? 0.08838834764831845f : 1.0f;
            const int s1 = (lane & 48) | ((fr + 15) & 15), s2 = (lane & 48) | ((fr + 14) & 15), s3 = (lane & 48) | ((fr + 13) & 15);
#pragma unroll
            for (int bj = 0; bj < 2; ++bj)
#pragma unroll
                for (int n = 0; n < 2; ++n) {
                    const int colc = u.pn * BM + bj * HALF + wc * 32 + 8 * fq + 4 * n;
                    const f32x4 w0 = *(const f32x4*)(cw + colc), w1 = *(const f32x4*)(cw + 1024 + colc), w2 = *(const f32x4*)(cw + 2048 + colc), w3 = *(const f32x4*)(cw + 3072 + colc), bb = *(const f32x4*)(cb + colc);
#pragma unroll
                    for (int ai = 0; ai < 2; ++ai) {
                        f32x4 pp1 = {0.f, 0.f, 0.f, 0.f}, pp2 = pp1, pp3 = pp1;
                        const int slab = u.pm * 4 + ai * 2 + wr;
#pragma unroll
                        for (int m = 0; m < 4; ++m) {
                            const f32x4 g = acc[ai][bj][m][n]; f32x4 p1, p2, p3;
#pragma unroll
                            for (int j = 0; j < 4; ++j) { p1[j] = __shfl(g[j], s1); p2[j] = __shfl(g[j], s2); p3[j] = __shfl(g[j], s3); }
                            const f32x4 g1 = fr >= 1 ? p1 : pp1, g2 = fr >= 2 ? p2 : pp2, g3 = fr >= 3 ? p3 : pp3;
                            const f32x4 cv = w3 * g + w2 * g1 + w1 * g2 + w0 * g3 + bb;
                            float o[4];
#pragma unroll
                            for (int j = 0; j < 4; ++j) o[j] = cv[j] * ksc / (1.0f + __expf(-cv[j]));
                            const size_t row = (size_t)(u.pm * BM + ai * HALF + wr * 64 + m * 16 + fr);
                            if (m == 0 && fr < 3) *(f32x4*)(QKFIRST + (size_t)(slab * 3 + fr) * 1024 + colc) = g;
                            else { typedef unsigned u32x2v __attribute__((ext_vector_type(2))); u32x2v w; w.x = cvt_pk_bf16(o[0], o[1]); w.y = cvt_pk_bf16(o[2], o[3]); *(u32x2v*)(O + row * LDC + colc) = w; }
                            if (m == 3 && fr >= 13) *(f32x4*)(QKLAST + (size_t)(slab * 3 + (fr - 13)) * 1024 + colc) = g;
                            pp1 = p1; pp2 = p2; pp3 = p3;
                        }
                    }
                }
            return;
        }
        const int row0 = u.pm * BM + wr * 64 + fr, col0 = u.pn * BM + wc * 32 + 8 * fq;
        const float sc = (u.pn == 8 || u.pn == 9) ? 0.18033688011112042f : 1.0f;
#pragma unroll
        for (int ai = 0; ai < 2; ++ai)
#pragma unroll
            for (int m = 0; m < 4; ++m) { bf16_t* rowp = O + (size_t)(row0 + ai * HALF + m * 16) * LDC + col0;
#pragma unroll
                for (int bj = 0; bj < 2; ++bj) { const f32x4 v0 = acc[ai][bj][m][0] * sc, v1 = acc[ai][bj][m][1] * sc;
                    u32x4 w; w.x = cvt_pk_bf16(v0[0], v0[1]); w.y = cvt_pk_bf16(v0[2], v0[3]); w.z = cvt_pk_bf16(v1[0], v1[1]); w.w = cvt_pk_bf16(v1[2], v1[3]);
                    *(u32x4*)(rowp + bj * HALF) = w; } }
    }
};
template <class Epi, class Sched, bool ALIGN_EPI = false, bool SP2 = false>
__device__ __forceinline__ void gemm_phase(PG8_LAS unsigned char* lds, const Gemm g, const Sched& S, const Epi& E) {
    const int tid = threadIdx.x, wid = __builtin_amdgcn_readfirstlane(tid >> 6), lane = tid & 63, wr = wid >> 2, wc = wid & 3, fr = lane & 15, fq = lane >> 4;
    const int K = g.K, nt = K / BK;
    unsigned voffA[2], voffB[2];
#pragma unroll
    for (int i = 0; i < 2; ++i) { int R, C; stage_rc(tid * 16 + i * 8192, R, C); const int Rb = Epi::PERM ? ((R & ~31) + perm32(R & 31)) : R;
        voffA[i] = (unsigned)(R * K + C) * 2u; voffB[i] = (unsigned)(Rb * K + C) * 2u; }
    const size_t kstep = (size_t)(BK * 2);
    const size_t hstep = (size_t)HALF * K * 2;
    const size_t tstep = 2 * hstep;
    const unsigned ldsw = (unsigned)wid * 1024u;
    const int aoff = lds_byte(wr * 64 + fr, fq * 8), boff = lds_byte(wc * 32 + fr, fq * 8);
#define PG8_SA(b, h) (((b) * 2 + (h)) * HTB)
#define PG8_SB(b, h) ((4 + (b) * 2 + (h)) * HTB)
#define PG8_STAGE(bufoff, gbase, voff) do { _Pragma("unroll") for (int _i = 0; _i < 2; ++_i) \
        __builtin_amdgcn_global_load_lds((const unsigned*)((const char*)(gbase) + (voff)[_i]), (PG8_LAS unsigned*)(lds + (bufoff) + ldsw + _i * 8192), 16, 0, 0); } while (0)
#define PG8_LDA(dst, b, h) do { _Pragma("unroll") for (int m = 0; m < 4; ++m) _Pragma("unroll") for (int k = 0; k < 2; ++k) dst[m][k] = *(const PG8_LAS bf16x8*)(lds + PG8_SA(b, h) + aoff + m * 2048 + k * 1024); } while (0)
#define PG8_LDB(dst, b, h) do { _Pragma("unroll") for (int n = 0; n < 2; ++n) _Pragma("unroll") for (int k = 0; k < 2; ++k) dst[n][k] = *(const PG8_LAS bf16x8*)(lds + PG8_SB(b, h) + boff + n * 2048 + k * 1024); } while (0)
#define PG8_MMA(ai, bj, At, Bt) do { __builtin_amdgcn_s_setprio(1); _Pragma("unroll") for (int m = 0; m < 4; ++m) _Pragma("unroll") for (int n = 0; n < 2; ++n) _Pragma("unroll") for (int k = 0; k < 2; ++k) \
        acc[ai][bj][m][n] = __builtin_amdgcn_mfma_f32_16x16x32_bf16(Bt[n][k], At[m][k], acc[ai][bj][m][n], 0, 0, 0); __builtin_amdgcn_s_setprio(0); } while (0)
#define PG8_WAIT_V(n) asm volatile("s_waitcnt vmcnt(" #n ")" ::: "memory")
#define PG8_WAIT_L(n) asm volatile("s_waitcnt lgkmcnt(" #n ")" ::: "memory")
#define PG8_BAR __builtin_amdgcn_s_barrier()
#define PG8_SCHED __builtin_amdgcn_sched_barrier(0)
    Unit cur, nxt; int ui = 0;
    if (!S.next(0, cur)) return;
    f32x4 acc[2][2][4][2];
#pragma unroll
    for (int a = 0; a < 2; ++a)
#pragma unroll
        for (int b = 0; b < 2; ++b)
#pragma unroll
            for (int m = 0; m < 4; ++m)
#pragma unroll
                for (int n = 0; n < 2; ++n) acc[a][b][m][n] = (f32x4){0.f, 0.f, 0.f, 0.f};
    bf16x8 At[4][2], B0[2][2], B1[2][2];
    const char* cA = (const char*)g.A + (size_t)cur.pm * tstep; const char* cB = (const char*)g.Bt + (size_t)cur.pn * tstep;
    S.a_ready(cur);
    if constexpr (SP2) {
        PG8_STAGE(PG8_SB(0, 0), cB, voffB); PG8_STAGE(PG8_SB(0, 1), cB + hstep, voffB); PG8_STAGE(PG8_SA(0, 0), cA, voffA); PG8_STAGE(PG8_SA(0, 1), cA + hstep, voffA);
        if (wr == 1) PG8_BAR;
        PG8_WAIT_V(2); PG8_BAR;
        PG8_STAGE(PG8_SB(1, 0), cB + kstep, voffB); PG8_STAGE(PG8_SA(1, 0), cA + kstep, voffA); PG8_STAGE(PG8_SB(1, 1), cB + hstep + kstep, voffB);
        PG8_WAIT_V(6); PG8_BAR;
    } else {
        PG8_STAGE(PG8_SB(0, 0), cB, voffB); PG8_STAGE(PG8_SA(0, 0), cA, voffA); PG8_STAGE(PG8_SB(0, 1), cB + hstep, voffB); PG8_STAGE(PG8_SA(0, 1), cA + hstep, voffA);
        if (wr == 1) PG8_BAR;
        PG8_WAIT_V(4); PG8_BAR;
        PG8_STAGE(PG8_SB(1, 0), cB + kstep, voffB); PG8_STAGE(PG8_SA(1, 0), cA + kstep, voffA); PG8_STAGE(PG8_SB(1, 1), cB + hstep + kstep, voffB);
        PG8_WAIT_V(6); PG8_BAR;
    }
    for (;;) {
        const bool has_next = S.next(ui + 1, nxt);
        const char* nA = has_next ? (const char*)g.A + (size_t)nxt.pm * tstep : cA; const char* nB = has_next ? (const char*)g.Bt + (size_t)nxt.pn * tstep : cB;
        for (int t = 0; t < nt; t += 2) {
            const bool last = (t == nt - 2);
            const char* a1 = cA + (size_t)(t + 1) * kstep;
            const char* a2 = last ? nA : cA + (size_t)(t + 2) * kstep; const char* b2 = last ? nB : cB + (size_t)(t + 2) * kstep;
            const char* a3 = a2 + kstep; const char* b3 = b2 + kstep;
            if (last && has_next) S.a_ready(nxt);
            if constexpr (SP2) {
            PG8_LDB(B0, 0, 0); PG8_LDB(B1, 0, 1); PG8_SCHED; PG8_LDA(At, 0, 0); PG8_STAGE(PG8_SA(1, 1), a1 + hstep, voffA);
            PG8_WAIT_V(8); PG8_WAIT_L(0); PG8_BAR; PG8_MMA(0, 0, At, B0); PG8_MMA(0, 1, At, B1); PG8_BAR; PG8_SCHED;
            PG8_LDA(At, 0, 1); PG8_STAGE(PG8_SB(0, 0), b2, voffB); PG8_STAGE(PG8_SB(0, 1), b2 + hstep, voffB); PG8_STAGE(PG8_SA(0, 0), a2, voffA);
            PG8_WAIT_V(8); PG8_WAIT_L(0); PG8_BAR; PG8_MMA(1, 0, At, B0); PG8_MMA(1, 1, At, B1); PG8_BAR; PG8_SCHED;
            PG8_LDB(B0, 1, 0); PG8_LDB(B1, 1, 1); PG8_SCHED; PG8_LDA(At, 1, 0); PG8_STAGE(PG8_SA(0, 1), a2 + hstep, voffA);
            PG8_WAIT_V(8); PG8_WAIT_L(0); PG8_BAR; PG8_MMA(0, 0, At, B0); PG8_MMA(0, 1, At, B1); PG8_BAR; PG8_SCHED;
            PG8_LDA(At, 1, 1); PG8_STAGE(PG8_SB(1, 0), b3, voffB); PG8_STAGE(PG8_SB(1, 1), b3 + hstep, voffB); PG8_STAGE(PG8_SA(1, 0), a3, voffA);
            PG8_WAIT_V(8); PG8_WAIT_L(0); PG8_BAR; PG8_MMA(1, 0, At, B0); PG8_MMA(1, 1, At, B1); PG8_BAR; PG8_SCHED;
            } else {
            PG8_LDB(B0, 0, 0); PG8_SCHED; PG8_LDA(At, 0, 0); PG8_STAGE(PG8_SA(1, 1), a1 + hstep, voffA);
            PG8_WAIT_L(8); PG8_BAR; PG8_WAIT_L(0); PG8_MMA(0, 0, At, B0); PG8_BAR; PG8_SCHED;
            PG8_LDB(B1, 0, 1); PG8_STAGE(PG8_SB(0, 0), b2, voffB);
            PG8_BAR; PG8_WAIT_L(0); PG8_MMA(0, 1, At, B1); PG8_BAR;
            PG8_LDA(At, 0, 1); PG8_STAGE(PG8_SA(0, 0), a2, voffA);
            PG8_BAR; PG8_WAIT_L(0); PG8_MMA(1, 0, At, B0); PG8_BAR; PG8_SCHED;
            PG8_STAGE(PG8_SB(0, 1), b2 + hstep, voffB);
            PG8_WAIT_V(6); PG8_BAR; PG8_MMA(1, 1, At, B1); PG8_BAR;
            PG8_LDB(B0, 1, 0); PG8_SCHED; PG8_LDA(At, 1, 0); PG8_STAGE(PG8_SA(0, 1), a2 + hstep, voffA);
            PG8_WAIT_L(8); PG8_BAR; PG8_WAIT_L(0); PG8_MMA(0, 0, At, B0); PG8_BAR; PG8_SCHED;
            PG8_LDB(B1, 1, 1); PG8_STAGE(PG8_SB(1, 0), b3, voffB);
            PG8_BAR; PG8_WAIT_L(0); PG8_MMA(0, 1, At, B1); PG8_BAR;
            PG8_LDA(At, 1, 1); PG8_STAGE(PG8_SA(1, 0), a3, voffA);
            PG8_BAR; PG8_WAIT_L(0); PG8_MMA(1, 0, At, B0); PG8_BAR; PG8_SCHED;
            PG8_STAGE(PG8_SB(1, 1), b3 + hstep, voffB);
            PG8_WAIT_V(6); PG8_BAR; PG8_MMA(1, 1, At, B1); PG8_BAR;
            }
        }
        if constexpr (ALIGN_EPI) { if (wr == 0) PG8_BAR; }
        if constexpr (!Epi::AFTER_DRAIN) { E(acc, cur, wr, wc, fr, fq); S.done(cur); }
        if (!has_next) break;
#pragma unroll
        for (int a = 0; a < 2; ++a)
#pragma unroll
            for (int b = 0; b < 2; ++b)
#pragma unroll
                for (int m = 0; m < 4; ++m)
#pragma unroll
                    for (int n = 0; n < 2; ++n) acc[a][b][m][n] = (f32x4){0.f, 0.f, 0.f, 0.f};
        cur = nxt; cA = nA; cB = nB; ++ui;
        if constexpr (ALIGN_EPI) { if (wr == 1) PG8_BAR; }
    }
    PG8_WAIT_V(0);
    if constexpr (!ALIGN_EPI) { if (wr == 0) PG8_BAR; }
    PG8_BAR;
    if constexpr (Epi::AFTER_DRAIN) { E.fused(acc, cur, wr, wc, fr, fq, lds, wid, lane); S.done(cur); }
#undef PG8_SA
#undef PG8_SB
#undef PG8_STAGE
#undef PG8_LDA
#undef PG8_LDB
#undef PG8_MMA
#undef PG8_WAIT_V
#undef PG8_WAIT_L
#undef PG8_BAR
#undef PG8_SCHED
}
}
#define GAS __attribute__((address_space(1)))
#define LAS __attribute__((address_space(3)))
typedef unsigned short bf16;
typedef unsigned v4u __attribute__((ext_vector_type(4)));
typedef float f32x4 __attribute__((ext_vector_type(4)));
typedef short bf16x8 __attribute__((ext_vector_type(8)));
typedef GAS unsigned gu32;
typedef GAS unsigned long long gu64;
#define RLX_AGENT __ATOMIC_RELAXED, __HIP_MEMORY_SCOPE_AGENT
#define LDS_WAIT() asm volatile("s_waitcnt lgkmcnt(0)" ::: "memory")
#define VM_WAIT() asm volatile("s_waitcnt vmcnt(0)" ::: "memory")
__device__ __forceinline__ unsigned long long rt() { return __builtin_amdgcn_s_memrealtime(); }
__device__ __forceinline__ unsigned f2bf(float f) { unsigned u = __builtin_bit_cast(unsigned, f); return (u + 0x7fffu + ((u >> 16) & 1u)) >> 16; }
__device__ __forceinline__ unsigned pk2(float lo, float hi) { return f2bf(lo) | (f2bf(hi) << 16); }

#define XB_TMO      128
#define XB_XCNT(j)  (256  + 64 * (j))
#define XB_XSUB(j)  (1280 + 64 * (j))
#define XB_XGEN(j)  (2304 + 64 * (j))
#define XB_TOP      3328
#define XB_TOPGEN   3392
#define XCD_BAR_WORDS 3456
#define XB_SPIN_CAP (1u << 18)

__device__ __forceinline__ unsigned xb_ld(unsigned* p)              { return __hip_atomic_load(p, __ATOMIC_RELAXED, __HIP_MEMORY_SCOPE_AGENT); }
__device__ __forceinline__ unsigned xb_add(unsigned* p, unsigned v) { return __hip_atomic_fetch_add(p, v, __ATOMIC_RELAXED, __HIP_MEMORY_SCOPE_AGENT); }
__device__ __forceinline__ unsigned xb_xcc_id() { return (unsigned)__builtin_amdgcn_s_getreg((3 << 11) | 20) & 0xFu; }
#define XB_SPIN(cond, bar) do { unsigned _sp = 0; while (cond) { __builtin_amdgcn_s_sleep(1); \
    if ((++_sp & 255u) == 0u) { if (xb_ld(&(bar)[XB_TMO])) break; if (_sp > XB_SPIN_CAP) { atomicAdd(&(bar)[XB_TMO], 1u); break; } } } } while (0)

struct XcdBarrier {
    unsigned* bar; unsigned x;
    volatile LAS unsigned* st;
};

__device__ __forceinline__ XcdBarrier xcd_barrier_post(unsigned* bar, volatile LAS unsigned* st) {
    XcdBarrier b; b.bar = bar; b.x = xb_xcc_id(); b.st = st;
    if (threadIdx.x == 0) (void)xb_add(&bar[XB_XCNT(b.x)], 1u);
    return b;
}
__device__ __forceinline__ void xcd_barrier_complete(unsigned* bar, unsigned x, unsigned& nloc, unsigned& nx) {
    const unsigned G = gridDim.x * gridDim.y * gridDim.z;
    unsigned sum, cnt, mine, sp = 0u;
    for (;;) {
        sum = 0u; cnt = 0u; mine = 0u;
#pragma unroll
        for (unsigned j = 0; j < 16; ++j) { const unsigned c = xb_ld(&bar[XB_XCNT(j)]); sum += c; cnt += (c > 0u) ? 1u : 0u; mine = (j == x) ? c : mine; }
        if (sum == G) break;
        __builtin_amdgcn_s_sleep(1);
        if ((++sp & 255u) == 0u) { if (xb_ld(&bar[XB_TMO])) break; if (sp > XB_SPIN_CAP) { atomicAdd(&bar[XB_TMO], 1u); break; } }
    }
    nloc = mine > 0u ? mine : 1u; nx = cnt > 0u ? cnt : 1u;
}

__device__ __forceinline__ void xcd_barrier(const XcdBarrier& b) {
    asm volatile("s_waitcnt vmcnt(0)" ::: "memory");
    __syncthreads();
    if (threadIdx.x == 0) {
        unsigned* bar = b.bar;
        __builtin_amdgcn_s_waitcnt(0);
        unsigned nloc = b.st[0], nx = b.st[1];
        if (nloc == 0u) { xcd_barrier_complete(bar, b.x, nloc, nx); b.st[0] = nloc; b.st[1] = nx; }
        const unsigned old = xb_add(&bar[XB_XSUB(b.x)], 1u);
        const unsigned gen = old / nloc;
        if (old + 1u == (gen + 1u) * nloc) {
            __builtin_amdgcn_fence(__ATOMIC_RELEASE, "agent");
            asm volatile("s_waitcnt vmcnt(0)" ::: "memory");
            const unsigned og = xb_add(&bar[XB_TOP], 1u);
            const unsigned tg = og / nx;
            if (og + 1u == (tg + 1u) * nx) xb_add(&bar[XB_TOPGEN], 1u);
            else XB_SPIN(xb_ld(&bar[XB_TOPGEN]) == tg, bar);
            __builtin_amdgcn_fence(__ATOMIC_ACQUIRE, "agent");
            xb_add(&bar[XB_XGEN(b.x)], 1u);
            asm volatile("s_waitcnt vmcnt(0)" ::: "memory");
        } else {
            XB_SPIN(xb_ld(&bar[XB_XGEN(b.x)]) == gen, bar);
            __builtin_amdgcn_fence(__ATOMIC_ACQUIRE, "agent");
            asm volatile("s_waitcnt vmcnt(0)" ::: "memory");
        }
    }
    __syncthreads();
}
namespace mk {
constexpr int NWAVES = 8;
constexpr int BATCH = 16, SEQ = 2048, D = 1024, T = BATCH * SEQ;
constexpr int IN_COLS = 3592, NIN = 3584, DFF = 2816, NUP = 2 * DFF;
constexpr int C_QM = 0, C_KM = 512, C_VM = 1024, C_OM = 1536, C_QS = 2048, C_KS = 2560, C_VS = 3072;
constexpr float EPS = 1e-6f;
constexpr size_t MiB = 1u << 20;
constexpr size_t WS_CTL = 0, CTL_ZERO_BYTES = 1 * MiB;
constexpr size_t WS_WIN = 2 * MiB, WS_WOUT = 9 * MiB, WS_WUP = 11 * MiB, WS_WDN = 22 * MiB, WS_GATES = 28 * MiB;
constexpr size_t WS_H = 32 * MiB, WS_PROJ = 96 * MiB, WS_MIXIN = 320 * MiB, WS_MIX = 384 * MiB;
constexpr size_t WS_QKFIRST = 448 * MiB, WS_QKLAST = 454 * MiB, WS_DN = 460 * MiB, WS_NS = 461 * MiB, WS_SCAL = 462 * MiB, WS_MS = 462 * MiB + 65536, WS_END = 463 * MiB;
constexpr size_t WS_ACT = 96 * MiB, WS_GFIRST = 272 * MiB, WS_GLAST = 283 * MiB, WS_UFIRST = 294 * MiB;
constexpr size_t WS_Y = 320 * MiB;
static_assert(WS_ACT + (size_t)T * DFF * 2 <= WS_GFIRST && WS_UFIRST + 11 * MiB <= WS_MIXIN, "ws map");
constexpr int CW_TMO = 0, CW_BAR = 4096;
constexpr int RING_OFF = 0, RING_BYTES = 131072, LDSCTL_OFF = RING_BYTES, MISC_OFF = LDSCTL_OFF + 320, LDS_BYTES = 147456;

struct Frame {
    LAS unsigned char* lds;
    volatile LAS unsigned* MISC;
    gu32* ctl;
    int tid, lane, wave, vcu, G;
};
__device__ __forceinline__ float wave_sum(float v) {
#pragma unroll
    for (int o = 1; o < 64; o <<= 1) v += __shfl_xor(v, o);
    return v;
}
__device__ __forceinline__ float bf2f(bf16 b) { return __uint_as_float((unsigned)b << 16); }
__device__ __forceinline__ float logsig(float x) { return fminf(x, 0.f) - __logf(1.f + __expf(-fabsf(x))); }
__device__ __forceinline__ float sigmoidf_(float x) { return 1.f / (1.f + __expf(-x)); }

__device__ __forceinline__ void ld_bf16_row16(const bf16* row, int lane, f32x4 (&v)[4]) {
    const GAS unsigned long long* p = (const GAS unsigned long long*)row + lane;
#pragma unroll
    for (int j = 0; j < 4; ++j) { const unsigned long long w = p[64 * j]; const unsigned lo = (unsigned)w, hi = (unsigned)(w >> 32);
        v[j] = (f32x4){__uint_as_float(lo << 16), __uint_as_float(lo & 0xffff0000u), __uint_as_float(hi << 16), __uint_as_float(hi & 0xffff0000u)}; }
}
__device__ __forceinline__ float sumsq16(const f32x4 (&v)[4]) { float s = 0.f;
#pragma unroll
    for (int j = 0; j < 4; ++j) s += (v[j].x * v[j].x + v[j].y * v[j].y) + (v[j].z * v[j].z + v[j].w * v[j].w);
    return s; }
__device__ __forceinline__ void transpose_item(const float* W, int ldw, int srccol0, bf16* WT, int K, int destrow0, int k0, LAS float* scr, int lane) {
    float tv[32];
#pragma unroll
    for (int i = 0; i < 32; ++i) tv[i] = W[(size_t)(k0 + 2 * i + (lane >> 5)) * ldw + srccol0 + (lane & 31)];
#pragma unroll
    for (int i = 0; i < 32; ++i) scr[(2 * i + (lane >> 5)) * 33 + (lane & 31)] = tv[i];
    LDS_WAIT(); asm volatile("" ::: "memory");
    const int c = lane & 7;
#pragma unroll
    for (int j = 0; j < 4; ++j) { const int n = (lane >> 3) + 8 * j; const LAS float* s = scr + (8 * c) * 33 + n;
        v4u o; o.x = pk2(s[0 * 33], s[1 * 33]); o.y = pk2(s[2 * 33], s[3 * 33]); o.z = pk2(s[4 * 33], s[5 * 33]); o.w = pk2(s[6 * 33], s[7 * 33]);
        *(GAS v4u*)(WT + (size_t)(destrow0 + n) * K + k0 + 8 * c) = o; }
    LDS_WAIT(); asm volatile("" ::: "memory");
}
struct P0Args { const float *x, *g_pre, *w_in, *b_i, *b_f, *w_out, *w_up, *w_down; bf16 *WT_IN, *WT_OUT, *WT_UP, *WT_DN, *H; float* GATES; };
__device__ __forceinline__ void p0_prologue(Frame& F, const P0Args& a) {
    LAS float* scr = (LAS float*)(F.lds + RING_OFF + F.wave * 16384);
    const int gw = F.vcu * NWAVES + F.wave, NGW = F.G * NWAVES;
    constexpr int I_IN = 16 * (NIN / 32), I_OUT = 16 * 32, I_UP = 16 * (NUP / 32), I_DN = (DFF / 64) * 32;
    constexpr int NITEMS = I_IN + I_OUT + I_UP + I_DN;
#ifndef MK_PROBE_MASK
#define MK_PROBE_MASK 0
#endif
    _Pragma("nounroll") for (int rp_ = 0; rp_ < ((((MK_PROBE_MASK) >> 8) & 1) ? 2 : 1); ++rp_)
    for (int it = gw; it < NITEMS; it += NGW) {
        int r = it;
        if (r < I_IN) { const int nblk = NIN / 32, kb = r / nblk, nb = r % nblk, n0 = 32 * nb; const int src = n0 < 2048 ? n0 : n0 + 8;
            transpose_item(a.w_in, IN_COLS, src, a.WT_IN, D, n0, 64 * kb, scr, F.lane); continue; }
        r -= I_IN;
        if (r < I_OUT) { const int kb = r / 32, nb = r % 32; transpose_item(a.w_out, D, 32 * nb, a.WT_OUT, D, 32 * nb, 64 * kb, scr, F.lane); continue; }
        r -= I_OUT;
        if (r < I_UP) { const int nblk = NUP / 32, kb = r / nblk, nb = r % nblk, n0 = 32 * nb, tj = n0 >> 8, w = n0 & 255; const int src = w < 128 ? 128 * tj + w : DFF + 128 * tj + (w - 128);
            transpose_item(a.w_up, NUP, src, a.WT_UP, D, n0, 64 * kb, scr, F.lane); continue; }
        r -= I_UP;
        { const int kb = r / 32, nb = r % 32; transpose_item(a.w_down, D, 32 * nb, a.WT_DN, DFF, 32 * nb, 64 * kb, scr, F.lane); }
    }
    __syncthreads();
    LAS float* WG = (LAS float*)(F.lds + RING_OFF);
    for (int i = F.tid; i < 8 * D; i += NWAVES * 64) { const int k = i >> 3, g = i & 7; WG[g * D + k] = a.w_in[(size_t)k * IN_COLS + 2048 + g]; }
    __syncthreads();
    f32x4 gain[4];
#pragma unroll
    for (int j = 0; j < 4; ++j) gain[j] = ((const GAS f32x4*)a.g_pre)[64 * j + F.lane];
    const int lane = F.lane, b5 = lane >> 5, b4 = (lane >> 4) & 1, b3 = (lane >> 3) & 1, gsel = 4 * b5 + 2 * b4 + b3;
    const float gbias = gsel < 4 ? a.b_i[gsel] : a.b_f[gsel - 4];
    constexpr int RB = 4;
    _Pragma("nounroll") for (int rp_ = 0; rp_ < ((((MK_PROBE_MASK) >> 9) & 1) ? 2 : 1); ++rp_)
    for (int m0 = gw; m0 < T; m0 += NGW * RB) {
        f32x4 v[RB][4];
#pragma unroll
        for (int q = 0; q < RB; ++q) { const int m = m0 + NGW * q; if (m < T) { const GAS f32x4* xr = (const GAS f32x4*)(a.x + (size_t)m * D) + lane;
#pragma unroll
            for (int j = 0; j < 4; ++j) v[q][j] = xr[64 * j]; } }
#pragma unroll
        for (int q = 0; q < RB; ++q) { const int m = m0 + NGW * q; if (m < T) {
            const float rstd = 1.0f / sqrtf(wave_sum(sumsq16(v[q])) * (1.f / D) + EPS);
#pragma unroll
            for (int j = 0; j < 4; ++j) v[q][j] = v[q][j] * rstd * gain[j];
            GAS unsigned long long* o8 = (GAS unsigned long long*)(a.H + (size_t)m * D) + lane;
#pragma unroll
            for (int j = 0; j < 4; ++j) o8[64 * j] = (unsigned long long)pk2(v[q][j].x, v[q][j].y) | ((unsigned long long)pk2(v[q][j].z, v[q][j].w) << 32);
            float d[8];
#pragma unroll
            for (int g = 0; g < 8; ++g) { float s = 0.f;
#pragma unroll
                for (int j = 0; j < 4; ++j) { const f32x4 w = ((const LAS f32x4*)(WG + g * D))[64 * j + lane]; s += (v[q][j].x * w.x + v[q][j].y * w.y) + (v[q][j].z * w.z + v[q][j].w * w.w); }
                d[g] = s; }
            float e4[4], e2[2], e1;
#pragma unroll
            for (int k = 0; k < 4; ++k) { const float keep = b5 ? d[k + 4] : d[k], send = b5 ? d[k] : d[k + 4]; e4[k] = keep + __shfl_xor(send, 32); }
#pragma unroll
            for (int k = 0; k < 2; ++k) { const float keep = b4 ? e4[k + 2] : e4[k], send = b4 ? e4[k] : e4[k + 2]; e2[k] = keep + __shfl_xor(send, 16); }
            { const float keep = b3 ? e2[1] : e2[0], send = b3 ? e2[0] : e2[1]; e1 = keep + __shfl_xor(send, 8); }
            e1 += __shfl_xor(e1, 4); e1 += __shfl_xor(e1, 2); e1 += __shfl_xor(e1, 1);
            if ((lane & 7) == 0) { const float gv = e1 + gbias; a.GATES[(size_t)m * 8 + gsel] = gsel < 4 ? gv : logsig(gv); }
        } }
    }
}

struct MixArgs { const bf16* PROJ; const float* GATES; const float *cw, *cb, *mnorm; float* HRAW; bf16* MIXIN; const float *QKFIRST, *QKLAST; bf16 *DC, *CS; float *DN, *NS, *SCAL, *MS; };
__device__ __forceinline__ float patch_qk(const float* QKFIRST, const float* QKLAST, const float* cw, const float* cb, int slab, bool has_prev, int rr, int chn, float sc) {
    float x[6];
#pragma unroll
    for (int j = 0; j < 3; ++j) { x[j] = has_prev ? QKLAST[(size_t)((slab - 1) * 3 + j) * 1024 + chn] : 0.f; x[3 + j] = QKFIRST[(size_t)(slab * 3 + j) * 1024 + chn]; }
    float y = cb[chn];
#pragma unroll
    for (int j = 0; j < 4; ++j) { const float xv = rr == 0 ? x[j] : (rr == 1 ? x[j + 1] : x[j + 2]); y += cw[j * 1024 + chn] * xv; }
    return y * sc / (1.0f + __expf(-y));
}
__device__ __forceinline__ void mlstm_naive_unit(Frame& F, const MixArgs& a, int b, int h) {
    LAS float* ql = (LAS float*)(F.lds); LAS float* kl = ql + 64 * 128; LAS float* vl = kl + 64 * 128;
    LAS float* fi = vl + 64 * 128; LAS float* ff = fi + 64; LAS float* red = ff + 64; LAS float* redd = red + 2 * 4 * 128;
    const int tid = F.tid, e = tid & 127, dq = tid >> 7;
    const size_t rowbase = (size_t)b * SEQ;
    float C[32], n[32];
#pragma unroll
    for (int i = 0; i < 32; ++i) { C[i] = 0.f; n[i] = 0.f; }
    for (int chunk = 0; chunk < SEQ / 64; ++chunk) {
        __syncthreads();
        for (int i = 0; i < 16; ++i) {
            const int idx = tid + 512 * i, t = idx >> 7, c = idx & 127, tt = chunk * 64 + t;
            if (t >= 3) { const bf16* pr = a.PROJ + (rowbase + tt) * NIN + h * 128 + c; ql[idx] = bf2f(pr[C_QM]); kl[idx] = bf2f(pr[C_KM]); }
            else { const int slab = b * 32 + chunk; ql[idx] = patch_qk(a.QKFIRST, a.QKLAST, a.cw, a.cb, slab, chunk > 0, t, h * 128 + c, 1.0f); kl[idx] = patch_qk(a.QKFIRST, a.QKLAST, a.cw, a.cb, slab, chunk > 0, t, 512 + h * 128 + c, 0.08838834764831845f); }
            vl[idx] = bf2f(a.PROJ[(rowbase + tt) * NIN + C_VM + h * 128 + c]);
        }
        if (tid < 64) { const size_t r = rowbase + chunk * 64 + tid; fi[tid] = __expf(a.GATES[r * 8 + h]); ff[tid] = __expf(a.GATES[r * 8 + 4 + h]); }
        __syncthreads();
        for (int t = 0; t < 64; ++t) {
            const float fg = ff[t], ig = fi[t], ve = vl[t * 128 + e];
            float acc = 0.f, dacc = 0.f;
#pragma unroll
            for (int dd = 0; dd < 32; ++dd) { const float kd = kl[t * 128 + dq * 32 + dd], qd = ql[t * 128 + dq * 32 + dd];
                C[dd] = fg * C[dd] + (ig * kd) * ve; acc += C[dd] * qd; n[dd] = fg * n[dd] + ig * kd; dacc += n[dd] * qd; }
            LAS float* rb = red + (t & 1) * 512; LAS float* rd = redd + (t & 1) * 4;
            rb[dq * 128 + e] = acc; if (e == 0) rd[dq] = dacc;
            __syncthreads();
            if (tid < 128) { const float num = (rb[e] + rb[128 + e]) + (rb[256 + e] + rb[384 + e]); const float den = (rd[0] + rd[1]) + (rd[2] + rd[3]);
                a.HRAW[(rowbase + chunk * 64 + t) * 512 + h * 128 + e] = num / fmaxf(fabsf(den), 1.0f); }
        }
    }
    VM_WAIT(); __syncthreads(); __builtin_amdgcn_fence(__ATOMIC_ACQUIRE, "agent"); VM_WAIT();
    for (int rr = F.wave; rr < SEQ; rr += NWAVES) {
        const size_t r = rowbase + rr;
        const float h0 = a.HRAW[r * 512 + h * 128 + F.lane], h1 = a.HRAW[r * 512 + h * 128 + 64 + F.lane];
        const float rstd = 1.0f / sqrtf(wave_sum(h0 * h0 + h1 * h1) * (1.f / 128.f) + EPS);
        const float o0 = sigmoidf_(bf2f(a.PROJ[r * NIN + C_OM + h * 128 + F.lane])), o1 = sigmoidf_(bf2f(a.PROJ[r * NIN + C_OM + h * 128 + 64 + F.lane]));
        a.MIXIN[r * D + h * 128 + F.lane] = (bf16)f2bf(o0 * h0 * rstd * a.mnorm[h * 128 + F.lane]);
        a.MIXIN[r * D + h * 128 + 64 + F.lane] = (bf16)f2bf(o1 * h1 * rstd * a.mnorm[h * 128 + 64 + F.lane]);
    }
}
__device__ __forceinline__ void sb_naive_unit(Frame& F, const MixArgs& a, int b, int h, int qblk) {
    LAS float* Kl = (LAS float*)(F.lds); LAS float* Vl = Kl + 64 * 64;
    const int tid = F.tid, t = qblk * 512 + tid;
    const size_t rowbase = (size_t)b * SEQ;
    float q[64], o[64], rem = 0.f;
    { const bf16* qp = a.PROJ + (rowbase + t) * NIN + C_QS + h * 64;
#pragma unroll
      for (int d = 0; d < 64; ++d) { q[d] = bf2f(qp[d]) * 0.6931471805599453f; o[d] = 0.f; } }
    for (int kt = qblk * 8 + 7; kt >= 0; --kt) {
        __syncthreads();
        for (int i = 0; i < 8; ++i) { const int idx = tid + 512 * i, s = idx >> 6, d = idx & 63; const bf16* pr = a.PROJ + (rowbase + kt * 64 + s) * NIN + h * 64 + d;
            Kl[idx] = bf2f(pr[C_KS]); Vl[idx] = bf2f(pr[C_VS]); }
        __syncthreads();
        if (kt * 64 < t) {
            for (int sl = 63; sl >= 0; --sl) {
                if (kt * 64 + sl < t) {
                    float z = 0.f;
#pragma unroll
                    for (int d4 = 0; d4 < 16; ++d4) { const f32x4 kv = ((const LAS f32x4*)(Kl + sl * 64))[d4]; z += (q[4 * d4] * kv.x + q[4 * d4 + 1] * kv.y) + (q[4 * d4 + 2] * kv.z + q[4 * d4 + 3] * kv.w); }
                    const float l = __logf(1.f + __expf(-fabsf(z)));
                    const float ls = fminf(z, 0.f) - l, l1 = fminf(-z, 0.f) - l;
                    const float at = __expf(ls + rem); rem += l1;
#pragma unroll
                    for (int d4 = 0; d4 < 16; ++d4) { const f32x4 vv = ((const LAS f32x4*)(Vl + sl * 64))[d4]; o[4 * d4] += at * vv.x; o[4 * d4 + 1] += at * vv.y; o[4 * d4 + 2] += at * vv.z; o[4 * d4 + 3] += at * vv.w; }
                }
            }
        }
    }
    GAS v4u* op = (GAS v4u*)(a.MIXIN + (rowbase + t) * D + 512 + h * 64);
#pragma unroll
    for (int i = 0; i < 8; ++i) { v4u w; w.x = pk2(o[8 * i], o[8 * i + 1]); w.y = pk2(o[8 * i + 2], o[8 * i + 3]); w.z = pk2(o[8 * i + 4], o[8 * i + 5]); w.w = pk2(o[8 * i + 6], o[8 * i + 7]); op[i] = w; }
}

typedef short v4i16_t __attribute__((ext_vector_type(4)));
typedef float f32x16 __attribute__((ext_vector_type(16)));
__device__ __forceinline__ v4i16_t tr16(const LAS unsigned char* p) { return __builtin_amdgcn_ds_read_tr16_b64_v4i16((LAS v4i16_t*)p); }
__device__ __forceinline__ bf16x8 cat8(v4i16_t a, v4i16_t b) { return (bf16x8){a[0], a[1], a[2], a[3], b[0], b[1], b[2], b[3]}; }
typedef float f32x2_t __attribute__((ext_vector_type(2))); typedef __bf16 bf16x2_t __attribute__((ext_vector_type(2)));
__device__ __forceinline__ unsigned cvtpk(float lo, float hi) { f32x2_t v = {lo, hi}; bf16x2_t b = __builtin_convertvector(v, bf16x2_t); return __builtin_bit_cast(unsigned, b); }
__device__ __forceinline__ bf16x8 pack8(const float* p) { v4u w; w.x = cvtpk(p[0], p[1]); w.y = cvtpk(p[2], p[3]); w.z = cvtpk(p[4], p[5]); w.w = cvtpk(p[6], p[7]); return __builtin_bit_cast(bf16x8, w); }
constexpr int SB_VRS = 192, SB_VBUF = 32 * SB_VRS;
__device__ __forceinline__ void sb_phase(Frame& F, const bf16* PROJ, bf16* MIXIN) {
    LAS unsigned char* vb = F.lds + RING_OFF + F.wave * (2 * SB_VBUF);
    const int lane = F.lane, tl = lane & 31, hh = lane >> 5;
    const int troff = (4 * hh + ((lane & 15) >> 2)) * SB_VRS + (16 * ((lane >> 4) & 1) + 4 * (lane & 3)) * 2;
    for (int bu = F.vcu; bu < 1024; bu += F.G) {
        const int bh = bu & 127, qi = (7 - (bu >> 7)) * 8 + F.wave, b = bh >> 3, h = bh & 7;
        const size_t rowbase = (size_t)b * SEQ;
        const bf16* kvbase = PROJ + rowbase * NIN + h * 64;
        bf16x8 qf[4], kf[4], kn[4]; v4u vr[4], vn[4];
        { const bf16* qp = kvbase + (size_t)(32 * qi + tl) * NIN + C_QS + 8 * hh;
#pragma unroll
          for (int s = 0; s < 4; ++s) qf[s] = *(const GAS bf16x8*)(qp + 16 * s); }
#define SB_LOADK(dst, kb) do { const bf16* kp_ = kvbase + (size_t)(32 * (kb) + tl) * NIN + C_KS + 8 * hh; _Pragma("unroll") for (int s = 0; s < 4; ++s) dst[s] = *(const GAS bf16x8*)(kp_ + 16 * s); } while (0)
#define SB_LOADV(dst, kb) do { _Pragma("unroll") for (int i = 0; i < 4; ++i) { const int idx_ = lane + 64 * i; dst[i] = *(const GAS v4u*)(kvbase + (size_t)(32 * (kb) + (idx_ >> 3)) * NIN + C_VS + 8 * (idx_ & 7)); } } while (0)
#define SB_WRITEV(buf, srcv) do { _Pragma("unroll") for (int i = 0; i < 4; ++i) { const int idx_ = lane + 64 * i; *(LAS v4u*)((buf) + (idx_ >> 3) * SB_VRS + 16 * (idx_ & 7)) = srcv[i]; } } while (0)
        bf16x8 k2[4]; v4u v2[4];
        SB_LOADK(kf, qi); SB_LOADV(vr, qi);
        if (qi > 0) { SB_LOADK(kn, qi - 1); SB_LOADV(vn, qi - 1); }
        SB_WRITEV(vb, vr);
        f32x16 o0, o1;
#pragma unroll
        for (int r = 0; r < 16; ++r) { o0[r] = 0.f; o1[r] = 0.f; }
        float carry = 1.f; int cur = 0;
        for (int kb = qi; kb >= 0; --kb) {
            if (kb > 1) { SB_LOADK(k2, kb - 2); SB_LOADV(v2, kb - 2); }
            f32x16 S;
#pragma unroll
            for (int r = 0; r < 16; ++r) S[r] = 0.f;
#pragma unroll
            for (int s = 0; s < 4; ++s) S = __builtin_amdgcn_mfma_f32_32x32x16_bf16(kf[s], qf[s], S, 0, 0, 0);
            float om[16], bt[16];
            const bool diag = (kb == qi);
#pragma unroll
            for (int r = 0; r < 16; ++r) {
                const float e = __builtin_amdgcn_exp2f(fminf(S[r], 100.f));
                float m_ = __builtin_amdgcn_rcpf(1.f + e), b_ = e * m_;
                if (diag) { const bool masked = ((r & 3) + 8 * (r >> 2) + 4 * hh) >= tl; m_ = masked ? 1.f : m_; b_ = masked ? 0.f : b_; }
                om[r] = m_; bt[r] = b_;
            }
            float xs[16], G[4], pG[4];
#pragma unroll
            for (int g = 0; g < 4; ++g) { xs[4 * g + 3] = 1.f; xs[4 * g + 2] = om[4 * g + 3]; xs[4 * g + 1] = xs[4 * g + 2] * om[4 * g + 2]; xs[4 * g] = xs[4 * g + 1] * om[4 * g + 1]; G[g] = xs[4 * g] * om[4 * g]; }
#pragma unroll
            for (int g = 0; g < 4; ++g) pG[g] = __shfl_xor(G[g], 32);
            float Sg[4]; Sg[3] = carry; Sg[2] = Sg[3] * (G[3] * pG[3]); Sg[1] = Sg[2] * (G[2] * pG[2]); Sg[0] = Sg[1] * (G[1] * pG[1]); carry = Sg[0] * (G[0] * pG[0]);
            float P[16];
#pragma unroll
            for (int g = 0; g < 4; ++g) { const float off = hh ? Sg[g] : Sg[g] * pG[g];
#pragma unroll
                for (int j = 0; j < 4; ++j) P[4 * g + j] = bt[4 * g + j] * (xs[4 * g + j] * off); }
            const bf16x8 pb0 = pack8(P), pb1 = pack8(P + 8);
            const LAS unsigned char* vbase = vb + cur * SB_VBUF + troff;
            { const bf16x8 a00 = cat8(tr16(vbase), tr16(vbase + 8 * SB_VRS)), a01 = cat8(tr16(vbase + 64), tr16(vbase + 8 * SB_VRS + 64));
              const bf16x8 a10 = cat8(tr16(vbase + 16 * SB_VRS), tr16(vbase + 24 * SB_VRS)), a11 = cat8(tr16(vbase + 16 * SB_VRS + 64), tr16(vbase + 24 * SB_VRS + 64));
              o0 = __builtin_amdgcn_mfma_f32_32x32x16_bf16(a00, pb0, o0, 0, 0, 0); o1 = __builtin_amdgcn_mfma_f32_32x32x16_bf16(a01, pb0, o1, 0, 0, 0);
              o0 = __builtin_amdgcn_mfma_f32_32x32x16_bf16(a10, pb1, o0, 0, 0, 0); o1 = __builtin_amdgcn_mfma_f32_32x32x16_bf16(a11, pb1, o1, 0, 0, 0); }
            if (__all(carry < 7.888609052210118e-31f)) break;
            if (kb > 0) { SB_WRITEV(vb + (cur ^ 1) * SB_VBUF, vn);
#pragma unroll
                for (int s = 0; s < 4; ++s) { kf[s] = kn[s]; kn[s] = k2[s]; vn[s] = v2[s]; }
                cur ^= 1; }
        }
#undef SB_LOADK
#undef SB_LOADV
#undef SB_WRITEV
        bf16* orow = MIXIN + (rowbase + 32 * qi + tl) * D + 512 + h * 64 + 4 * hh;
#pragma unroll
        for (int g = 0; g < 4; ++g) {
            *(GAS unsigned long long*)(orow + 8 * g) = (unsigned long long)cvtpk(o0[4 * g], o0[4 * g + 1]) | ((unsigned long long)cvtpk(o0[4 * g + 2], o0[4 * g + 3]) << 32);
            *(GAS unsigned long long*)(orow + 32 + 8 * g) = (unsigned long long)cvtpk(o1[4 * g], o1[4 * g + 1]) | ((unsigned long long)cvtpk(o1[4 * g + 2], o1[4 * g + 3]) << 32);
        }
    }
}

constexpr int ML_RST = 320, ML_RSR = 272;
struct ARegs { v4u k[2], v[2]; float x[6]; float lf, li; };
__device__ __forceinline__ void ml_load_a(ARegs& r, const MixArgs& a, int u, int tid, int lane) {
    const int bh = u >> 5, c = u & 31, b = bh >> 2, h = bh & 3; const size_t row0 = (size_t)b * SEQ + 64 * c;
#pragma unroll
    for (int i = 0; i < 2; ++i) { const int idx = tid + 512 * i, s = idx >> 4, ch = idx & 15; const bf16* pr = a.PROJ + (row0 + s) * NIN + h * 128 + ch * 8;
        if (s >= 3) r.k[i] = *(const GAS v4u*)(pr + C_KM);
        r.v[i] = *(const GAS v4u*)(pr + C_VM); }
    if (tid < 384) { const int chn = 512 + h * 128 + (tid & 127), slab = b * 32 + c;
#pragma unroll
        for (int j = 0; j < 3; ++j) { r.x[j] = c > 0 ? a.QKLAST[(size_t)((slab - 1) * 3 + j) * 1024 + chn] : 0.f; r.x[3 + j] = a.QKFIRST[(size_t)(slab * 3 + j) * 1024 + chn]; } }
    r.lf = a.GATES[(row0 + lane) * 8 + 4 + h]; r.li = a.GATES[(row0 + lane) * 8 + h];
}
__device__ __forceinline__ v4u scale_bf16x8(v4u raw, float ws) { v4u o;
    o.x = pk2(__uint_as_float(raw.x << 16) * ws, __uint_as_float(raw.x & 0xffff0000u) * ws); o.y = pk2(__uint_as_float(raw.y << 16) * ws, __uint_as_float(raw.y & 0xffff0000u) * ws);
    o.z = pk2(__uint_as_float(raw.z << 16) * ws, __uint_as_float(raw.z & 0xffff0000u) * ws); o.w = pk2(__uint_as_float(raw.w << 16) * ws, __uint_as_float(raw.w & 0xffff0000u) * ws); return o; }
__device__ __forceinline__ void ml_pass_a(Frame& F, const MixArgs& a) {
    LAS unsigned char* Kl = F.lds + RING_OFF; LAS unsigned char* Vw = Kl + 64 * ML_RST; LAS float* wk = (LAS float*)(Vw + 64 * ML_RST);
    const int tid = F.tid, lane = F.lane, w = F.wave, hh = lane >> 5;
    const int tro = (8 * hh + ((lane & 15) >> 2)) * ML_RST + (16 * ((lane >> 4) & 1) + 4 * (lane & 3)) * 2;
    int u = F.vcu;
    if ((u & 31) == 31 || u >= 2048) return;
    const int hfix = (u >> 5) & 3, prr = tid >> 7, pchn = 512 + hfix * 128 + (tid & 127);
    float pw[4], pb = 0.f;
    if (tid < 384) { pb = a.cb[pchn];
#pragma unroll
        for (int j = 0; j < 4; ++j) pw[j] = a.cw[j * 1024 + pchn]; }
    ARegs cur, nxt; ml_load_a(cur, a, u, tid, lane);
    for (; u < 2048; u += F.G) {
        const int un = u + F.G;
        __syncthreads();
        float bc = cur.lf;
#pragma unroll
        for (int o = 1; o < 64; o <<= 1) { const float t_ = __shfl_up(bc, o); if (lane >= o) bc += t_; }
        const float av = cur.li - bc; float mx = av;
#pragma unroll
        for (int o = 1; o < 64; o <<= 1) mx = fmaxf(mx, __shfl_xor(mx, o));
        const float wkv = __expf(av - mx);
        if (w == 0) { wk[lane] = wkv; if (lane == 63) { a.SCAL[2 * u] = bc; a.SCAL[2 * u + 1] = mx; } }
#pragma unroll
        for (int i = 0; i < 2; ++i) { const int idx = tid + 512 * i, s = idx >> 4, ch = idx & 15;
            if (s >= 3) *(LAS v4u*)(Kl + s * ML_RST + ch * 16) = cur.k[i];
            *(LAS v4u*)(Vw + s * ML_RST + ch * 16) = scale_bf16x8(cur.v[i], __shfl(wkv, s)); }
        if (tid < 384) { float y = pb;
#pragma unroll
            for (int j = 0; j < 4; ++j) { const float xv = prr == 0 ? cur.x[j] : (prr == 1 ? cur.x[j + 1] : cur.x[j + 2]); y += pw[j] * xv; }
            *(LAS bf16*)(Kl + prr * ML_RST + (tid & 127) * 2) = (bf16)f2bf(y * 0.08838834764831845f / (1.0f + __expf(-y))); }
        if (un < 2048) ml_load_a(nxt, a, un, tid, lane);
        __syncthreads();
        {
            const int d = 16 * w + (lane & 15), sq = lane >> 4; float acc = 0.f;
#pragma unroll
            for (int s = 0; s < 16; ++s) acc += wk[16 * sq + s] * bf2f(*(const LAS bf16*)(Kl + (16 * sq + s) * ML_RST + d * 2));
            acc += __shfl_xor(acc, 16); acc += __shfl_xor(acc, 32);
            if (lane < 16) a.DN[(size_t)u * 128 + d] = acc; }
        const int dt = w >> 1, et0 = 2 * (w & 1);
        f32x16 c0, c1;
#pragma unroll
        for (int r = 0; r < 16; ++r) { c0[r] = 0.f; c1[r] = 0.f; }
#pragma unroll
        for (int kk = 0; kk < 4; ++kk) {
            const LAS unsigned char* ka = Kl + tro + 16 * kk * ML_RST + dt * 64; const LAS unsigned char* va = Vw + tro + 16 * kk * ML_RST + et0 * 64;
            const bf16x8 A = cat8(tr16(ka), tr16(ka + 4 * ML_RST)), B0 = cat8(tr16(va), tr16(va + 4 * ML_RST)), B1 = cat8(tr16(va + 64), tr16(va + 4 * ML_RST + 64));
            c0 = __builtin_amdgcn_mfma_f32_32x32x16_bf16(A, B0, c0, 0, 0, 0); c1 = __builtin_amdgcn_mfma_f32_32x32x16_bf16(A, B1, c1, 0, 0, 0);
        }
        bf16* dcu = a.DC + (size_t)u * 16384;
#pragma unroll
        for (int g = 0; g < 4; ++g) {
            const int fo0 = (((et0 * 8 + 2 * dt + (g >> 1)) * 64) + (lane & 31) + 32 * (g & 1)) * 8 + 4 * hh, fo1 = fo0 + 8 * 64 * 8;
            *(GAS unsigned long long*)(dcu + fo0) = (unsigned long long)cvtpk(c0[4 * g], c0[4 * g + 1]) | ((unsigned long long)cvtpk(c0[4 * g + 2], c0[4 * g + 3]) << 32);
            *(GAS unsigned long long*)(dcu + fo1) = (unsigned long long)cvtpk(c1[4 * g], c1[4 * g + 1]) | ((unsigned long long)cvtpk(c1[4 * g + 2], c1[4 * g + 3]) << 32);
        }
        cur = nxt;
    }
}
__device__ __forceinline__ void ml_pass_b(Frame& F, const MixArgs& a) {
    LAS float* scl = (LAS float*)(F.lds + RING_OFF);
    const int tid = F.tid;
    for (int u = F.vcu; u < 256; u += F.G) {
        const int bh = u >> 2, qtr = u & 3;
        __syncthreads();
        if (tid < 64) scl[tid] = a.SCAL[(size_t)bh * 64 + tid];
        __syncthreads();
        const size_t base = (size_t)bh * 32 * 16384 + qtr * 4096 + tid * 8;
        float C[8], nv = 0.f, ms = 0.f;
#pragma unroll
        for (int i = 0; i < 8; ++i) C[i] = 0.f;
        v4u ring[8];
#pragma unroll
        for (int i = 0; i < 8; ++i) ring[i] = *(const GAS v4u*)(a.DC + base + (size_t)i * 16384);
#pragma unroll
        for (int c = 0; c < 32; ++c) {
            v4u o; o.x = pk2(C[0], C[1]); o.y = pk2(C[2], C[3]); o.z = pk2(C[4], C[5]); o.w = pk2(C[6], C[7]);
            *(GAS v4u*)(a.CS + base + (size_t)c * 16384) = o;
            if (tid < 32) a.NS[(size_t)(bh * 32 + c) * 128 + qtr * 32 + tid] = nv;
            if (qtr == 0 && tid == 0) a.MS[bh * 32 + c] = ms;
            if (c < 31) {
                const float bl = scl[2 * c], pm = scl[2 * c + 1], M = fmaxf(pm, ms), sc = __expf(pm - M), dec = __expf(ms - M);
                ms = bl + M;
                const v4u d = ring[c & 7];
                if (c + 8 < 31) ring[c & 7] = *(const GAS v4u*)(a.DC + base + (size_t)(c + 8) * 16384);
                C[0] = dec * C[0] + sc * __uint_as_float(d.x << 16); C[1] = dec * C[1] + sc * __uint_as_float(d.x & 0xffff0000u);
                C[2] = dec * C[2] + sc * __uint_as_float(d.y << 16); C[3] = dec * C[3] + sc * __uint_as_float(d.y & 0xffff0000u);
                C[4] = dec * C[4] + sc * __uint_as_float(d.z << 16); C[5] = dec * C[5] + sc * __uint_as_float(d.z & 0xffff0000u);
                C[6] = dec * C[6] + sc * __uint_as_float(d.w << 16); C[7] = dec * C[7] + sc * __uint_as_float(d.w & 0xffff0000u);
                if (tid < 32) nv = dec * nv + sc * a.DN[(size_t)(bh * 32 + c) * 128 + qtr * 32 + tid];
            }
        }
    }
}
struct CRegs { v4u q[2], k[2], v[2]; float xq[6], xk[6]; float lf, li, ms, nsv; };
__device__ __forceinline__ void ml_load_c(CRegs& r, const MixArgs& a, int u, int tid, int lane) {
    const int bh = u >> 5, c = u & 31, b = bh >> 2, h = bh & 3; const size_t row0 = (size_t)b * SEQ + 64 * c;
#pragma unroll
    for (int i = 0; i < 2; ++i) { const int idx = tid + 512 * i, s = idx >> 4, ch = idx & 15; const bf16* pr = a.PROJ + (row0 + s) * NIN + h * 128 + ch * 8;
        if (s >= 3) { r.q[i] = *(const GAS v4u*)(pr + C_QM); r.k[i] = *(const GAS v4u*)(pr + C_KM); }
        r.v[i] = *(const GAS v4u*)(pr + C_VM); }
    if (tid < 384) { const int chq = h * 128 + (tid & 127), slab = b * 32 + c;
#pragma unroll
        for (int j = 0; j < 3; ++j) { r.xq[j] = c > 0 ? a.QKLAST[(size_t)((slab - 1) * 3 + j) * 1024 + chq] : 0.f; r.xq[3 + j] = a.QKFIRST[(size_t)(slab * 3 + j) * 1024 + chq];
                                      r.xk[j] = c > 0 ? a.QKLAST[(size_t)((slab - 1) * 3 + j) * 1024 + 512 + chq] : 0.f; r.xk[3 + j] = a.QKFIRST[(size_t)(slab * 3 + j) * 1024 + 512 + chq]; } }
    r.lf = a.GATES[(row0 + lane) * 8 + 4 + h]; r.li = a.GATES[(row0 + lane) * 8 + h]; r.ms = a.MS[u];
    if (tid < 128) r.nsv = a.NS[(size_t)u * 128 + tid];
}
__device__ __forceinline__ void ml_pass_c(Frame& F, const MixArgs& a) {
    LAS unsigned char* Ql = F.lds + RING_OFF; LAS unsigned char* Kl = Ql + 64 * ML_RSR; LAS unsigned char* Vl = Kl + 64 * ML_RSR;
    LAS float* al = (LAS float*)(Vl + 64 * ML_RST); LAS float* Ml = al + 64; LAS float* wil = Ml + 64; LAS float* enm = wil + 64; LAS float* nl = enm + 64; LAS float* ssq = nl + 128;
    const int tid = F.tid, lane = F.lane, w = F.wave, hh = lane >> 5, tl = lane & 31;
    const int et = w & 3, tt = w >> 2, t = 32 * tt + tl;
    int u = F.vcu;
    if (u >= 2048) return;
    const int hfix = (u >> 5) & 3, prr = tid >> 7, pchq = hfix * 128 + (tid & 127);
    float pwq[4], pwk[4], pbq = 0.f, pbk = 0.f;
    if (tid < 384) { pbq = a.cb[pchq]; pbk = a.cb[512 + pchq];
#pragma unroll
        for (int j = 0; j < 4; ++j) { pwq[j] = a.cw[j * 1024 + pchq]; pwk[j] = a.cw[j * 1024 + 512 + pchq]; } }
    f32x4 mn[4];
#pragma unroll
    for (int g = 0; g < 4; ++g) mn[g] = *(const GAS f32x4*)(a.mnorm + hfix * 128 + 32 * et + 8 * g + 4 * hh);
    const int trq = (4 * hh + ((lane & 15) >> 2)) * ML_RST + (32 * et + 16 * ((lane >> 4) & 1) + 4 * (lane & 3)) * 2;
    CRegs cur, nxt; ml_load_c(cur, a, u, tid, lane);
    for (; u < 2048; u += F.G) {
        const int un = u + F.G;
        const int bh = u >> 5, c = u & 31, b = bh >> 2, h = bh & 3;
        const size_t row0 = (size_t)b * SEQ + 64 * c;
        __syncthreads();
        if (w == 0) {
            float bc = cur.lf;
#pragma unroll
            for (int o = 1; o < 64; o <<= 1) { const float t_ = __shfl_up(bc, o); if (lane >= o) bc += t_; }
            const float av = cur.li - bc; float pm = av;
#pragma unroll
            for (int o = 1; o < 64; o <<= 1) { const float t_ = __shfl_up(pm, o); if (lane >= o) pm = fmaxf(pm, t_); }
            const float M = fmaxf(pm, cur.ms);
            al[lane] = av; Ml[lane] = M; wil[lane] = __expf(cur.ms - M); enm[lane] = __expf(-bc - M);
        }
        if (tid < 128) nl[tid] = cur.nsv;
#pragma unroll
        for (int i = 0; i < 2; ++i) { const int idx = tid + 512 * i, s = idx >> 4, ch = idx & 15;
            if (s >= 3) { *(LAS v4u*)(Ql + s * ML_RSR + ch * 16) = cur.q[i]; *(LAS v4u*)(Kl + s * ML_RSR + ch * 16) = cur.k[i]; }
            *(LAS v4u*)(Vl + s * ML_RST + ch * 16) = cur.v[i]; }
        if (tid < 384) { float yq = pbq, yk = pbk;
#pragma unroll
            for (int j = 0; j < 4; ++j) { const float xq = prr == 0 ? cur.xq[j] : (prr == 1 ? cur.xq[j + 1] : cur.xq[j + 2]), xk = prr == 0 ? cur.xk[j] : (prr == 1 ? cur.xk[j + 1] : cur.xk[j + 2]); yq += pwq[j] * xq; yk += pwk[j] * xk; }
            *(LAS bf16*)(Ql + prr * ML_RSR + (tid & 127) * 2) = (bf16)f2bf(yq / (1.0f + __expf(-yq)));
            *(LAS bf16*)(Kl + prr * ML_RSR + (tid & 127) * 2) = (bf16)f2bf(yk * 0.08838834764831845f / (1.0f + __expf(-yk))); }
        bf16x8 cf[8];
#pragma unroll
        for (int kk = 0; kk < 8; ++kk) cf[kk] = *(const GAS bf16x8*)(a.CS + (size_t)u * 16384 + ((et * 8 + kk) * 64 + lane) * 8);
        unsigned long long ogw[4];
#pragma unroll
        for (int g = 0; g < 4; ++g) ogw[g] = *(const GAS unsigned long long*)(a.PROJ + (row0 + t) * NIN + C_OM + h * 128 + 32 * et + 8 * g + 4 * hh);
        if (un < 2048) ml_load_c(nxt, a, un, tid, lane);
        __syncthreads();
        bf16x8 qf[8];
#pragma unroll
        for (int kk = 0; kk < 8; ++kk) qf[kk] = *(const LAS bf16x8*)(Ql + t * ML_RSR + (16 * kk + 8 * hh) * 2);
        float qn = 0.f;
#pragma unroll
        for (int kk = 0; kk < 8; ++kk) { const f32x4 n0 = *(const LAS f32x4*)(nl + 16 * kk + 8 * hh), n1 = *(const LAS f32x4*)(nl + 16 * kk + 8 * hh + 4);
            qn += bf2f((bf16)qf[kk][0]) * n0.x + bf2f((bf16)qf[kk][1]) * n0.y + bf2f((bf16)qf[kk][2]) * n0.z + bf2f((bf16)qf[kk][3]) * n0.w
                + bf2f((bf16)qf[kk][4]) * n1.x + bf2f((bf16)qf[kk][5]) * n1.y + bf2f((bf16)qf[kk][6]) * n1.z + bf2f((bf16)qf[kk][7]) * n1.w; }
        qn += __shfl_xor(qn, 32);
        const float Mt = Ml[t], wi = wil[t];
        f32x16 numI; float dsum = 0.f;
#pragma unroll
        for (int r = 0; r < 16; ++r) numI[r] = 0.f;
        for (int st = 0; st <= tt; ++st) {
            f32x16 S;
#pragma unroll
            for (int r = 0; r < 16; ++r) S[r] = 0.f;
#pragma unroll
            for (int kk = 0; kk < 8; ++kk) { const bf16x8 kfr = *(const LAS bf16x8*)(Kl + (32 * st + tl) * ML_RSR + (16 * kk + 8 * hh) * 2); S = __builtin_amdgcn_mfma_f32_32x32x16_bf16(kfr, qf[kk], S, 0, 0, 0); }
            float P[16];
            const bool diag = (st == tt);
#pragma unroll
            for (int g = 0; g < 4; ++g) { const f32x4 a4 = *(const LAS f32x4*)(al + 32 * st + 8 * g + 4 * hh);
#pragma unroll
                for (int j = 0; j < 4; ++j) { float p = S[4 * g + j] * __expf(a4[j] - Mt); if (diag && (8 * g + 4 * hh + j) > tl) p = 0.f; P[4 * g + j] = p; dsum += p; } }
            const bf16x8 pb0 = pack8(P), pb1 = pack8(P + 8);
            const LAS unsigned char* tv = Vl + 32 * st * ML_RST + trq;
            const bf16x8 A0 = cat8(tr16(tv), tr16(tv + 8 * ML_RST)), A1 = cat8(tr16(tv + 16 * ML_RST), tr16(tv + 24 * ML_RST));
            numI = __builtin_amdgcn_mfma_f32_32x32x16_bf16(A0, pb0, numI, 0, 0, 0); numI = __builtin_amdgcn_mfma_f32_32x32x16_bf16(A1, pb1, numI, 0, 0, 0);
        }
        dsum += __shfl_xor(dsum, 32);
        f32x16 qc;
#pragma unroll
        for (int r = 0; r < 16; ++r) qc[r] = 0.f;
#pragma unroll
        for (int kk = 0; kk < 8; ++kk) qc = __builtin_amdgcn_mfma_f32_32x32x16_bf16(cf[kk], qf[kk], qc, 0, 0, 0);
        const float den = dsum + wi * qn, rdn = 1.0f / fmaxf(fabsf(den), enm[t]);
        float hv[16], ss = 0.f;
#pragma unroll
        for (int r = 0; r < 16; ++r) { hv[r] = (numI[r] + wi * qc[r]) * rdn; ss += hv[r] * hv[r]; }
        ss += __shfl_xor(ss, 32);
        if (hh == 0) ssq[et * 64 + t] = ss;
        __syncthreads();
        const float rstd = 1.0f / sqrtf(((ssq[t] + ssq[64 + t]) + (ssq[128 + t] + ssq[192 + t])) * (1.f / 128.f) + EPS);
#pragma unroll
        for (int g = 0; g < 4; ++g) { const int e = h * 128 + 32 * et + 8 * g + 4 * hh;
            const unsigned lo = (unsigned)ogw[g], hi = (unsigned)(ogw[g] >> 32);
            const float o0 = sigmoidf_(__uint_as_float(lo << 16)) * hv[4 * g] * rstd * mn[g].x, o1 = sigmoidf_(__uint_as_float(lo & 0xffff0000u)) * hv[4 * g + 1] * rstd * mn[g].y;
            const float o2 = sigmoidf_(__uint_as_float(hi << 16)) * hv[4 * g + 2] * rstd * mn[g].z, o3 = sigmoidf_(__uint_as_float(hi & 0xffff0000u)) * hv[4 * g + 3] * rstd * mn[g].w;
            *(GAS unsigned long long*)(a.MIXIN + (row0 + t) * D + e) = (unsigned long long)cvtpk(o0, o1) | ((unsigned long long)cvtpk(o2, o3) << 32); }
        cur = nxt;
    }
}
__device__ __forceinline__ void p2_mixers_naive(Frame& F, const MixArgs& a) {
    const int bx = blockIdx.x;
    if (bx < 64) { mlstm_naive_unit(F, a, bx >> 2, bx & 3); __syncthreads(); }
#if defined(MK_SB_NAIVE)
    else { for (int u = bx - 64; u < 512; u += (F.G - 64)) { const int qblk = 3 - (u >> 7), bh = u & 127; sb_naive_unit(F, a, bh >> 3, bh & 7, qblk); } }
#else
    sb_phase(F, a.PROJ, a.MIXIN);
#endif
}

__device__ __forceinline__ void p3b_rows(Frame& F, const float* x, const bf16* MIX, const float* g1, const float* g2, float* out, bf16* H) {
    const int gw = F.vcu * NWAVES + F.wave, NGW = F.G * NWAVES;
    f32x4 ga[4], gb[4];
#pragma unroll
    for (int j = 0; j < 4; ++j) { ga[j] = ((const GAS f32x4*)g1)[64 * j + F.lane]; gb[j] = ((const GAS f32x4*)g2)[64 * j + F.lane]; }
    constexpr int RB = 4;
    for (int m0 = gw; m0 < T; m0 += NGW * RB) {
        f32x4 mv[RB][4], xv[RB][4];
#pragma unroll
        for (int q = 0; q < RB; ++q) { const int m = m0 + NGW * q; if (m < T) { ld_bf16_row16(MIX + (size_t)m * D, F.lane, mv[q]);
            const GAS f32x4* xr = (const GAS f32x4*)(x + (size_t)m * D) + F.lane;
#pragma unroll
            for (int j = 0; j < 4; ++j) xv[q][j] = xr[64 * j]; } }
#pragma unroll
        for (int q = 0; q < RB; ++q) { const int m = m0 + NGW * q; if (m < T) {
            const float r1 = 1.0f / sqrtf(wave_sum(sumsq16(mv[q])) * (1.f / D) + EPS);
#pragma unroll
            for (int j = 0; j < 4; ++j) xv[q][j] = xv[q][j] + mv[q][j] * r1 * ga[j];
            GAS f32x4* orow = (GAS f32x4*)(out + (size_t)m * D) + F.lane;
#pragma unroll
            for (int j = 0; j < 4; ++j) orow[64 * j] = xv[q][j];
            const float r2 = 1.0f / sqrtf(wave_sum(sumsq16(xv[q])) * (1.f / D) + EPS);
            GAS unsigned long long* o8 = (GAS unsigned long long*)(H + (size_t)m * D) + F.lane;
#pragma unroll
            for (int j = 0; j < 4; ++j) { const f32x4 hv = xv[q][j] * r2 * gb[j]; o8[64 * j] = (unsigned long long)pk2(hv.x, hv.y) | ((unsigned long long)pk2(hv.z, hv.w) << 32); }
        } }
    }
}
__device__ __forceinline__ void p6_rows(Frame& F, const bf16* Y, const float* g3, float* out) {
    const int gw = F.vcu * NWAVES + F.wave, NGW = F.G * NWAVES;
    f32x4 ga[4];
#pragma unroll
    for (int j = 0; j < 4; ++j) ga[j] = ((const GAS f32x4*)g3)[64 * j + F.lane];
    constexpr int RB = 4;
    for (int m0 = gw; m0 < T; m0 += NGW * RB) {
        f32x4 yv[RB][4], xv[RB][4];
#pragma unroll
        for (int q = 0; q < RB; ++q) { const int m = m0 + NGW * q; if (m < T) { ld_bf16_row16(Y + (size_t)m * D, F.lane, yv[q]);
            const GAS f32x4* orow = (const GAS f32x4*)(out + (size_t)m * D) + F.lane;
#pragma unroll
            for (int j = 0; j < 4; ++j) xv[q][j] = orow[64 * j]; } }
#pragma unroll
        for (int q = 0; q < RB; ++q) { const int m = m0 + NGW * q; if (m < T) {
            const float r1 = 1.0f / sqrtf(wave_sum(sumsq16(yv[q])) * (1.f / D) + EPS);
            GAS f32x4* orow = (GAS f32x4*)(out + (size_t)m * D) + F.lane;
#pragma unroll
            for (int j = 0; j < 4; ++j) orow[64 * j] = xv[q][j] + yv[q][j] * r1 * ga[j];
        } }
    }
}
__device__ __forceinline__ void p4b_fixup(Frame& F, const float* cw, const float* cb, const float* GFIRST, const float* GLAST, const float* UFIRST, bf16* ACT) {
    constexpr int C4 = DFF / 4, TOTAL = 512 * 2 * C4;
    for (int it = F.vcu * NWAVES * 64 + F.tid; it < TOTAL; it += F.G * NWAVES * 64) {
        const int c4 = it % C4, rs = it / C4, rr = rs & 1, s = rs >> 1; const bool first = (s & 31) == 0;
        const f32x4 z4 = {0.f, 0.f, 0.f, 0.f};
        const f32x4 g0 = *(const GAS f32x4*)(GFIRST + (size_t)(s * 2 + rr) * DFF + 4 * c4);
        f32x4 gm1, gm2;
        if (rr == 0) { gm1 = first ? z4 : *(const GAS f32x4*)(GLAST + (size_t)((s - 1) * 2 + 1) * DFF + 4 * c4); gm2 = first ? z4 : *(const GAS f32x4*)(GLAST + (size_t)((s - 1) * 2 + 0) * DFF + 4 * c4); }
        else { gm1 = *(const GAS f32x4*)(GFIRST + (size_t)(s * 2 + 0) * DFF + 4 * c4); gm2 = first ? z4 : *(const GAS f32x4*)(GLAST + (size_t)((s - 1) * 2 + 1) * DFF + 4 * c4); }
        const f32x4 w0 = *(const GAS f32x4*)(cw + 4 * c4), w1 = *(const GAS f32x4*)(cw + DFF + 4 * c4), w2 = *(const GAS f32x4*)(cw + 2 * DFF + 4 * c4), bb = *(const GAS f32x4*)(cb + 4 * c4);
        const f32x4 uu = *(const GAS f32x4*)(UFIRST + (size_t)(s * 2 + rr) * DFF + 4 * c4);
        const f32x4 cv = w2 * g0 + w1 * gm1 + w0 * gm2 + bb;
        const float a0 = pg8::gelu_tanh(cv.x) * uu.x, a1 = pg8::gelu_tanh(cv.y) * uu.y, a2 = pg8::gelu_tanh(cv.z) * uu.z, a3 = pg8::gelu_tanh(cv.w) * uu.w;
        *(GAS unsigned long long*)(ACT + (size_t)(64 * s + rr) * DFF + 4 * c4) = (unsigned long long)pk2(a0, a1) | ((unsigned long long)pk2(a2, a3) << 32);
    }
}

struct Args { const float* in[16]; float* out; unsigned char* ws; int ph_lo, ph_hi; };
constexpr int N_PHASES = 9;
__global__ void __launch_bounds__(NWAVES * 64, 2) mega_fwd(Args args) {
    extern __shared__ __attribute__((aligned(16))) unsigned char lds[];
    Frame F;
    F.lds = (LAS unsigned char*)lds;
    F.MISC = (volatile LAS unsigned*)(F.lds + MISC_OFF);
    F.tid = threadIdx.x; F.lane = F.tid & 63; F.wave = __builtin_amdgcn_readfirstlane(F.tid >> 6);
    F.G = gridDim.x; { const int bx = blockIdx.x; F.vcu = (F.G % 8 == 0) ? (bx % 8) * (F.G / 8) + bx / 8 : bx; }
    unsigned char* ws = args.ws;
    F.ctl = (gu32*)(ws + WS_CTL);
    const float* x = args.in[0]; const float* g_pre = args.in[1]; const float* w_in = args.in[2]; const float* mconv_w = args.in[3]; const float* mconv_b = args.in[4];
    const float* b_i = args.in[5]; const float* b_f = args.in[6]; const float* mnorm = args.in[7]; const float* w_out = args.in[8]; const float* g_postmix = args.in[9];
    const float* g_preffn = args.in[10]; const float* w_up = args.in[11]; const float* fconv_w = args.in[12]; const float* fconv_b = args.in[13]; const float* w_down = args.in[14];
    const float* g_postffn = args.in[15];
    bf16* WT_IN = (bf16*)(ws + WS_WIN); bf16* WT_OUT = (bf16*)(ws + WS_WOUT); bf16* WT_UP = (bf16*)(ws + WS_WUP); bf16* WT_DN = (bf16*)(ws + WS_WDN);
    float* GATES = (float*)(ws + WS_GATES); bf16* H = (bf16*)(ws + WS_H); bf16* PROJ = (bf16*)(ws + WS_PROJ); bf16* MIXIN = (bf16*)(ws + WS_MIXIN); bf16* MIX = (bf16*)(ws + WS_MIX);
    float* QKFIRST = (float*)(ws + WS_QKFIRST); float* QKLAST = (float*)(ws + WS_QKLAST); float* DN = (float*)(ws + WS_DN); float* NS = (float*)(ws + WS_NS); float* SCAL = (float*)(ws + WS_SCAL); float* MS = (float*)(ws + WS_MS);
    bf16* ACT = (bf16*)(ws + WS_ACT); float* GFIRST = (float*)(ws + WS_GFIRST); float* GLAST = (float*)(ws + WS_GLAST); float* UFIRST = (float*)(ws + WS_UFIRST); bf16* Y = (bf16*)(ws + WS_Y);
    for (int u = F.tid; u < (LDS_BYTES - LDSCTL_OFF) / 4; u += NWAVES * 64) ((LAS unsigned*)(F.lds + LDSCTL_OFF))[u] = 0u;
    __syncthreads();
    XcdBarrier bar = xcd_barrier_post((unsigned*)(F.ctl + CW_BAR), F.MISC + 8);
    const int lo = args.ph_lo, hi = args.ph_hi;
#define IN(k) (lo <= (k) && (k) < hi)
#define SEAM(k) do { if (IN(k) && IN((k) + 1)) xcd_barrier(bar); } while (0)
#ifndef MK_PROBE_MASK
#define MK_PROBE_MASK 0
#endif
#define REPS(k) _Pragma("nounroll") for (int rep_ = 0; rep_ < ((((MK_PROBE_MASK) >> (k)) & 1) ? 2 : 1); ++rep_)
#define GREPS(k) ((((MK_PROBE_MASK) >> (k)) & 1) ? 2 : 1)
#define REPBAR() do { if (rep_) xcd_barrier(bar); } while (0)

    if (IN(0)) REPS(0) { REPBAR(); const P0Args a{x, g_pre, w_in, b_i, b_f, w_out, w_up, w_down, WT_IN, WT_OUT, WT_UP, WT_DN, H, GATES}; p0_prologue(F, a); }
    SEAM(0);
    if (IN(1)) { pg8::Gemm g{H, WT_IN, T, NIN, D}; pg8::StaticOrder S; S.init(T, NIN, F.G, (int)blockIdx.x, GREPS(1));
        pg8::EpiProj E{PROJ, mconv_w, mconv_b, QKFIRST, QKLAST};
        pg8::gemm_phase<pg8::EpiProj, pg8::StaticOrder, true, true>(F.lds + RING_OFF, g, S, E); }
    SEAM(1);
    {
        const MixArgs a{PROJ, GATES, mconv_w, mconv_b, mnorm, args.out, MIXIN, QKFIRST, QKLAST, (bf16*)args.out, (bf16*)args.out + (size_t)2048 * 16384, DN, NS, SCAL, MS};
#if defined(MK_MLSTM_NAIVE)
        if (IN(2)) p2_mixers_naive(F, a);
#else
        if (IN(2)) REPS(2) { REPBAR(); ml_pass_a(F, a); xcd_barrier(bar); ml_pass_b(F, a); __syncthreads(); sb_phase(F, a.PROJ, a.MIXIN); xcd_barrier(bar); ml_pass_c(F, a); }
#endif
    }
    SEAM(2);
    if (IN(3)) { pg8::Gemm g{MIXIN, WT_OUT, T, D, D}; pg8::StaticOrder S; S.init(T, D, F.G, (int)blockIdx.x, GREPS(3));
        pg8::EpiBf16<0> E{MIX, D, nullptr, 0, 0, 1.f};
        pg8::gemm_phase<pg8::EpiBf16<0>, pg8::StaticOrder, true, true>(F.lds + RING_OFF, g, S, E); }
    SEAM(3);
    if (IN(4)) REPS(4) { REPBAR(); p3b_rows(F, x, MIX, g_postmix, g_preffn, args.out, H); }
    SEAM(4);
    if (IN(5)) { pg8::Gemm g{H, WT_UP, T, NUP, D}; pg8::StaticOrder S; S.init(T, NUP, F.G, (int)blockIdx.x, GREPS(5));
        pg8::EpiGateUp E{ACT, fconv_w, fconv_b, GFIRST, GLAST, UFIRST};
        pg8::gemm_phase<pg8::EpiGateUp, pg8::StaticOrder, true, true>(F.lds + RING_OFF, g, S, E); }
    SEAM(5);
    if (IN(6)) REPS(6) { REPBAR(); p4b_fixup(F, fconv_w, fconv_b, GFIRST, GLAST, UFIRST, ACT); }
    SEAM(6);
    if (IN(7)) { pg8::Gemm g{ACT, WT_DN, T, D, DFF}; pg8::StaticOrder S; S.init(T, D, F.G, (int)blockIdx.x, GREPS(7));
        pg8::EpiBf16<0> E{Y, D, nullptr, 0, 0, 1.f};
        pg8::gemm_phase<pg8::EpiBf16<0>, pg8::StaticOrder, true, true>(F.lds + RING_OFF, g, S, E); }
    SEAM(7);
    if (IN(8)) p6_rows(F, Y, g_postffn, args.out);
#undef IN
#undef SEAM
}
}

#ifndef MK_N_LAUNCHES
#define MK_N_LAUNCHES 1
#endif
extern "C" void kernel_launch(void* const* d_in, const int* in_sizes, int n_in, void* d_out, int out_size, void* d_ws, size_t ws_size, hipStream_t stream) {
    using namespace mk;
    static int grid = 0;
    if (grid == 0) {
        if (n_in != 16 || in_sizes[0] != T * D || out_size != T * D || ws_size < WS_END) { fprintf(stderr, "kernel_launch: unexpected shapes / workspace (n_in %d, ws %zu); nothing launched\n", n_in, ws_size); grid = -1; return; }
        int dev = 0, cus = 0, per_cu = 0;
        if (hipGetDevice(&dev) != hipSuccess || hipDeviceGetAttribute(&cus, hipDeviceAttributeMultiprocessorCount, dev) != hipSuccess) { grid = -1; return; }
        if (hipFuncSetAttribute((const void*)mega_fwd, hipFuncAttributeMaxDynamicSharedMemorySize, LDS_BYTES) != hipSuccess) { fprintf(stderr, "kernel_launch: hipFuncSetAttribute failed\n"); grid = -1; return; }
        if (hipOccupancyMaxActiveBlocksPerMultiprocessor(&per_cu, (const void*)mega_fwd, NWAVES * 64, LDS_BYTES) != hipSuccess || per_cu < 1) { fprintf(stderr, "kernel_launch: occupancy query says %d blocks per CU\n", per_cu); (void)hipGetLastError(); grid = -1; return; }
        grid = cus >= 128 ? (cus / 128) * 128 : 0;
        if (grid == 0) { grid = -1; return; }
    }
    if (grid < 0) return;
    if (hipMemsetAsync((char*)d_ws + WS_CTL, 0, CTL_ZERO_BYTES, stream) != hipSuccess) return;
    Args a{};
    for (int i = 0; i < 16; ++i) a.in[i] = (const float*)d_in[i];
    a.out = (float*)d_out; a.ws = (unsigned char*)d_ws;
#if MK_N_LAUNCHES == 1
    a.ph_lo = 0; a.ph_hi = N_PHASES;
    hipLaunchKernelGGL(mega_fwd, dim3(grid), dim3(NWAVES * 64), LDS_BYTES, stream, a);
#else
    for (int p = 0; p < N_PHASES; ++p) { a.ph_lo = p; a.ph_hi = p + 1; hipLaunchKernelGGL(mega_fwd, dim3(grid), dim3(NWAVES * 64), LDS_BYTES, stream, a); }
#endif
}
```

```cpp
#include <hip/hip_runtime.h>
#include <cstdio>
#include <cstdint>
#ifdef MK_PROBE_MASK
#define PG8_PROBE (MK_PROBE_MASK)
#else
#define PG8_PROBE 0
#endif
namespace pg8 {
#define PG8_LAS __attribute__((address_space(3)))
typedef unsigned short bf16_t;
typedef short bf16x8 __attribute__((ext_vector_type(8)));
typedef float f32x4 __attribute__((ext_vector_type(4)));
typedef unsigned u32x4 __attribute__((ext_vector_type(4)));
constexpr int BM = 256, BK = 64, HALF = 128, HTB = HALF * BK * 2  , STAGE_BYTES = 8 * HTB, NXCD = 8, WGM = 8;

__host__ __device__ __forceinline__ int lds_byte(int r, int c) { const int st = (r >> 4) * 2 + (c >> 5), rr = r & 15, cc = c & 31, ob = rr * 64 + cc * 2; return st * 1024 + (ob ^ (((ob >> 9) & 1) << 5)); }
__host__ __device__ __forceinline__ void stage_rc(int b, int& R, int& C) { const int st = b / 1024, sb = b % 1024, swz = sb ^ (((sb >> 9) & 1) << 5); R = (st >> 1) * 16 + swz / 64; C = (st & 1) * 32 + (swz % 64) / 2; }
__host__ __device__ __forceinline__ int perm32(int rho) { const int n = rho >> 4, i = rho & 15; return 8 * (i >> 2) + 4 * n + (i & 3); }

struct Unit { int pm, pn; };
struct Gemm { const bf16_t* A; const bf16_t* Bt; int M, N, K; };

struct StaticOrder {
    int nM, nN, nwg, G, c, nrep;
    __host__ __device__ void init(int M, int N, int G_, int c_, int nrep_ = 1) { nM = M / BM; nN = N / BM; nwg = nM * nN; G = G_; c = c_; nrep = nrep_; }
    __host__ __device__ bool next(int i, Unit& u) const {
        const long L = (long)i * G + c; if (L >= (long)nwg * nrep) return false;
        int wgid = (int)(L % nwg); { const int q = nwg / NXCD, r = nwg % NXCD, xcd = wgid % NXCD, off = wgid / NXCD; wgid = (xcd < r ? xcd * (q + 1) : r * (q + 1) + (xcd - r) * q) + off; }
        const int nig = WGM * nN, gid = wgid / nig, fm = gid * WGM, gsz = (nM - fm) < WGM ? (nM - fm) : WGM;
        u.pm = fm + ((wgid % nig) % gsz); u.pn = (wgid % nig) / gsz; return true;
    }
    __device__ __forceinline__ void a_ready(const Unit&) const {}
    __device__ __forceinline__ void done(const Unit&) const {}
};

__device__ __forceinline__ unsigned cvt_pk_bf16(float lo, float hi) { unsigned r; asm volatile("v_cvt_pk_bf16_f32 %0, %1, %2" : "=v"(r) : "v"(lo), "v"(hi)); return r; }
typedef float f32x2 __attribute__((ext_vector_type(2)));
__device__ __forceinline__ f32x2 gelu_pk(f32x2 v) {
    const f32x2 av = __builtin_elementwise_abs(v), d = av * 0.2316418882f + 1.0f;
    f32x2 t; t.x = __builtin_amdgcn_rcpf(d.x); t.y = __builtin_amdgcn_rcpf(d.y);
    f32x2 q = t * 0.5307027145f + (-0.7265760135f); q = q * t + 0.7107068705f; q = q * t + (-0.142248368f); q = q * t + 0.127414796f; q = q * t;
    const f32x2 s = (v * v) * (-0.72134752044f);
    f32x2 e; e.x = __builtin_amdgcn_exp2f(s.x); e.y = __builtin_amdgcn_exp2f(s.y);
    const f32x2 m = v * (q * e), r = v - m;
    f32x2 o; o.x = v.x < 0.f ? m.x : r.x; o.y = v.y < 0.f ? m.y : r.y; return o;
}

template <int ACT  > struct EpiBf16 {
    static constexpr bool PERM = true, AFTER_DRAIN = false, TWICE = (PG8_PROBE >> 16) & 1; static_assert(ACT == 0 || ACT == 1, "EpiBf16: ACT is 0 (none) or 1 (gelu_pk)");
    bf16_t* O; int ldc; const float* bias; int split_cols; size_t split_stride; float scale0;
    __device__ __forceinline__ void operator()(const f32x4 (&acc)[2][2][4][2], const Unit& u, int wr, int wc, int fr, int fq) const {
        const int row0 = u.pm * BM + wr * 64 + fr; int colt = u.pn * BM; bf16_t* base = O;
        float sc = 1.f; if (split_cols) { const int t = colt / split_cols; base += (size_t)t * split_stride; colt -= t * split_cols; if (t == 0) sc = scale0; }
        const int col0 = colt + wc * 32 + 8 * fq, bcol0 = u.pn * BM + wc * 32 + 8 * fq;
        f32x4 bv[2][2];
#pragma unroll
        for (int bj = 0; bj < 2; ++bj)
#pragma unroll
            for (int n = 0; n < 2; ++n) bv[bj][n] = bias ? *(const f32x4*)(bias + bcol0 + bj * HALF + 4 * n) : (f32x4){0.f, 0.f, 0.f, 0.f};
#pragma unroll
        for (int ai = 0; ai < 2; ++ai)
#pragma unroll
            for (int m = 0; m < 4; ++m) { bf16_t* rowp = base + (size_t)(row0 + ai * HALF + m * 16) * ldc + col0;
#pragma unroll
                for (int bj = 0; bj < 2; ++bj) { f32x4 v0 = acc[ai][bj][m][0] + bv[bj][0], v1 = acc[ai][bj][m][1] + bv[bj][1];
                    if (ACT == 1) { f32x2 a = gelu_pk((f32x2){v0[0], v0[1]}), b = gelu_pk((f32x2){v0[2], v0[3]}), c = gelu_pk((f32x2){v1[0], v1[1]}), d = gelu_pk((f32x2){v1[2], v1[3]});
                        v0 = (f32x4){a.x, a.y, b.x, b.y}; v1 = (f32x4){c.x, c.y, d.x, d.y}; }
                    v0 = v0 * sc; v1 = v1 * sc; u32x4 w; w.x = cvt_pk_bf16(v0[0], v0[1]); w.y = cvt_pk_bf16(v0[2], v0[3]); w.z = cvt_pk_bf16(v1[0], v1[1]); w.w = cvt_pk_bf16(v1[2], v1[3]);
                    *(u32x4*)(rowp + bj * HALF) = w; } }
    }
};

__device__ __forceinline__ float gelu_tanh(float x) {
    const float y = x * (2.3022082f * (1.0f + 0.044715f * x * x));
    return x * __builtin_amdgcn_rcpf(1.0f + __builtin_amdgcn_exp2f(-y));
}
__device__ __forceinline__ float silu_fast(float x) { return x * __builtin_amdgcn_rcpf(1.0f + __builtin_amdgcn_exp2f(-1.4426950408889634f * x)); }
template <int N> __device__ __forceinline__ float ror16(float v) { return __int_as_float(__builtin_amdgcn_update_dpp(0, __float_as_int(v), 0x120 + N, 0xf, 0xf, false)); }
struct EpiGateUp {
    static constexpr bool PERM = true, AFTER_DRAIN = false, TWICE = (PG8_PROBE >> 14) & 1;
    static constexpr int DFF = 2816;
    bf16_t* ACT; const float* cw; const float* cb; float* GFIRST; float* GLAST; float* UFIRST;
    __device__ __forceinline__ void operator()(const f32x4 (&acc)[2][2][4][2], const Unit& u, int wr, int wc, int fr, int fq) const {
        const int colg = u.pn * 128 + wc * 32 + 8 * fq;
        f32x4 w0[2], w1[2], w2[2], bb[2];
#pragma unroll
        for (int n = 0; n < 2; ++n) { w0[n] = *(const f32x4*)(cw + colg + 4 * n); w1[n] = *(const f32x4*)(cw + DFF + colg + 4 * n); w2[n] = *(const f32x4*)(cw + 2 * DFF + colg + 4 * n); bb[n] = *(const f32x4*)(cb + colg + 4 * n); }
#pragma unroll
        for (int ai = 0; ai < 2; ++ai) {
            f32x4 pp1[2] = {{0.f, 0.f, 0.f, 0.f}, {0.f, 0.f, 0.f, 0.f}}, pp2[2] = {{0.f, 0.f, 0.f, 0.f}, {0.f, 0.f, 0.f, 0.f}};
            const int slab = u.pm * 4 + ai * 2 + wr;
#pragma unroll
            for (int m = 0; m < 4; ++m) {
                f32x4 g[2], uu[2], p1[2], p2[2];
#pragma unroll
                for (int n = 0; n < 2; ++n) { g[n] = acc[ai][0][m][n]; uu[n] = acc[ai][1][m][n];
#pragma unroll
                    for (int j = 0; j < 4; ++j) { p1[n][j] = ror16<1>(g[n][j]); p2[n][j] = ror16<2>(g[n][j]); } }
                const size_t row = (size_t)(u.pm * BM + ai * HALF + wr * 64 + m * 16 + fr);
                u32x4 w;
                unsigned pk[4];
#pragma unroll
                for (int n = 0; n < 2; ++n) {
                    const f32x4 g1 = fr >= 1 ? p1[n] : pp1[n], g2 = fr >= 2 ? p2[n] : pp2[n];
                    const f32x4 cv = w2[n] * g[n] + w1[n] * g1 + w0[n] * g2 + bb[n];
                    float a[4];
#pragma unroll
                    for (int j = 0; j < 4; ++j) a[j] = gelu_tanh(cv[j]) * uu[n][j];
                    pk[2 * n] = cvt_pk_bf16(a[0], a[1]); pk[2 * n + 1] = cvt_pk_bf16(a[2], a[3]);
                }
                w.x = pk[0]; w.y = pk[1]; w.z = pk[2]; w.w = pk[3];
                if (m == 0 && fr < 2) {
                    float* gf = GFIRST + (size_t)(slab * 2 + fr) * DFF + colg; float* uf = UFIRST + (size_t)(slab * 2 + fr) * DFF + colg;
                    *(f32x4*)gf = g[0]; *(f32x4*)(gf + 4) = g[1]; *(f32x4*)uf = uu[0]; *(f32x4*)(uf + 4) = uu[1];
                } else {
                    *(u32x4*)(ACT + row * DFF + colg) = w;
                }
                if (m == 3 && fr >= 14) { float* gl = GLAST + (size_t)(slab * 2 + (fr - 14)) * DFF + colg; *(f32x4*)gl = g[0]; *(f32x4*)(gl + 4) = g[1]; }
#pragma unroll
                for (int n = 0; n < 2; ++n) { pp1[n] = p1[n]; pp2[n] = p2[n]; }
            }
        }
    }
};

struct EpiProj {
    static constexpr bool PERM = true, AFTER_DRAIN = false, TWICE = (PG8_PROBE >> 15) & 1;
    static constexpr int LDC = 3584;
    bf16_t* O; const float* cw; const float* cb; float* QKFIRST; float* QKLAST;
    __device__ __forceinline__ void operator()(const f32x4 (&acc)[2][2][4][2], const Unit& u, int wr, int wc, int fr, int fq) const {
        if (u.pn < 4) {
            const float ksc = (u.pn >= 2) ? 0.08838834764831845f : 1.0f;
#pragma unroll
            for (int bj = 0; bj < 2; ++bj)
#pragma unroll
                for (int n = 0; n < 2; ++n) {
                    const int colc = u.pn * BM + bj * HALF + wc * 32 + 8 * fq + 4 * n;
                    const f32x4 w0 = *(const f32x4*)(cw + colc), w1 = *(const f32x4*)(cw + 1024 + colc), w2 = *(const f32x4*)(cw + 2048 + colc), w3 = *(const f32x4*)(cw + 3072 + colc), bb = *(const f32x4*)(cb + colc);
#pragma unroll
                    for (int ai = 0; ai < 2; ++ai) {
                        f32x4 pp1 = {0.f, 0.f, 0.f, 0.f}, pp2 = pp1, pp3 = pp1;
                        const int slab = u.pm * 4 + ai * 2 + wr;
#pragma unroll
                        for (int m = 0; m < 4; ++m) {
                            const f32x4 g = acc[ai][bj][m][n]; f32x4 p1, p2, p3;
#pragma unroll
                            for (int j = 0; j < 4; ++j) { p1[j] = ror16<1>(g[j]); p2[j] = ror16<2>(g[j]); p3[j] = ror16<3>(g[j]); }
                            const f32x4 g1 = fr >= 1 ? p1 : pp1, g2 = fr >= 2 ? p2 : pp2, g3 = fr >= 3 ? p3 : pp3;
                            const f32x4 cv = w3 * g + w2 * g1 + w1 * g2 + w0 * g3 + bb;
                            float o[4];
#pragma unroll
                            for (int j = 0; j < 4; ++j) o[j] = silu_fast(cv[j]) * ksc;
                            const size_t row = (size_t)(u.pm * BM + ai * HALF + wr * 64 + m * 16 + fr);
                            if (m == 0 && fr < 3) *(f32x4*)(QKFIRST + (size_t)(slab * 3 + fr) * 1024 + colc) = g;
                            else { typedef unsigned u32x2v __attribute__((ext_vector_type(2))); u32x2v w; w.x = cvt_pk_bf16(o[0], o[1]); w.y = cvt_pk_bf16(o[2], o[3]); *(u32x2v*)(O + row * LDC + colc) = w; }
                            if (m == 3 && fr >= 13) *(f32x4*)(QKLAST + (size_t)(slab * 3 + (fr - 13)) * 1024 + colc) = g;
                            pp1 = p1; pp2 = p2; pp3 = p3;
                        }
                    }
                }
            return;
        }
        const int row0 = u.pm * BM + wr * 64 + fr, col0 = u.pn * BM + wc * 32 + 8 * fq;
        const float sc = (u.pn == 8 || u.pn == 9) ? 0.18033688011112042f : 1.0f;
#pragma unroll
        for (int ai = 0; ai < 2; ++ai)
#pragma unroll
            for (int m = 0; m < 4; ++m) { bf16_t* rowp = O + (size_t)(row0 + ai * HALF + m * 16) * LDC + col0;
#pragma unroll
                for (int bj = 0; bj < 2; ++bj) { const f32x4 v0 = acc[ai][bj][m][0] * sc, v1 = acc[ai][bj][m][1] * sc;
                    u32x4 w; w.x = cvt_pk_bf16(v0[0], v0[1]); w.y = cvt_pk_bf16(v0[2], v0[3]); w.z = cvt_pk_bf16(v1[0], v1[1]); w.w = cvt_pk_bf16(v1[2], v1[3]);
                    *(u32x4*)(rowp + bj * HALF) = w; } }
    }
};
template <class Epi, class Sched, bool ALIGN_EPI = false, bool SP2 = false>
__device__ __forceinline__ void gemm_phase(PG8_LAS unsigned char* lds, const Gemm g, const Sched& S, const Epi& E) {
    const int tid = threadIdx.x, wid = __builtin_amdgcn_readfirstlane(tid >> 6), lane = tid & 63, wr = wid >> 2, wc = wid & 3, fr = lane & 15, fq = lane >> 4;
    const int K = g.K, nt = K / BK;
    unsigned voffA[2], voffB[2];
#pragma unroll
    for (int i = 0; i < 2; ++i) { int R, C; stage_rc(tid * 16 + i * 8192, R, C); const int Rb = Epi::PERM ? ((R & ~31) + perm32(R & 31)) : R;
        voffA[i] = (unsigned)(R * K + C) * 2u; voffB[i] = (unsigned)(Rb * K + C) * 2u; }
    const size_t kstep = (size_t)(BK * 2);
    const size_t hstep = (size_t)HALF * K * 2;
    const size_t tstep = 2 * hstep;
    const unsigned ldsw = (unsigned)wid * 1024u;
    const int aoff = lds_byte(wr * 64 + fr, fq * 8), boff = lds_byte(wc * 32 + fr, fq * 8);
#define PG8_SA(b, h) (((b) * 2 + (h)) * HTB)
#define PG8_SB(b, h) ((4 + (b) * 2 + (h)) * HTB)
#define PG8_STAGE(bufoff, gbase, voff) do { _Pragma("unroll") for (int _i = 0; _i < 2; ++_i) \
        __builtin_amdgcn_global_load_lds((const unsigned*)((const char*)(gbase) + (voff)[_i]), (PG8_LAS unsigned*)(lds + (bufoff) + ldsw + _i * 8192), 16, 0, 0); } while (0)
#define PG8_LDA(dst, b, h) do { _Pragma("unroll") for (int m = 0; m < 4; ++m) _Pragma("unroll") for (int k = 0; k < 2; ++k) dst[m][k] = *(const PG8_LAS bf16x8*)(lds + PG8_SA(b, h) + aoff + m * 2048 + k * 1024); } while (0)
#define PG8_LDB(dst, b, h) do { _Pragma("unroll") for (int n = 0; n < 2; ++n) _Pragma("unroll") for (int k = 0; k < 2; ++k) dst[n][k] = *(const PG8_LAS bf16x8*)(lds + PG8_SB(b, h) + boff + n * 2048 + k * 1024); } while (0)
#define PG8_MMA(ai, bj, At, Bt) do { __builtin_amdgcn_s_setprio(1); _Pragma("unroll") for (int m = 0; m < 4; ++m) _Pragma("unroll") for (int n = 0; n < 2; ++n) _Pragma("unroll") for (int k = 0; k < 2; ++k) \
        acc[ai][bj][m][n] = __builtin_amdgcn_mfma_f32_16x16x32_bf16(Bt[n][k], At[m][k], acc[ai][bj][m][n], 0, 0, 0); __builtin_amdgcn_s_setprio(0); } while (0)
#define PG8_WAIT_V(n) asm volatile("s_waitcnt vmcnt(" #n ")" ::: "memory")
#define PG8_WAIT_L(n) asm volatile("s_waitcnt lgkmcnt(" #n ")" ::: "memory")
#define PG8_BAR __builtin_amdgcn_s_barrier()
#define PG8_SCHED __builtin_amdgcn_sched_barrier(0)
    Unit cur, nxt; int ui = 0;
    if (!S.next(0, cur)) return;
    f32x4 acc[2][2][4][2];
#pragma unroll
    for (int a = 0; a < 2; ++a)
#pragma unroll
        for (int b = 0; b < 2; ++b)
#pragma unroll
            for (int m = 0; m < 4; ++m)
#pragma unroll
                for (int n = 0; n < 2; ++n) acc[a][b][m][n] = (f32x4){0.f, 0.f, 0.f, 0.f};
    bf16x8 At[4][2], B0[2][2], B1[2][2];
    const char* cA = (const char*)g.A + (size_t)cur.pm * tstep; const char* cB = (const char*)g.Bt + (size_t)cur.pn * tstep;
    S.a_ready(cur);
    if constexpr (SP2) {
        PG8_STAGE(PG8_SB(0, 0), cB, voffB); PG8_STAGE(PG8_SB(0, 1), cB + hstep, voffB); PG8_STAGE(PG8_SA(0, 0), cA, voffA); PG8_STAGE(PG8_SA(0, 1), cA + hstep, voffA);
        if (wr == 1) PG8_BAR;
        PG8_WAIT_V(2); PG8_BAR;
        PG8_STAGE(PG8_SB(1, 0), cB + kstep, voffB); PG8_STAGE(PG8_SA(1, 0), cA + kstep, voffA); PG8_STAGE(PG8_SB(1, 1), cB + hstep + kstep, voffB);
        PG8_WAIT_V(6); PG8_BAR;
    } else {
        PG8_STAGE(PG8_SB(0, 0), cB, voffB); PG8_STAGE(PG8_SA(0, 0), cA, voffA); PG8_STAGE(PG8_SB(0, 1), cB + hstep, voffB); PG8_STAGE(PG8_SA(0, 1), cA + hstep, voffA);
        if (wr == 1) PG8_BAR;
        PG8_WAIT_V(4); PG8_BAR;
        PG8_STAGE(PG8_SB(1, 0), cB + kstep, voffB); PG8_STAGE(PG8_SA(1, 0), cA + kstep, voffA); PG8_STAGE(PG8_SB(1, 1), cB + hstep + kstep, voffB);
        PG8_WAIT_V(6); PG8_BAR;
    }
    for (;;) {
        const bool has_next = S.next(ui + 1, nxt);
        const char* nA = has_next ? (const char*)g.A + (size_t)nxt.pm * tstep : cA; const char* nB = has_next ? (const char*)g.Bt + (size_t)nxt.pn * tstep : cB;
        for (int t = 0; t < nt; t += 2) {
            const bool last = (t == nt - 2);
            const char* a1 = cA + (size_t)(t + 1) * kstep;
            const char* a2 = last ? nA : cA + (size_t)(t + 2) * kstep; const char* b2 = last ? nB : cB + (size_t)(t + 2) * kstep;
            const char* a3 = a2 + kstep; const char* b3 = b2 + kstep;
            if (last && has_next) S.a_ready(nxt);
            if constexpr (SP2) {
            PG8_LDB(B0, 0, 0); PG8_LDB(B1, 0, 1); PG8_SCHED; PG8_LDA(At, 0, 0); PG8_STAGE(PG8_SA(1, 1), a1 + hstep, voffA);
            PG8_WAIT_V(8); PG8_WAIT_L(0); PG8_BAR; PG8_MMA(0, 0, At, B0); PG8_MMA(0, 1, At, B1); PG8_BAR; PG8_SCHED;
            PG8_LDA(At, 0, 1); PG8_STAGE(PG8_SB(0, 0), b2, voffB); PG8_STAGE(PG8_SB(0, 1), b2 + hstep, voffB); PG8_STAGE(PG8_SA(0, 0), a2, voffA);
            PG8_WAIT_V(8); PG8_WAIT_L(0); PG8_BAR; PG8_MMA(1, 0, At, B0); PG8_MMA(1, 1, At, B1); PG8_BAR; PG8_SCHED;
            PG8_LDB(B0, 1, 0); PG8_LDB(B1, 1, 1); PG8_SCHED; PG8_LDA(At, 1, 0); PG8_STAGE(PG8_SA(0, 1), a2 + hstep, voffA);
            PG8_WAIT_V(8); PG8_WAIT_L(0); PG8_BAR; PG8_MMA(0, 0, At, B0); PG8_MMA(0, 1, At, B1); PG8_BAR; PG8_SCHED;
            PG8_LDA(At, 1, 1); PG8_STAGE(PG8_SB(1, 0), b3, voffB); PG8_STAGE(PG8_SB(1, 1), b3 + hstep, voffB); PG8_STAGE(PG8_SA(1, 0), a3, voffA);
            PG8_WAIT_V(8); PG8_WAIT_L(0); PG8_BAR; PG8_MMA(1, 0, At, B0); PG8_MMA(1, 1, At, B1); PG8_BAR; PG8_SCHED;
            } else {
            PG8_LDB(B0, 0, 0); PG8_SCHED; PG8_LDA(At, 0, 0); PG8_STAGE(PG8_SA(1, 1), a1 + hstep, voffA);
            PG8_WAIT_L(8); PG8_BAR; PG8_WAIT_L(0); PG8_MMA(0, 0, At, B0); PG8_BAR; PG8_SCHED;
            PG8_LDB(B1, 0, 1); PG8_STAGE(PG8_SB(0, 0), b2, voffB);
            PG8_BAR; PG8_WAIT_L(0); PG8_MMA(0, 1, At, B1); PG8_BAR;
            PG8_LDA(At, 0, 1); PG8_STAGE(PG8_SA(0, 0), a2, voffA);
            PG8_BAR; PG8_WAIT_L(0); PG8_MMA(1, 0, At, B0); PG8_BAR; PG8_SCHED;
            PG8_STAGE(PG8_SB(0, 1), b2 + hstep, voffB);
            PG8_WAIT_V(6); PG8_BAR; PG8_MMA(1, 1, At, B1); PG8_BAR;
            PG8_LDB(B0, 1, 0); PG8_SCHED; PG8_LDA(At, 1, 0); PG8_STAGE(PG8_SA(0, 1), a2 + hstep, voffA);
            PG8_WAIT_L(8); PG8_BAR; PG8_WAIT_L(0); PG8_MMA(0, 0, At, B0); PG8_BAR; PG8_SCHED;
            PG8_LDB(B1, 1, 1); PG8_STAGE(PG8_SB(1, 0), b3, voffB);
            PG8_BAR; PG8_WAIT_L(0); PG8_MMA(0, 1, At, B1); PG8_BAR;
            PG8_LDA(At, 1, 1); PG8_STAGE(PG8_SA(1, 0), a3, voffA);
            PG8_BAR; PG8_WAIT_L(0); PG8_MMA(1, 0, At, B0); PG8_BAR; PG8_SCHED;
            PG8_STAGE(PG8_SB(1, 1), b3 + hstep, voffB);
            PG8_WAIT_V(6); PG8_BAR; PG8_MMA(1, 1, At, B1); PG8_BAR;
            }
        }
        if constexpr (ALIGN_EPI) { if (wr == 0) PG8_BAR; }
        if constexpr (!Epi::AFTER_DRAIN) { E(acc, cur, wr, wc, fr, fq); if constexpr (Epi::TWICE) { asm volatile("" ::: "memory"); E(acc, cur, wr, wc, fr, fq); } S.done(cur); }
        if (!has_next) break;
#pragma unroll
        for (int a = 0; a < 2; ++a)
#pragma unroll
            for (int b = 0; b < 2; ++b)
#pragma unroll
                for (int m = 0; m < 4; ++m)
#pragma unroll
                    for (int n = 0; n < 2; ++n) acc[a][b][m][n] = (f32x4){0.f, 0.f, 0.f, 0.f};
        cur = nxt; cA = nA; cB = nB; ++ui;
        if constexpr (ALIGN_EPI) { if (wr == 1) PG8_BAR; }
    }
    PG8_WAIT_V(0);
    if constexpr (!ALIGN_EPI) { if (wr == 0) PG8_BAR; }
    PG8_BAR;
    if constexpr (Epi::AFTER_DRAIN) { E.fused(acc, cur, wr, wc, fr, fq, lds, wid, lane); S.done(cur); }
#undef PG8_SA
#undef PG8_SB
#undef PG8_STAGE
#undef PG8_LDA
#undef PG8_LDB
#undef PG8_MMA
#undef PG8_WAIT_V
#undef PG8_WAIT_L
#undef PG8_BAR
#undef PG8_SCHED
}
}
#define GAS __attribute__((address_space(1)))
#define LAS __attribute__((address_space(3)))
typedef unsigned short bf16;
typedef unsigned v4u __attribute__((ext_vector_type(4)));
typedef float f32x4 __attribute__((ext_vector_type(4)));
typedef short bf16x8 __attribute__((ext_vector_type(8)));
typedef GAS unsigned gu32;
typedef GAS unsigned long long gu64;
#define RLX_AGENT __ATOMIC_RELAXED, __HIP_MEMORY_SCOPE_AGENT
#define LDS_WAIT() asm volatile("s_waitcnt lgkmcnt(0)" ::: "memory")
#define VM_WAIT() asm volatile("s_waitcnt vmcnt(0)" ::: "memory")
__device__ __forceinline__ unsigned long long rt() { return __builtin_amdgcn_s_memrealtime(); }
__device__ __forceinline__ unsigned f2bf(float f) { unsigned u = __builtin_bit_cast(unsigned, f); return (u + 0x7fffu + ((u >> 16) & 1u)) >> 16; }
__device__ __forceinline__ unsigned pk2(float lo, float hi) { return f2bf(lo) | (f2bf(hi) << 16); }

#define XB_TMO      128
#define XB_XCNT(j)  (256  + 64 * (j))
#define XB_XSUB(j)  (1280 + 64 * (j))
#define XB_XGEN(j)  (2304 + 64 * (j))
#define XB_TOP      3328
#define XB_TOPGEN   3392
#define XCD_BAR_WORDS 3456
#define XB_SPIN_CAP (1u << 18)

__device__ __forceinline__ unsigned xb_ld(unsigned* p)              { return __hip_atomic_load(p, __ATOMIC_RELAXED, __HIP_MEMORY_SCOPE_AGENT); }
__device__ __forceinline__ unsigned xb_add(unsigned* p, unsigned v) { return __hip_atomic_fetch_add(p, v, __ATOMIC_RELAXED, __HIP_MEMORY_SCOPE_AGENT); }
__device__ __forceinline__ unsigned xb_xcc_id() { return (unsigned)__builtin_amdgcn_s_getreg((3 << 11) | 20) & 0xFu; }
#define XB_SPIN(cond, bar) do { unsigned _sp = 0; while (cond) { __builtin_amdgcn_s_sleep(1); \
    if ((++_sp & 255u) == 0u) { if (xb_ld(&(bar)[XB_TMO])) break; if (_sp > XB_SPIN_CAP) { atomicAdd(&(bar)[XB_TMO], 1u); break; } } } } while (0)

struct XcdBarrier {
    unsigned* bar; unsigned x;
    volatile LAS unsigned* st;
};

__device__ __forceinline__ XcdBarrier xcd_barrier_post(unsigned* bar, volatile LAS unsigned* st) {
    XcdBarrier b; b.bar = bar; b.x = xb_xcc_id(); b.st = st;
    if (threadIdx.x == 0) (void)xb_add(&bar[XB_XCNT(b.x)], 1u);
    return b;
}
__device__ __forceinline__ void xcd_barrier_complete(unsigned* bar, unsigned x, unsigned& nloc, unsigned& nx) {
    const unsigned G = gridDim.x * gridDim.y * gridDim.z;
    unsigned sum, cnt, mine, sp = 0u;
    for (;;) {
        sum = 0u; cnt = 0u; mine = 0u;
#pragma unroll
        for (unsigned j = 0; j < 16; ++j) { const unsigned c = xb_ld(&bar[XB_XCNT(j)]); sum += c; cnt += (c > 0u) ? 1u : 0u; mine = (j == x) ? c : mine; }
        if (sum == G) break;
        __builtin_amdgcn_s_sleep(1);
        if ((++sp & 255u) == 0u) { if (xb_ld(&bar[XB_TMO])) break; if (sp > XB_SPIN_CAP) { atomicAdd(&bar[XB_TMO], 1u); break; } }
    }
    nloc = mine > 0u ? mine : 1u; nx = cnt > 0u ? cnt : 1u;
}

__device__ __forceinline__ void xcd_barrier(const XcdBarrier& b) {
    asm volatile("s_waitcnt vmcnt(0)" ::: "memory");
    __syncthreads();
    if (threadIdx.x == 0) {
        unsigned* bar = b.bar;
        __builtin_amdgcn_s_waitcnt(0);
        unsigned nloc = b.st[0], nx = b.st[1];
        if (nloc == 0u) { xcd_barrier_complete(bar, b.x, nloc, nx); b.st[0] = nloc; b.st[1] = nx; }
        const unsigned old = xb_add(&bar[XB_XSUB(b.x)], 1u);
        const unsigned gen = old / nloc;
        if (old + 1u == (gen + 1u) * nloc) {
            __builtin_amdgcn_fence(__ATOMIC_RELEASE, "agent");
            asm volatile("s_waitcnt vmcnt(0)" ::: "memory");
            const unsigned og = xb_add(&bar[XB_TOP], 1u);
            const unsigned tg = og / nx;
            if (og + 1u == (tg + 1u) * nx) xb_add(&bar[XB_TOPGEN], 1u);
            else XB_SPIN(xb_ld(&bar[XB_TOPGEN]) == tg, bar);
            __builtin_amdgcn_fence(__ATOMIC_ACQUIRE, "agent");
            xb_add(&bar[XB_XGEN(b.x)], 1u);
            asm volatile("s_waitcnt vmcnt(0)" ::: "memory");
        } else {
            XB_SPIN(xb_ld(&bar[XB_XGEN(b.x)]) == gen, bar);
            __builtin_amdgcn_fence(__ATOMIC_ACQUIRE, "agent");
            asm volatile("s_waitcnt vmcnt(0)" ::: "memory");
        }
    }
    __syncthreads();
}
namespace mk {
constexpr int NWAVES = 8;
constexpr int BATCH = 16, SEQ = 2048, D = 1024, T = BATCH * SEQ;
constexpr int IN_COLS = 3592, NIN = 3584, DFF = 2816, NUP = 2 * DFF;
constexpr int C_QM = 0, C_KM = 512, C_VM = 1024, C_OM = 1536, C_QS = 2048, C_KS = 2560, C_VS = 3072;
constexpr float EPS = 1e-6f;
constexpr size_t MiB = 1u << 20;
constexpr size_t WS_CTL = 0, CTL_ZERO_BYTES = 1 * MiB;
constexpr size_t WS_WIN = 2 * MiB, WS_WOUT = 9 * MiB, WS_WUP = 11 * MiB, WS_WDN = 22 * MiB, WS_GATES = 28 * MiB;
constexpr size_t WS_H = 32 * MiB, WS_PROJ = 96 * MiB, WS_MIXIN = 320 * MiB, WS_MIX = 384 * MiB;
constexpr size_t WS_QKFIRST = 448 * MiB, WS_QKLAST = 454 * MiB, WS_DN = 460 * MiB, WS_NS = 461 * MiB, WS_SCAL = 462 * MiB, WS_MS = 462 * MiB + 65536, WS_END = 463 * MiB;
constexpr size_t WS_ACT = 96 * MiB, WS_GFIRST = 272 * MiB, WS_GLAST = 283 * MiB, WS_UFIRST = 294 * MiB;
constexpr size_t WS_Y = 320 * MiB;
static_assert(WS_ACT + (size_t)T * DFF * 2 <= WS_GFIRST && WS_UFIRST + 11 * MiB <= WS_MIXIN, "ws map");
constexpr int CW_TMO = 0, CW_BAR = 4096;
constexpr int RING_OFF = 0, RING_BYTES = 131072, LDSCTL_OFF = RING_BYTES, MISC_OFF = LDSCTL_OFF + 320, LDS_BYTES = 147456;

struct Frame {
    LAS unsigned char* lds;
    volatile LAS unsigned* MISC;
    gu32* ctl;
    int tid, lane, wave, vcu, G;
};
__device__ __forceinline__ float wave_sum(float v) {
#pragma unroll
    for (int o = 1; o < 64; o <<= 1) v += __shfl_xor(v, o);
    return v;
}
__device__ __forceinline__ float bf2f(bf16 b) { return __uint_as_float((unsigned)b << 16); }
__device__ __forceinline__ float logsig(float x) { return fminf(x, 0.f) - __logf(1.f + __expf(-fabsf(x))); }
__device__ __forceinline__ float sigmoidf_(float x) { return __builtin_amdgcn_rcpf(1.f + __builtin_amdgcn_exp2f(-1.4426950408889634f * x)); }

__device__ __forceinline__ void ld_bf16_row16(const bf16* row, int lane, f32x4 (&v)[4]) {
    const GAS unsigned long long* p = (const GAS unsigned long long*)row + lane;
#pragma unroll
    for (int j = 0; j < 4; ++j) { const unsigned long long w = p[64 * j]; const unsigned lo = (unsigned)w, hi = (unsigned)(w >> 32);
        v[j] = (f32x4){__uint_as_float(lo << 16), __uint_as_float(lo & 0xffff0000u), __uint_as_float(hi << 16), __uint_as_float(hi & 0xffff0000u)}; }
}
__device__ __forceinline__ float sumsq16(const f32x4 (&v)[4]) { float s = 0.f;
#pragma unroll
    for (int j = 0; j < 4; ++j) s += (v[j].x * v[j].x + v[j].y * v[j].y) + (v[j].z * v[j].z + v[j].w * v[j].w);
    return s; }
__device__ __forceinline__ void transpose_item(const float* W, int ldw, int srccol0, bf16* WT, int K, int destrow0, int k0, LAS float* scr, int lane) {
    float tv[32];
#pragma unroll
    for (int i = 0; i < 32; ++i) tv[i] = W[(size_t)(k0 + 2 * i + (lane >> 5)) * ldw + srccol0 + (lane & 31)];
#pragma unroll
    for (int i = 0; i < 32; ++i) scr[(2 * i + (lane >> 5)) * 33 + (lane & 31)] = tv[i];
    LDS_WAIT(); asm volatile("" ::: "memory");
    const int c = lane & 7;
#pragma unroll
    for (int j = 0; j < 4; ++j) { const int n = (lane >> 3) + 8 * j; const LAS float* s = scr + (8 * c) * 33 + n;
        v4u o; o.x = pk2(s[0 * 33], s[1 * 33]); o.y = pk2(s[2 * 33], s[3 * 33]); o.z = pk2(s[4 * 33], s[5 * 33]); o.w = pk2(s[6 * 33], s[7 * 33]);
        *(GAS v4u*)(WT + (size_t)(destrow0 + n) * K + k0 + 8 * c) = o; }
    LDS_WAIT(); asm volatile("" ::: "memory");
}
struct P0Args { const float *x, *g_pre, *w_in, *b_i, *b_f, *w_out, *w_up, *w_down; bf16 *WT_IN, *WT_OUT, *WT_UP, *WT_DN, *H; float* GATES; };
__device__ __forceinline__ void p0_prologue(Frame& F, const P0Args& a) {
    LAS float* scr = (LAS float*)(F.lds + RING_OFF + F.wave * 16384);
    const int gw = F.vcu * NWAVES + F.wave, NGW = F.G * NWAVES;
    constexpr int I_IN = 16 * (NIN / 32), I_OUT = 16 * 32, I_UP = 16 * (NUP / 32), I_DN = (DFF / 64) * 32;
    constexpr int NITEMS = I_IN + I_OUT + I_UP + I_DN;
#ifndef MK_PROBE_MASK
#define MK_PROBE_MASK 0
#endif
    _Pragma("nounroll") for (int rp_ = 0; rp_ < ((((MK_PROBE_MASK) >> 8) & 1) ? 2 : 1); ++rp_)
    for (int it = gw; it < NITEMS; it += NGW) {
        int r = it;
        if (r < I_IN) { const int nblk = NIN / 32, kb = r / nblk, nb = r % nblk, n0 = 32 * nb; const int src = n0 < 2048 ? n0 : n0 + 8;
            transpose_item(a.w_in, IN_COLS, src, a.WT_IN, D, n0, 64 * kb, scr, F.lane); continue; }
        r -= I_IN;
        if (r < I_OUT) { const int kb = r / 32, nb = r % 32; transpose_item(a.w_out, D, 32 * nb, a.WT_OUT, D, 32 * nb, 64 * kb, scr, F.lane); continue; }
        r -= I_OUT;
        if (r < I_UP) { const int nblk = NUP / 32, kb = r / nblk, nb = r % nblk, n0 = 32 * nb, tj = n0 >> 8, w = n0 & 255; const int src = w < 128 ? 128 * tj + w : DFF + 128 * tj + (w - 128);
            transpose_item(a.w_up, NUP, src, a.WT_UP, D, n0, 64 * kb, scr, F.lane); continue; }
        r -= I_UP;
        { const int kb = r / 32, nb = r % 32; transpose_item(a.w_down, D, 32 * nb, a.WT_DN, DFF, 32 * nb, 64 * kb, scr, F.lane); }
    }
    __syncthreads();
    LAS float* WG = (LAS float*)(F.lds + RING_OFF);
    for (int i = F.tid; i < 8 * D; i += NWAVES * 64) { const int k = i >> 3, g = i & 7; WG[g * D + k] = a.w_in[(size_t)k * IN_COLS + 2048 + g]; }
    __syncthreads();
    f32x4 gain[4];
#pragma unroll
    for (int j = 0; j < 4; ++j) gain[j] = ((const GAS f32x4*)a.g_pre)[64 * j + F.lane];
    const int lane = F.lane, b5 = lane >> 5, b4 = (lane >> 4) & 1, b3 = (lane >> 3) & 1, gsel = 4 * b5 + 2 * b4 + b3;
    const float gbias = gsel < 4 ? a.b_i[gsel] : a.b_f[gsel - 4];
    constexpr int RB = 4;
    _Pragma("nounroll") for (int rp_ = 0; rp_ < ((((MK_PROBE_MASK) >> 9) & 1) ? 2 : 1); ++rp_)
    for (int m0 = gw; m0 < T; m0 += NGW * RB) {
        f32x4 v[RB][4];
#pragma unroll
        for (int q = 0; q < RB; ++q) { const int m = m0 + NGW * q; if (m < T) { const GAS f32x4* xr = (const GAS f32x4*)(a.x + (size_t)m * D) + lane;
#pragma unroll
            for (int j = 0; j < 4; ++j) v[q][j] = xr[64 * j]; } }
#pragma unroll
        for (int q = 0; q < RB; ++q) { const int m = m0 + NGW * q; if (m < T) {
            const float rstd = 1.0f / sqrtf(wave_sum(sumsq16(v[q])) * (1.f / D) + EPS);
#pragma unroll
            for (int j = 0; j < 4; ++j) v[q][j] = v[q][j] * rstd * gain[j];
            GAS unsigned long long* o8 = (GAS unsigned long long*)(a.H + (size_t)m * D) + lane;
#pragma unroll
            for (int j = 0; j < 4; ++j) o8[64 * j] = (unsigned long long)pk2(v[q][j].x, v[q][j].y) | ((unsigned long long)pk2(v[q][j].z, v[q][j].w) << 32);
            float d[8];
#pragma unroll
            for (int g = 0; g < 8; ++g) { float s = 0.f;
#pragma unroll
                for (int j = 0; j < 4; ++j) { const f32x4 w = ((const LAS f32x4*)(WG + g * D))[64 * j + lane]; s += (v[q][j].x * w.x + v[q][j].y * w.y) + (v[q][j].z * w.z + v[q][j].w * w.w); }
                d[g] = s; }
            float e4[4], e2[2], e1;
#pragma unroll
            for (int k = 0; k < 4; ++k) { const float keep = b5 ? d[k + 4] : d[k], send = b5 ? d[k] : d[k + 4]; e4[k] = keep + __shfl_xor(send, 32); }
#pragma unroll
            for (int k = 0; k < 2; ++k) { const float keep = b4 ? e4[k + 2] : e4[k], send = b4 ? e4[k] : e4[k + 2]; e2[k] = keep + __shfl_xor(send, 16); }
            { const float keep = b3 ? e2[1] : e2[0], send = b3 ? e2[0] : e2[1]; e1 = keep + __shfl_xor(send, 8); }
            e1 += __shfl_xor(e1, 4); e1 += __shfl_xor(e1, 2); e1 += __shfl_xor(e1, 1);
            if ((lane & 7) == 0) { const float gv = e1 + gbias; a.GATES[(size_t)m * 8 + gsel] = gsel < 4 ? gv : logsig(gv); }
        } }
    }
}

struct MixArgs { const bf16* PROJ; const float* GATES; const float *cw, *cb, *mnorm; float* HRAW; bf16* MIXIN; const float *QKFIRST, *QKLAST; bf16 *DC, *CS; float *DN, *NS, *SCAL, *MS; };
__device__ __forceinline__ float patch_qk(const float* QKFIRST, const float* QKLAST, const float* cw, const float* cb, int slab, bool has_prev, int rr, int chn, float sc) {
    float x[6];
#pragma unroll
    for (int j = 0; j < 3; ++j) { x[j] = has_prev ? QKLAST[(size_t)((slab - 1) * 3 + j) * 1024 + chn] : 0.f; x[3 + j] = QKFIRST[(size_t)(slab * 3 + j) * 1024 + chn]; }
    float y = cb[chn];
#pragma unroll
    for (int j = 0; j < 4; ++j) { const float xv = rr == 0 ? x[j] : (rr == 1 ? x[j + 1] : x[j + 2]); y += cw[j * 1024 + chn] * xv; }
    return y * sc / (1.0f + __expf(-y));
}
__device__ __forceinline__ void mlstm_naive_unit(Frame& F, const MixArgs& a, int b, int h) {
    LAS float* ql = (LAS float*)(F.lds); LAS float* kl = ql + 64 * 128; LAS float* vl = kl + 64 * 128;
    LAS float* fi = vl + 64 * 128; LAS float* ff = fi + 64; LAS float* red = ff + 64; LAS float* redd = red + 2 * 4 * 128;
    const int tid = F.tid, e = tid & 127, dq = tid >> 7;
    const size_t rowbase = (size_t)b * SEQ;
    float C[32], n[32];
#pragma unroll
    for (int i = 0; i < 32; ++i) { C[i] = 0.f; n[i] = 0.f; }
    for (int chunk = 0; chunk < SEQ / 64; ++chunk) {
        __syncthreads();
        for (int i = 0; i < 16; ++i) {
            const int idx = tid + 512 * i, t = idx >> 7, c = idx & 127, tt = chunk * 64 + t;
            if (t >= 3) { const bf16* pr = a.PROJ + (rowbase + tt) * NIN + h * 128 + c; ql[idx] = bf2f(pr[C_QM]); kl[idx] = bf2f(pr[C_KM]); }
            else { const int slab = b * 32 + chunk; ql[idx] = patch_qk(a.QKFIRST, a.QKLAST, a.cw, a.cb, slab, chunk > 0, t, h * 128 + c, 1.0f); kl[idx] = patch_qk(a.QKFIRST, a.QKLAST, a.cw, a.cb, slab, chunk > 0, t, 512 + h * 128 + c, 0.08838834764831845f); }
            vl[idx] = bf2f(a.PROJ[(rowbase + tt) * NIN + C_VM + h * 128 + c]);
        }
        if (tid < 64) { const size_t r = rowbase + chunk * 64 + tid; fi[tid] = __expf(a.GATES[r * 8 + h]); ff[tid] = __expf(a.GATES[r * 8 + 4 + h]); }
        __syncthreads();
        for (int t = 0; t < 64; ++t) {
            const float fg = ff[t], ig = fi[t], ve = vl[t * 128 + e];
            float acc = 0.f, dacc = 0.f;
#pragma unroll
            for (int dd = 0; dd < 32; ++dd) { const float kd = kl[t * 128 + dq * 32 + dd], qd = ql[t * 128 + dq * 32 + dd];
                C[dd] = fg * C[dd] + (ig * kd) * ve; acc += C[dd] * qd; n[dd] = fg * n[dd] + ig * kd; dacc += n[dd] * qd; }
            LAS float* rb = red + (t & 1) * 512; LAS float* rd = redd + (t & 1) * 4;
            rb[dq * 128 + e] = acc; if (e == 0) rd[dq] = dacc;
            __syncthreads();
            if (tid < 128) { const float num = (rb[e] + rb[128 + e]) + (rb[256 + e] + rb[384 + e]); const float den = (rd[0] + rd[1]) + (rd[2] + rd[3]);
                a.HRAW[(rowbase + chunk * 64 + t) * 512 + h * 128 + e] = num / fmaxf(fabsf(den), 1.0f); }
        }
    }
    VM_WAIT(); __syncthreads(); __builtin_amdgcn_fence(__ATOMIC_ACQUIRE, "agent"); VM_WAIT();
    for (int rr = F.wave; rr < SEQ; rr += NWAVES) {
        const size_t r = rowbase + rr;
        const float h0 = a.HRAW[r * 512 + h * 128 + F.lane], h1 = a.HRAW[r * 512 + h * 128 + 64 + F.lane];
        const float rstd = 1.0f / sqrtf(wave_sum(h0 * h0 + h1 * h1) * (1.f / 128.f) + EPS);
        const float o0 = sigmoidf_(bf2f(a.PROJ[r * NIN + C_OM + h * 128 + F.lane])), o1 = sigmoidf_(bf2f(a.PROJ[r * NIN + C_OM + h * 128 + 64 + F.lane]));
        a.MIXIN[r * D + h * 128 + F.lane] = (bf16)f2bf(o0 * h0 * rstd * a.mnorm[h * 128 + F.lane]);
        a.MIXIN[r * D + h * 128 + 64 + F.lane] = (bf16)f2bf(o1 * h1 * rstd * a.mnorm[h * 128 + 64 + F.lane]);
    }
}
__device__ __forceinline__ void sb_naive_unit(Frame& F, const MixArgs& a, int b, int h, int qblk) {
    LAS float* Kl = (LAS float*)(F.lds); LAS float* Vl = Kl + 64 * 64;
    const int tid = F.tid, t = qblk * 512 + tid;
    const size_t rowbase = (size_t)b * SEQ;
    float q[64], o[64], rem = 0.f;
    { const bf16* qp = a.PROJ + (rowbase + t) * NIN + C_QS + h * 64;
#pragma unroll
      for (int d = 0; d < 64; ++d) { q[d] = bf2f(qp[d]) * 0.6931471805599453f; o[d] = 0.f; } }
    for (int kt = qblk * 8 + 7; kt >= 0; --kt) {
        __syncthreads();
        for (int i = 0; i < 8; ++i) { const int idx = tid + 512 * i, s = idx >> 6, d = idx & 63; const bf16* pr = a.PROJ + (rowbase + kt * 64 + s) * NIN + h * 64 + d;
            Kl[idx] = bf2f(pr[C_KS]); Vl[idx] = bf2f(pr[C_VS]); }
        __syncthreads();
        if (kt * 64 < t) {
            for (int sl = 63; sl >= 0; --sl) {
                if (kt * 64 + sl < t) {
                    float z = 0.f;
#pragma unroll
                    for (int d4 = 0; d4 < 16; ++d4) { const f32x4 kv = ((const LAS f32x4*)(Kl + sl * 64))[d4]; z += (q[4 * d4] * kv.x + q[4 * d4 + 1] * kv.y) + (q[4 * d4 + 2] * kv.z + q[4 * d4 + 3] * kv.w); }
                    const float l = __logf(1.f + __expf(-fabsf(z)));
                    const float ls = fminf(z, 0.f) - l, l1 = fminf(-z, 0.f) - l;
                    const float at = __expf(ls + rem); rem += l1;
#pragma unroll
                    for (int d4 = 0; d4 < 16; ++d4) { const f32x4 vv = ((const LAS f32x4*)(Vl + sl * 64))[d4]; o[4 * d4] += at * vv.x; o[4 * d4 + 1] += at * vv.y; o[4 * d4 + 2] += at * vv.z; o[4 * d4 + 3] += at * vv.w; }
                }
            }
        }
    }
    GAS v4u* op = (GAS v4u*)(a.MIXIN + (rowbase + t) * D + 512 + h * 64);
#pragma unroll
    for (int i = 0; i < 8; ++i) { v4u w; w.x = pk2(o[8 * i], o[8 * i + 1]); w.y = pk2(o[8 * i + 2], o[8 * i + 3]); w.z = pk2(o[8 * i + 4], o[8 * i + 5]); w.w = pk2(o[8 * i + 6], o[8 * i + 7]); op[i] = w; }
}

typedef short v4i16_t __attribute__((ext_vector_type(4)));
typedef float f32x16 __attribute__((ext_vector_type(16)));
__device__ __forceinline__ v4i16_t tr16(const LAS unsigned char* p) { return __builtin_amdgcn_ds_read_tr16_b64_v4i16((LAS v4i16_t*)p); }
__device__ __forceinline__ bf16x8 cat8(v4i16_t a, v4i16_t b) { return (bf16x8){a[0], a[1], a[2], a[3], b[0], b[1], b[2], b[3]}; }
typedef float f32x2_t __attribute__((ext_vector_type(2))); typedef __bf16 bf16x2_t __attribute__((ext_vector_type(2)));
__device__ __forceinline__ unsigned cvtpk(float lo, float hi) { f32x2_t v = {lo, hi}; bf16x2_t b = __builtin_convertvector(v, bf16x2_t); return __builtin_bit_cast(unsigned, b); }
__device__ __forceinline__ bf16x8 pack8(const float* p) { v4u w; w.x = cvtpk(p[0], p[1]); w.y = cvtpk(p[2], p[3]); w.z = cvtpk(p[4], p[5]); w.w = cvtpk(p[6], p[7]); return __builtin_bit_cast(bf16x8, w); }
constexpr int SB_VRS = 192, SB_VBUF = 32 * SB_VRS;
__device__ __forceinline__ void sb_phase(Frame& F, const bf16* PROJ, bf16* MIXIN) {
    LAS unsigned char* vb = F.lds + RING_OFF + F.wave * (2 * SB_VBUF);
    const int lane = F.lane, tl = lane & 31, hh = lane >> 5;
    const int troff = (4 * hh + ((lane & 15) >> 2)) * SB_VRS + (16 * ((lane >> 4) & 1) + 4 * (lane & 3)) * 2;
    for (int bu = F.vcu; bu < 1024; bu += F.G) {
        const int bh = bu & 127, qi = (7 - (bu >> 7)) * 8 + F.wave, b = bh >> 3, h = bh & 7;
        const size_t rowbase = (size_t)b * SEQ;
        const bf16* kvbase = PROJ + rowbase * NIN + h * 64;
        bf16x8 qf[4], kf[4], kn[4]; v4u vr[4], vn[4];
        { const bf16* qp = kvbase + (size_t)(32 * qi + tl) * NIN + C_QS + 8 * hh;
#pragma unroll
          for (int s = 0; s < 4; ++s) qf[s] = *(const GAS bf16x8*)(qp + 16 * s); }
#define SB_LOADK(dst, kb) do { const bf16* kp_ = kvbase + (size_t)(32 * (kb) + tl) * NIN + C_KS + 8 * hh; _Pragma("unroll") for (int s = 0; s < 4; ++s) dst[s] = *(const GAS bf16x8*)(kp_ + 16 * s); } while (0)
#define SB_LOADV(dst, kb) do { _Pragma("unroll") for (int i = 0; i < 4; ++i) { const int idx_ = lane + 64 * i; dst[i] = *(const GAS v4u*)(kvbase + (size_t)(32 * (kb) + (idx_ >> 3)) * NIN + C_VS + 8 * (idx_ & 7)); } } while (0)
#define SB_WRITEV(buf, srcv) do { _Pragma("unroll") for (int i = 0; i < 4; ++i) { const int idx_ = lane + 64 * i; *(LAS v4u*)((buf) + (idx_ >> 3) * SB_VRS + 16 * (idx_ & 7)) = srcv[i]; } } while (0)
        bf16x8 k2[4]; v4u v2[4];
        SB_LOADK(kf, qi); SB_LOADV(vr, qi);
        if (qi > 0) { SB_LOADK(kn, qi - 1); SB_LOADV(vn, qi - 1); }
        SB_WRITEV(vb, vr);
        f32x16 o0, o1;
#pragma unroll
        for (int r = 0; r < 16; ++r) { o0[r] = 0.f; o1[r] = 0.f; }
        float carry = 1.f; int cur = 0;
        for (int kb = qi; kb >= 0; --kb) {
            if (kb > 1) { SB_LOADK(k2, kb - 2); SB_LOADV(v2, kb - 2); }
            f32x16 S;
#pragma unroll
            for (int r = 0; r < 16; ++r) S[r] = 0.f;
#pragma unroll
            for (int s = 0; s < 4; ++s) S = __builtin_amdgcn_mfma_f32_32x32x16_bf16(kf[s], qf[s], S, 0, 0, 0);
            float om[16], bt[16];
            const bool diag = (kb == qi);
#pragma unroll
            for (int r = 0; r < 16; ++r) {
                const float e = __builtin_amdgcn_exp2f(fminf(S[r], 100.f));
                float m_ = __builtin_amdgcn_rcpf(1.f + e), b_ = e * m_;
                if (diag) { const bool masked = ((r & 3) + 8 * (r >> 2) + 4 * hh) >= tl; m_ = masked ? 1.f : m_; b_ = masked ? 0.f : b_; }
                om[r] = m_; bt[r] = b_;
            }
            float xs[16], G[4], pG[4];
#pragma unroll
            for (int g = 0; g < 4; ++g) { xs[4 * g + 3] = 1.f; xs[4 * g + 2] = om[4 * g + 3]; xs[4 * g + 1] = xs[4 * g + 2] * om[4 * g + 2]; xs[4 * g] = xs[4 * g + 1] * om[4 * g + 1]; G[g] = xs[4 * g] * om[4 * g]; }
#pragma unroll
            for (int g = 0; g < 4; ++g) pG[g] = __shfl_xor(G[g], 32);
            float Sg[4]; Sg[3] = carry; Sg[2] = Sg[3] * (G[3] * pG[3]); Sg[1] = Sg[2] * (G[2] * pG[2]); Sg[0] = Sg[1] * (G[1] * pG[1]); carry = Sg[0] * (G[0] * pG[0]);
            float P[16];
#pragma unroll
            for (int g = 0; g < 4; ++g) { const float off = hh ? Sg[g] : Sg[g] * pG[g];
#pragma unroll
                for (int j = 0; j < 4; ++j) P[4 * g + j] = bt[4 * g + j] * (xs[4 * g + j] * off); }
            const bf16x8 pb0 = pack8(P), pb1 = pack8(P + 8);
            const LAS unsigned char* vbase = vb + cur * SB_VBUF + troff;
            { const bf16x8 a00 = cat8(tr16(vbase), tr16(vbase + 8 * SB_VRS)), a01 = cat8(tr16(vbase + 64), tr16(vbase + 8 * SB_VRS + 64));
              const bf16x8 a10 = cat8(tr16(vbase + 16 * SB_VRS), tr16(vbase + 24 * SB_VRS)), a11 = cat8(tr16(vbase + 16 * SB_VRS + 64), tr16(vbase + 24 * SB_VRS + 64));
              o0 = __builtin_amdgcn_mfma_f32_32x32x16_bf16(a00, pb0, o0, 0, 0, 0); o1 = __builtin_amdgcn_mfma_f32_32x32x16_bf16(a01, pb0, o1, 0, 0, 0);
              o0 = __builtin_amdgcn_mfma_f32_32x32x16_bf16(a10, pb1, o0, 0, 0, 0); o1 = __builtin_amdgcn_mfma_f32_32x32x16_bf16(a11, pb1, o1, 0, 0, 0); }
            if (__all(carry < 7.888609052210118e-31f)) break;
            if (kb > 0) { SB_WRITEV(vb + (cur ^ 1) * SB_VBUF, vn);
#pragma unroll
                for (int s = 0; s < 4; ++s) { kf[s] = kn[s]; kn[s] = k2[s]; vn[s] = v2[s]; }
                cur ^= 1; }
        }
#undef SB_LOADK
#undef SB_LOADV
#undef SB_WRITEV
        bf16* orow = MIXIN + (rowbase + 32 * qi + tl) * D + 512 + h * 64 + 4 * hh;
#pragma unroll
        for (int g = 0; g < 4; ++g) {
            *(GAS unsigned long long*)(orow + 8 * g) = (unsigned long long)cvtpk(o0[4 * g], o0[4 * g + 1]) | ((unsigned long long)cvtpk(o0[4 * g + 2], o0[4 * g + 3]) << 32);
            *(GAS unsigned long long*)(orow + 32 + 8 * g) = (unsigned long long)cvtpk(o1[4 * g], o1[4 * g + 1]) | ((unsigned long long)cvtpk(o1[4 * g + 2], o1[4 * g + 3]) << 32);
        }
    }
}

constexpr int ML_RST = 320, ML_RSR = 272;
struct ARegs { v4u k[2], v[2]; float x[6]; float lf, li; };
__device__ __forceinline__ void ml_load_a(ARegs& r, const MixArgs& a, int u, int tid, int lane) {
    const int bh = u >> 5, c = u & 31, b = bh >> 2, h = bh & 3; const size_t row0 = (size_t)b * SEQ + 64 * c;
#pragma unroll
    for (int i = 0; i < 2; ++i) { const int idx = tid + 512 * i, s = idx >> 4, ch = idx & 15; const bf16* pr = a.PROJ + (row0 + s) * NIN + h * 128 + ch * 8;
        if (s >= 3) r.k[i] = *(const GAS v4u*)(pr + C_KM);
        r.v[i] = *(const GAS v4u*)(pr + C_VM); }
    if (tid < 384) { const int chn = 512 + h * 128 + (tid & 127), slab = b * 32 + c;
#pragma unroll
        for (int j = 0; j < 3; ++j) { r.x[j] = c > 0 ? a.QKLAST[(size_t)((slab - 1) * 3 + j) * 1024 + chn] : 0.f; r.x[3 + j] = a.QKFIRST[(size_t)(slab * 3 + j) * 1024 + chn]; } }
    r.lf = a.GATES[(row0 + lane) * 8 + 4 + h]; r.li = a.GATES[(row0 + lane) * 8 + h];
}
__device__ __forceinline__ v4u scale_bf16x8(v4u raw, float ws) { v4u o;
    o.x = pk2(__uint_as_float(raw.x << 16) * ws, __uint_as_float(raw.x & 0xffff0000u) * ws); o.y = pk2(__uint_as_float(raw.y << 16) * ws, __uint_as_float(raw.y & 0xffff0000u) * ws);
    o.z = pk2(__uint_as_float(raw.z << 16) * ws, __uint_as_float(raw.z & 0xffff0000u) * ws); o.w = pk2(__uint_as_float(raw.w << 16) * ws, __uint_as_float(raw.w & 0xffff0000u) * ws); return o; }
__device__ __forceinline__ void ml_pass_a(Frame& F, const MixArgs& a) {
    LAS unsigned char* Kl = F.lds + RING_OFF; LAS unsigned char* Vw = Kl + 64 * ML_RST; LAS float* wk = (LAS float*)(Vw + 64 * ML_RST);
    const int tid = F.tid, lane = F.lane, w = F.wave, hh = lane >> 5;
    const int tro = (8 * hh + ((lane & 15) >> 2)) * ML_RST + (16 * ((lane >> 4) & 1) + 4 * (lane & 3)) * 2;
    int u = F.vcu;
    if ((u & 31) == 31 || u >= 2048) return;
    const int hfix = (u >> 5) & 3, prr = tid >> 7, pchn = 512 + hfix * 128 + (tid & 127);
    float pw[4], pb = 0.f;
    if (tid < 384) { pb = a.cb[pchn];
#pragma unroll
        for (int j = 0; j < 4; ++j) pw[j] = a.cw[j * 1024 + pchn]; }
    ARegs cur, nxt; ml_load_a(cur, a, u, tid, lane);
    for (; u < 2048; u += F.G) {
        const int un = u + F.G;
        __syncthreads();
        float bc = cur.lf;
#pragma unroll
        for (int o = 1; o < 64; o <<= 1) { const float t_ = __shfl_up(bc, o); if (lane >= o) bc += t_; }
        const float av = cur.li - bc; float mx = av;
#pragma unroll
        for (int o = 1; o < 64; o <<= 1) mx = fmaxf(mx, __shfl_xor(mx, o));
        const float wkv = __expf(av - mx);
        if (w == 0) { wk[lane] = wkv; if (lane == 63) { a.SCAL[2 * u] = bc; a.SCAL[2 * u + 1] = mx; } }
#pragma unroll
        for (int i = 0; i < 2; ++i) { const int idx = tid + 512 * i, s = idx >> 4, ch = idx & 15;
            if (s >= 3) *(LAS v4u*)(Kl + s * ML_RST + ch * 16) = cur.k[i];
            *(LAS v4u*)(Vw + s * ML_RST + ch * 16) = scale_bf16x8(cur.v[i], __shfl(wkv, s)); }
        if (tid < 384) { float y = pb;
#pragma unroll
            for (int j = 0; j < 4; ++j) { const float xv = prr == 0 ? cur.x[j] : (prr == 1 ? cur.x[j + 1] : cur.x[j + 2]); y += pw[j] * xv; }
            *(LAS bf16*)(Kl + prr * ML_RST + (tid & 127) * 2) = (bf16)f2bf(y * 0.08838834764831845f / (1.0f + __expf(-y))); }
        if (un < 2048) ml_load_a(nxt, a, un, tid, lane);
        __syncthreads();
        {
            const int d = 16 * w + (lane & 15), sq = lane >> 4; float acc = 0.f;
#pragma unroll
            for (int s = 0; s < 16; ++s) acc += wk[16 * sq + s] * bf2f(*(const LAS bf16*)(Kl + (16 * sq + s) * ML_RST + d * 2));
            acc += __shfl_xor(acc, 16); acc += __shfl_xor(acc, 32);
            if (lane < 16) a.DN[(size_t)u * 128 + d] = acc; }
        const int dt = w >> 1, et0 = 2 * (w & 1);
        f32x16 c0, c1;
#pragma unroll
        for (int r = 0; r < 16; ++r) { c0[r] = 0.f; c1[r] = 0.f; }
#pragma unroll
        for (int kk = 0; kk < 4; ++kk) {
            const LAS unsigned char* ka = Kl + tro + 16 * kk * ML_RST + dt * 64; const LAS unsigned char* va = Vw + tro + 16 * kk * ML_RST + et0 * 64;
            const bf16x8 A = cat8(tr16(ka), tr16(ka + 4 * ML_RST)), B0 = cat8(tr16(va), tr16(va + 4 * ML_RST)), B1 = cat8(tr16(va + 64), tr16(va + 4 * ML_RST + 64));
            c0 = __builtin_amdgcn_mfma_f32_32x32x16_bf16(A, B0, c0, 0, 0, 0); c1 = __builtin_amdgcn_mfma_f32_32x32x16_bf16(A, B1, c1, 0, 0, 0);
        }
        bf16* dcu = a.DC + (size_t)u * 16384;
#pragma unroll
        for (int g = 0; g < 4; ++g) {
            const int fo0 = (((et0 * 8 + 2 * dt + (g >> 1)) * 64) + (lane & 31) + 32 * (g & 1)) * 8 + 4 * hh, fo1 = fo0 + 8 * 64 * 8;
            *(GAS unsigned long long*)(dcu + fo0) = (unsigned long long)cvtpk(c0[4 * g], c0[4 * g + 1]) | ((unsigned long long)cvtpk(c0[4 * g + 2], c0[4 * g + 3]) << 32);
            *(GAS unsigned long long*)(dcu + fo1) = (unsigned long long)cvtpk(c1[4 * g], c1[4 * g + 1]) | ((unsigned long long)cvtpk(c1[4 * g + 2], c1[4 * g + 3]) << 32);
        }
        cur = nxt;
    }
}
__device__ __forceinline__ void ml_pass_b(Frame& F, const MixArgs& a) {
    LAS float* scl = (LAS float*)(F.lds + RING_OFF);
    const int tid = F.tid;
    for (int u = F.vcu; u < 256; u += F.G) {
        const int bh = u >> 2, qtr = u & 3;
        __syncthreads();
        if (tid < 64) scl[tid] = a.SCAL[(size_t)bh * 64 + tid];
        __syncthreads();
        const size_t base = (size_t)bh * 32 * 16384 + qtr * 4096 + tid * 8;
        float C[8], nv = 0.f, ms = 0.f;
#pragma unroll
        for (int i = 0; i < 8; ++i) C[i] = 0.f;
        v4u ring[8];
#pragma unroll
        for (int i = 0; i < 8; ++i) ring[i] = *(const GAS v4u*)(a.DC + base + (size_t)i * 16384);
#pragma unroll
        for (int c = 0; c < 32; ++c) {
            v4u o; o.x = pk2(C[0], C[1]); o.y = pk2(C[2], C[3]); o.z = pk2(C[4], C[5]); o.w = pk2(C[6], C[7]);
            *(GAS v4u*)(a.CS + base + (size_t)c * 16384) = o;
            if (tid < 32) a.NS[(size_t)(bh * 32 + c) * 128 + qtr * 32 + tid] = nv;
            if (qtr == 0 && tid == 0) a.MS[bh * 32 + c] = ms;
            if (c < 31) {
                const float bl = scl[2 * c], pm = scl[2 * c + 1], M = fmaxf(pm, ms), sc = __expf(pm - M), dec = __expf(ms - M);
                ms = bl + M;
                const v4u d = ring[c & 7];
                if (c + 8 < 31) ring[c & 7] = *(const GAS v4u*)(a.DC + base + (size_t)(c + 8) * 16384);
                C[0] = dec * C[0] + sc * __uint_as_float(d.x << 16); C[1] = dec * C[1] + sc * __uint_as_float(d.x & 0xffff0000u);
                C[2] = dec * C[2] + sc * __uint_as_float(d.y << 16); C[3] = dec * C[3] + sc * __uint_as_float(d.y & 0xffff0000u);
                C[4] = dec * C[4] + sc * __uint_as_float(d.z << 16); C[5] = dec * C[5] + sc * __uint_as_float(d.z & 0xffff0000u);
                C[6] = dec * C[6] + sc * __uint_as_float(d.w << 16); C[7] = dec * C[7] + sc * __uint_as_float(d.w & 0xffff0000u);
                if (tid < 32) nv = dec * nv + sc * a.DN[(size_t)(bh * 32 + c) * 128 + qtr * 32 + tid];
            }
        }
    }
}
struct CRegs { v4u q[2], k[2], v[2]; float xq[6], xk[6]; float lf, li, ms, nsv; };
__device__ __forceinline__ void ml_load_c(CRegs& r, const MixArgs& a, int u, int tid, int lane) {
    const int bh = u >> 5, c = u & 31, b = bh >> 2, h = bh & 3; const size_t row0 = (size_t)b * SEQ + 64 * c;
#pragma unroll
    for (int i = 0; i < 2; ++i) { const int idx = tid + 512 * i, s = idx >> 4, ch = idx & 15; const bf16* pr = a.PROJ + (row0 + s) * NIN + h * 128 + ch * 8;
        if (s >= 3) { r.q[i] = *(const GAS v4u*)(pr + C_QM); r.k[i] = *(const GAS v4u*)(pr + C_KM); }
        r.v[i] = *(const GAS v4u*)(pr + C_VM); }
    if (tid < 384) { const int chq = h * 128 + (tid & 127), slab = b * 32 + c;
#pragma unroll
        for (int j = 0; j < 3; ++j) { r.xq[j] = c > 0 ? a.QKLAST[(size_t)((slab - 1) * 3 + j) * 1024 + chq] : 0.f; r.xq[3 + j] = a.QKFIRST[(size_t)(slab * 3 + j) * 1024 + chq];
                                      r.xk[j] = c > 0 ? a.QKLAST[(size_t)((slab - 1) * 3 + j) * 1024 + 512 + chq] : 0.f; r.xk[3 + j] = a.QKFIRST[(size_t)(slab * 3 + j) * 1024 + 512 + chq]; } }
    r.lf = a.GATES[(row0 + lane) * 8 + 4 + h]; r.li = a.GATES[(row0 + lane) * 8 + h]; r.ms = a.MS[u];
    if (tid < 128) r.nsv = a.NS[(size_t)u * 128 + tid];
}
__device__ __forceinline__ void ml_pass_c(Frame& F, const MixArgs& a) {
    LAS unsigned char* Ql = F.lds + RING_OFF; LAS unsigned char* Kl = Ql + 64 * ML_RSR; LAS unsigned char* Vl = Kl + 64 * ML_RSR;
    LAS float* al = (LAS float*)(Vl + 64 * ML_RST); LAS float* Ml = al + 64; LAS float* wil = Ml + 64; LAS float* enm = wil + 64; LAS float* nl = enm + 64; LAS float* ssq = nl + 128;
    const int tid = F.tid, lane = F.lane, w = F.wave, hh = lane >> 5, tl = lane & 31;
    const int et = w & 3, tt = w >> 2, t = 32 * tt + tl;
    int u = F.vcu;
    if (u >= 2048) return;
    const int hfix = (u >> 5) & 3, prr = tid >> 7, pchq = hfix * 128 + (tid & 127);
    float pwq[4], pwk[4], pbq = 0.f, pbk = 0.f;
    if (tid < 384) { pbq = a.cb[pchq]; pbk = a.cb[512 + pchq];
#pragma unroll
        for (int j = 0; j < 4; ++j) { pwq[j] = a.cw[j * 1024 + pchq]; pwk[j] = a.cw[j * 1024 + 512 + pchq]; } }
    f32x4 mn[4];
#pragma unroll
    for (int g = 0; g < 4; ++g) mn[g] = *(const GAS f32x4*)(a.mnorm + hfix * 128 + 32 * et + 8 * g + 4 * hh);
    const int trq = (4 * hh + ((lane & 15) >> 2)) * ML_RST + (32 * et + 16 * ((lane >> 4) & 1) + 4 * (lane & 3)) * 2;
    CRegs cur, nxt; ml_load_c(cur, a, u, tid, lane);
    for (; u < 2048; u += F.G) {
        const int un = u + F.G;
        const int bh = u >> 5, c = u & 31, b = bh >> 2, h = bh & 3;
        const size_t row0 = (size_t)b * SEQ + 64 * c;
        __syncthreads();
        if (w == 0) {
            float bc = cur.lf;
#pragma unroll
            for (int o = 1; o < 64; o <<= 1) { const float t_ = __shfl_up(bc, o); if (lane >= o) bc += t_; }
            const float av = cur.li - bc; float pm = av;
#pragma unroll
            for (int o = 1; o < 64; o <<= 1) { const float t_ = __shfl_up(pm, o); if (lane >= o) pm = fmaxf(pm, t_); }
            const float M = fmaxf(pm, cur.ms);
            al[lane] = av; Ml[lane] = M; wil[lane] = __expf(cur.ms - M); enm[lane] = __expf(-bc - M);
        }
        if (tid < 128) nl[tid] = cur.nsv;
#pragma unroll
        for (int i = 0; i < 2; ++i) { const int idx = tid + 512 * i, s = idx >> 4, ch = idx & 15;
            if (s >= 3) { *(LAS v4u*)(Ql + s * ML_RSR + ch * 16) = cur.q[i]; *(LAS v4u*)(Kl + s * ML_RSR + ch * 16) = cur.k[i]; }
            *(LAS v4u*)(Vl + s * ML_RST + ch * 16) = cur.v[i]; }
        if (tid < 384) { float yq = pbq, yk = pbk;
#pragma unroll
            for (int j = 0; j < 4; ++j) { const float xq = prr == 0 ? cur.xq[j] : (prr == 1 ? cur.xq[j + 1] : cur.xq[j + 2]), xk = prr == 0 ? cur.xk[j] : (prr == 1 ? cur.xk[j + 1] : cur.xk[j + 2]); yq += pwq[j] * xq; yk += pwk[j] * xk; }
            *(LAS bf16*)(Ql + prr * ML_RSR + (tid & 127) * 2) = (bf16)f2bf(yq / (1.0f + __expf(-yq)));
            *(LAS bf16*)(Kl + prr * ML_RSR + (tid & 127) * 2) = (bf16)f2bf(yk * 0.08838834764831845f / (1.0f + __expf(-yk))); }
        bf16x8 cf[8];
#pragma unroll
        for (int kk = 0; kk < 8; ++kk) cf[kk] = *(const GAS bf16x8*)(a.CS + (size_t)u * 16384 + ((et * 8 + kk) * 64 + lane) * 8);
        unsigned long long ogw[4];
#pragma unroll
        for (int g = 0; g < 4; ++g) ogw[g] = *(const GAS unsigned long long*)(a.PROJ + (row0 + t) * NIN + C_OM + h * 128 + 32 * et + 8 * g + 4 * hh);
        if (un < 2048) ml_load_c(nxt, a, un, tid, lane);
        __syncthreads();
        bf16x8 qf[8];
#pragma unroll
        for (int kk = 0; kk < 8; ++kk) qf[kk] = *(const LAS bf16x8*)(Ql + t * ML_RSR + (16 * kk + 8 * hh) * 2);
        float qn = 0.f;
#pragma unroll
        for (int kk = 0; kk < 8; ++kk) { const f32x4 n0 = *(const LAS f32x4*)(nl + 16 * kk + 8 * hh), n1 = *(const LAS f32x4*)(nl + 16 * kk + 8 * hh + 4);
            qn += bf2f((bf16)qf[kk][0]) * n0.x + bf2f((bf16)qf[kk][1]) * n0.y + bf2f((bf16)qf[kk][2]) * n0.z + bf2f((bf16)qf[kk][3]) * n0.w
                + bf2f((bf16)qf[kk][4]) * n1.x + bf2f((bf16)qf[kk][5]) * n1.y + bf2f((bf16)qf[kk][6]) * n1.z + bf2f((bf16)qf[kk][7]) * n1.w; }
        qn += __shfl_xor(qn, 32);
        const float Mt = Ml[t], wi = wil[t];
        f32x16 numI; float dsum = 0.f;
#pragma unroll
        for (int r = 0; r < 16; ++r) numI[r] = 0.f;
        for (int st = 0; st <= tt; ++st) {
            f32x16 S;
#pragma unroll
            for (int r = 0; r < 16; ++r) S[r] = 0.f;
#pragma unroll
            for (int kk = 0; kk < 8; ++kk) { const bf16x8 kfr = *(const LAS bf16x8*)(Kl + (32 * st + tl) * ML_RSR + (16 * kk + 8 * hh) * 2); S = __builtin_amdgcn_mfma_f32_32x32x16_bf16(kfr, qf[kk], S, 0, 0, 0); }
            float P[16];
            const bool diag = (st == tt);
#pragma unroll
            for (int g = 0; g < 4; ++g) { const f32x4 a4 = *(const LAS f32x4*)(al + 32 * st + 8 * g + 4 * hh);
#pragma unroll
                for (int j = 0; j < 4; ++j) { float p = S[4 * g + j] * __expf(a4[j] - Mt); if (diag && (8 * g + 4 * hh + j) > tl) p = 0.f; P[4 * g + j] = p; dsum += p; } }
            const bf16x8 pb0 = pack8(P), pb1 = pack8(P + 8);
            const LAS unsigned char* tv = Vl + 32 * st * ML_RST + trq;
            const bf16x8 A0 = cat8(tr16(tv), tr16(tv + 8 * ML_RST)), A1 = cat8(tr16(tv + 16 * ML_RST), tr16(tv + 24 * ML_RST));
            numI = __builtin_amdgcn_mfma_f32_32x32x16_bf16(A0, pb0, numI, 0, 0, 0); numI = __builtin_amdgcn_mfma_f32_32x32x16_bf16(A1, pb1, numI, 0, 0, 0);
        }
        dsum += __shfl_xor(dsum, 32);
        f32x16 qc;
#pragma unroll
        for (int r = 0; r < 16; ++r) qc[r] = 0.f;
#pragma unroll
        for (int kk = 0; kk < 8; ++kk) qc = __builtin_amdgcn_mfma_f32_32x32x16_bf16(cf[kk], qf[kk], qc, 0, 0, 0);
        const float den = dsum + wi * qn, rdn = 1.0f / fmaxf(fabsf(den), enm[t]);
        float hv[16], ss = 0.f;
#pragma unroll
        for (int r = 0; r < 16; ++r) { hv[r] = (numI[r] + wi * qc[r]) * rdn; ss += hv[r] * hv[r]; }
        ss += __shfl_xor(ss, 32);
        if (hh == 0) ssq[et * 64 + t] = ss;
        __syncthreads();
        const float rstd = 1.0f / sqrtf(((ssq[t] + ssq[64 + t]) + (ssq[128 + t] + ssq[192 + t])) * (1.f / 128.f) + EPS);
#pragma unroll
        for (int g = 0; g < 4; ++g) { const int e = h * 128 + 32 * et + 8 * g + 4 * hh;
            const unsigned lo = (unsigned)ogw[g], hi = (unsigned)(ogw[g] >> 32);
            const float o0 = sigmoidf_(__uint_as_float(lo << 16)) * hv[4 * g] * rstd * mn[g].x, o1 = sigmoidf_(__uint_as_float(lo & 0xffff0000u)) * hv[4 * g + 1] * rstd * mn[g].y;
            const float o2 = sigmoidf_(__uint_as_float(hi << 16)) * hv[4 * g + 2] * rstd * mn[g].z, o3 = sigmoidf_(__uint_as_float(hi & 0xffff0000u)) * hv[4 * g + 3] * rstd * mn[g].w;
            *(GAS unsigned long long*)(a.MIXIN + (row0 + t) * D + e) = (unsigned long long)cvtpk(o0, o1) | ((unsigned long long)cvtpk(o2, o3) << 32); }
        cur = nxt;
    }
}
__device__ __forceinline__ void p2_mixers_naive(Frame& F, const MixArgs& a) {
    const int bx = blockIdx.x;
    if (bx < 64) { mlstm_naive_unit(F, a, bx >> 2, bx & 3); __syncthreads(); }
#if defined(MK_SB_NAIVE)
    else { for (int u = bx - 64; u < 512; u += (F.G - 64)) { const int qblk = 3 - (u >> 7), bh = u & 127; sb_naive_unit(F, a, bh >> 3, bh & 7, qblk); } }
#else
    sb_phase(F, a.PROJ, a.MIXIN);
#endif
}

__device__ __forceinline__ void p3b_rows(Frame& F, const float* x, const bf16* MIX, const float* g1, const float* g2, float* out, bf16* H) {
    const int gw = F.vcu * NWAVES + F.wave, NGW = F.G * NWAVES;
    f32x4 ga[4], gb[4];
#pragma unroll
    for (int j = 0; j < 4; ++j) { ga[j] = ((const GAS f32x4*)g1)[64 * j + F.lane]; gb[j] = ((const GAS f32x4*)g2)[64 * j + F.lane]; }
    constexpr int RB = 4;
    for (int m0 = gw; m0 < T; m0 += NGW * RB) {
        f32x4 mv[RB][4], xv[RB][4];
#pragma unroll
        for (int q = 0; q < RB; ++q) { const int m = m0 + NGW * q; if (m < T) { ld_bf16_row16(MIX + (size_t)m * D, F.lane, mv[q]);
            const GAS f32x4* xr = (const GAS f32x4*)(x + (size_t)m * D) + F.lane;
#pragma unroll
            for (int j = 0; j < 4; ++j) xv[q][j] = xr[64 * j]; } }
#pragma unroll
        for (int q = 0; q < RB; ++q) { const int m = m0 + NGW * q; if (m < T) {
            const float r1 = 1.0f / sqrtf(wave_sum(sumsq16(mv[q])) * (1.f / D) + EPS);
#pragma unroll
            for (int j = 0; j < 4; ++j) xv[q][j] = xv[q][j] + mv[q][j] * r1 * ga[j];
            GAS f32x4* orow = (GAS f32x4*)(out + (size_t)m * D) + F.lane;
#pragma unroll
            for (int j = 0; j < 4; ++j) orow[64 * j] = xv[q][j];
            const float r2 = 1.0f / sqrtf(wave_sum(sumsq16(xv[q])) * (1.f / D) + EPS);
            GAS unsigned long long* o8 = (GAS unsigned long long*)(H + (size_t)m * D) + F.lane;
#pragma unroll
            for (int j = 0; j < 4; ++j) { const f32x4 hv = xv[q][j] * r2 * gb[j]; o8[64 * j] = (unsigned long long)pk2(hv.x, hv.y) | ((unsigned long long)pk2(hv.z, hv.w) << 32); }
        } }
    }
}
__device__ __forceinline__ void p6_rows(Frame& F, const bf16* Y, const float* g3, float* out) {
    const int gw = F.vcu * NWAVES + F.wave, NGW = F.G * NWAVES;
    f32x4 ga[4];
#pragma unroll
    for (int j = 0; j < 4; ++j) ga[j] = ((const GAS f32x4*)g3)[64 * j + F.lane];
    constexpr int RB = 4;
    for (int m0 = gw; m0 < T; m0 += NGW * RB) {
        f32x4 yv[RB][4], xv[RB][4];
#pragma unroll
        for (int q = 0; q < RB; ++q) { const int m = m0 + NGW * q; if (m < T) { ld_bf16_row16(Y + (size_t)m * D, F.lane, yv[q]);
            const GAS f32x4* orow = (const GAS f32x4*)(out + (size_t)m * D) + F.lane;
#pragma unroll
            for (int j = 0; j < 4; ++j) xv[q][j] = orow[64 * j]; } }
#pragma unroll
        for (int q = 0; q < RB; ++q) { const int m = m0 + NGW * q; if (m < T) {
            const float r1 = 1.0f / sqrtf(wave_sum(sumsq16(yv[q])) * (1.f / D) + EPS);
            GAS f32x4* orow = (GAS f32x4*)(out + (size_t)m * D) + F.lane;
#pragma unroll
            for (int j = 0; j < 4; ++j) orow[64 * j] = xv[q][j] + yv[q][j] * r1 * ga[j];
        } }
    }
}
__device__ __forceinline__ void p4b_fixup(Frame& F, const float* cw, const float* cb, const float* GFIRST, const float* GLAST, const float* UFIRST, bf16* ACT) {
    constexpr int C4 = DFF / 4, TOTAL = 512 * 2 * C4;
    for (int it = F.vcu * NWAVES * 64 + F.tid; it < TOTAL; it += F.G * NWAVES * 64) {
        const int c4 = it % C4, rs = it / C4, rr = rs & 1, s = rs >> 1; const bool first = (s & 31) == 0;
        const f32x4 z4 = {0.f, 0.f, 0.f, 0.f};
        const f32x4 g0 = *(const GAS f32x4*)(GFIRST + (size_t)(s * 2 + rr) * DFF + 4 * c4);
        f32x4 gm1, gm2;
        if (rr == 0) { gm1 = first ? z4 : *(const GAS f32x4*)(GLAST + (size_t)((s - 1) * 2 + 1) * DFF + 4 * c4); gm2 = first ? z4 : *(const GAS f32x4*)(GLAST + (size_t)((s - 1) * 2 + 0) * DFF + 4 * c4); }
        else { gm1 = *(const GAS f32x4*)(GFIRST + (size_t)(s * 2 + 0) * DFF + 4 * c4); gm2 = first ? z4 : *(const GAS f32x4*)(GLAST + (size_t)((s - 1) * 2 + 1) * DFF + 4 * c4); }
        const f32x4 w0 = *(const GAS f32x4*)(cw + 4 * c4), w1 = *(const GAS f32x4*)(cw + DFF + 4 * c4), w2 = *(const GAS f32x4*)(cw + 2 * DFF + 4 * c4), bb = *(const GAS f32x4*)(cb + 4 * c4);
        const f32x4 uu = *(const GAS f32x4*)(UFIRST + (size_t)(s * 2 + rr) * DFF + 4 * c4);
        const f32x4 cv = w2 * g0 + w1 * gm1 + w0 * gm2 + bb;
        const float a0 = pg8::gelu_tanh(cv.x) * uu.x, a1 = pg8::gelu_tanh(cv.y) * uu.y, a2 = pg8::gelu_tanh(cv.z) * uu.z, a3 = pg8::gelu_tanh(cv.w) * uu.w;
        *(GAS unsigned long long*)(ACT + (size_t)(64 * s + rr) * DFF + 4 * c4) = (unsigned long long)pk2(a0, a1) | ((unsigned long long)pk2(a2, a3) << 32);
    }
}

__device__ __forceinline__ void fixup_panel(Frame& F, int pm, const float* cw, const float* cb, const float* GFIRST, const float* GLAST, const float* UFIRST, bf16* ACT) {
    constexpr int C4 = DFF / 4, TOTAL = 4 * 2 * C4;
    for (int it = F.tid; it < TOTAL; it += NWAVES * 64) {
        const int c4 = it % C4, rs = it / C4, rr = rs & 1, s = 4 * pm + (rs >> 1); const bool first = (s & 31) == 0;
        const f32x4 z4 = {0.f, 0.f, 0.f, 0.f};
        const f32x4 g0 = *(const GAS f32x4*)(GFIRST + (size_t)(s * 2 + rr) * DFF + 4 * c4);
        f32x4 gm1, gm2;
        if (rr == 0) { gm1 = first ? z4 : *(const GAS f32x4*)(GLAST + (size_t)((s - 1) * 2 + 1) * DFF + 4 * c4); gm2 = first ? z4 : *(const GAS f32x4*)(GLAST + (size_t)((s - 1) * 2 + 0) * DFF + 4 * c4); }
        else { gm1 = *(const GAS f32x4*)(GFIRST + (size_t)(s * 2 + 0) * DFF + 4 * c4); gm2 = first ? z4 : *(const GAS f32x4*)(GLAST + (size_t)((s - 1) * 2 + 1) * DFF + 4 * c4); }
        const f32x4 w0 = *(const GAS f32x4*)(cw + 4 * c4), w1 = *(const GAS f32x4*)(cw + DFF + 4 * c4), w2 = *(const GAS f32x4*)(cw + 2 * DFF + 4 * c4), bb = *(const GAS f32x4*)(cb + 4 * c4);
        const f32x4 uu = *(const GAS f32x4*)(UFIRST + (size_t)(s * 2 + rr) * DFF + 4 * c4);
        const f32x4 cv = w2 * g0 + w1 * gm1 + w0 * gm2 + bb;
        const float a0 = pg8::gelu_tanh(cv.x) * uu.x, a1 = pg8::gelu_tanh(cv.y) * uu.y, a2 = pg8::gelu_tanh(cv.z) * uu.z, a3 = pg8::gelu_tanh(cv.w) * uu.w;
        *(GAS unsigned long long*)(ACT + (size_t)(64 * s + rr) * DFF + 4 * c4) = (unsigned long long)pk2(a0, a1) | ((unsigned long long)pk2(a2, a3) << 32);
    }
}

struct Args { const float* in[16]; float* out; unsigned char* ws; int ph_lo, ph_hi; };
constexpr int N_PHASES = 9;
__global__ void __launch_bounds__(NWAVES * 64, 2) mega_fwd(Args args) {
    extern __shared__ __attribute__((aligned(16))) unsigned char lds[];
    Frame F;
    F.lds = (LAS unsigned char*)lds;
    F.MISC = (volatile LAS unsigned*)(F.lds + MISC_OFF);
    F.tid = threadIdx.x; F.lane = F.tid & 63; F.wave = __builtin_amdgcn_readfirstlane(F.tid >> 6);
    F.G = gridDim.x; { const int bx = blockIdx.x; F.vcu = (F.G % 8 == 0) ? (bx % 8) * (F.G / 8) + bx / 8 : bx; }
    unsigned char* ws = args.ws;
    F.ctl = (gu32*)(ws + WS_CTL);
    const float* x = args.in[0]; const float* g_pre = args.in[1]; const float* w_in = args.in[2]; const float* mconv_w = args.in[3]; const float* mconv_b = args.in[4];
    const float* b_i = args.in[5]; const float* b_f = args.in[6]; const float* mnorm = args.in[7]; const float* w_out = args.in[8]; const float* g_postmix = args.in[9];
    const float* g_preffn = args.in[10]; const float* w_up = args.in[11]; const float* fconv_w = args.in[12]; const float* fconv_b = args.in[13]; const float* w_down = args.in[14];
    const float* g_postffn = args.in[15];
    bf16* WT_IN = (bf16*)(ws + WS_WIN); bf16* WT_OUT = (bf16*)(ws + WS_WOUT); bf16* WT_UP = (bf16*)(ws + WS_WUP); bf16* WT_DN = (bf16*)(ws + WS_WDN);
    float* GATES = (float*)(ws + WS_GATES); bf16* H = (bf16*)(ws + WS_H); bf16* PROJ = (bf16*)(ws + WS_PROJ); bf16* MIXIN = (bf16*)(ws + WS_MIXIN); bf16* MIX = (bf16*)(ws + WS_MIX);
    float* QKFIRST = (float*)(ws + WS_QKFIRST); float* QKLAST = (float*)(ws + WS_QKLAST); float* DN = (float*)(ws + WS_DN); float* NS = (float*)(ws + WS_NS); float* SCAL = (float*)(ws + WS_SCAL); float* MS = (float*)(ws + WS_MS);
    bf16* ACT = (bf16*)(ws + WS_ACT); float* GFIRST = (float*)(ws + WS_GFIRST); float* GLAST = (float*)(ws + WS_GLAST); float* UFIRST = (float*)(ws + WS_UFIRST); bf16* Y = (bf16*)(ws + WS_Y);
    for (int u = F.tid; u < (LDS_BYTES - LDSCTL_OFF) / 4; u += NWAVES * 64) ((LAS unsigned*)(F.lds + LDSCTL_OFF))[u] = 0u;
    __syncthreads();
    XcdBarrier bar = xcd_barrier_post((unsigned*)(F.ctl + CW_BAR), F.MISC + 8);
    const int lo = args.ph_lo, hi = args.ph_hi;
#define IN(k) (lo <= (k) && (k) < hi)
#define SEAM(k) do { if (IN(k) && IN((k) + 1)) xcd_barrier(bar); } while (0)
#ifndef MK_PROBE_MASK
#define MK_PROBE_MASK 0
#endif
#define REPS(k) _Pragma("nounroll") for (int rep_ = 0; rep_ < ((((MK_PROBE_MASK) >> (k)) & 1) ? 2 : 1); ++rep_)
#define GREPS(k) ((((MK_PROBE_MASK) >> (k)) & 1) ? 2 : 1)
#define REPBAR() do { if (rep_) xcd_barrier(bar); } while (0)

    if (IN(0)) REPS(0) { REPBAR(); const P0Args a{x, g_pre, w_in, b_i, b_f, w_out, w_up, w_down, WT_IN, WT_OUT, WT_UP, WT_DN, H, GATES}; p0_prologue(F, a); }
    SEAM(0);
    if (IN(1)) { pg8::Gemm g{H, WT_IN, T, NIN, D}; pg8::StaticOrder S; S.init(T, NIN, F.G, (int)blockIdx.x, GREPS(1));
        pg8::EpiProj E{PROJ, mconv_w, mconv_b, QKFIRST, QKLAST};
        pg8::gemm_phase<pg8::EpiProj, pg8::StaticOrder, true, true>(F.lds + RING_OFF, g, S, E); }
    SEAM(1);
    {
        const MixArgs a{PROJ, GATES, mconv_w, mconv_b, mnorm, args.out, MIXIN, QKFIRST, QKLAST, (bf16*)args.out, (bf16*)args.out + (size_t)2048 * 16384, DN, NS, SCAL, MS};
#if defined(MK_MLSTM_NAIVE)
        if (IN(2)) p2_mixers_naive(F, a);
#else
        if (IN(2)) REPS(2) { REPBAR(); ml_pass_a(F, a); xcd_barrier(bar); ml_pass_b(F, a); __syncthreads(); sb_phase(F, a.PROJ, a.MIXIN); xcd_barrier(bar); ml_pass_c(F, a); }
#endif
    }
    SEAM(2);
    if (IN(3)) { pg8::Gemm g{MIXIN, WT_OUT, T, D, D}; pg8::StaticOrder S; S.init(T, D, F.G, (int)blockIdx.x, GREPS(3));
        pg8::EpiBf16<0> E{MIX, D, nullptr, 0, 0, 1.f};
        pg8::gemm_phase<pg8::EpiBf16<0>, pg8::StaticOrder, true, true>(F.lds + RING_OFF, g, S, E); }
    SEAM(3);
    if (IN(4)) REPS(4) { REPBAR(); p3b_rows(F, x, MIX, g_postmix, g_preffn, args.out, H); }
    SEAM(4);
    if (IN(5)) { pg8::Gemm g{H, WT_UP, T, NUP, D}; pg8::StaticOrder S; S.init(T, NUP, F.G, (int)blockIdx.x, GREPS(5));
        pg8::EpiGateUp E{ACT, fconv_w, fconv_b, GFIRST, GLAST, UFIRST};
        pg8::gemm_phase<pg8::EpiGateUp, pg8::StaticOrder, true, true>(F.lds + RING_OFF, g, S, E); }
    do { if (IN(5) && IN(7)) xcd_barrier(bar); } while (0);
    if (IN(7)) { pg8::Gemm g{ACT, WT_DN, T, D, DFF}; pg8::StaticOrder S; S.init(T, D, F.G, (int)blockIdx.x, GREPS(7));
        { pg8::Unit fu; int lastpm = -1; for (int i = 0; S.next(i, fu); ++i) if (fu.pm != lastpm) { fixup_panel(F, fu.pm, fconv_w, fconv_b, GFIRST, GLAST, UFIRST, ACT); lastpm = fu.pm; } VM_WAIT(); __syncthreads(); }
        pg8::EpiBf16<0> E{Y, D, nullptr, 0, 0, 1.f};
        pg8::gemm_phase<pg8::EpiBf16<0>, pg8::StaticOrder, true, true>(F.lds + RING_OFF, g, S, E); }
    SEAM(7);
    if (IN(8)) p6_rows(F, Y, g_postffn, args.out);
#undef IN
#undef SEAM
}
}

#ifndef MK_N_LAUNCHES
#define MK_N_LAUNCHES 1
#endif
extern "C" void kernel_launch(void* const* d_in, const int* in_sizes, int n_in, void* d_out, int out_size, void* d_ws, size_t ws_size, hipStream_t stream) {
    using namespace mk;
    static int grid = 0;
    if (grid == 0) {
        if (n_in != 16 || in_sizes[0] != T * D || out_size != T * D || ws_size < WS_END) { fprintf(stderr, "kernel_launch: unexpected shapes / workspace (n_in %d, ws %zu); nothing launched\n", n_in, ws_size); grid = -1; return; }
        int dev = 0, cus = 0, per_cu = 0;
        if (hipGetDevice(&dev) != hipSuccess || hipDeviceGetAttribute(&cus, hipDeviceAttributeMultiprocessorCount, dev) != hipSuccess) { grid = -1; return; }
        if (hipFuncSetAttribute((const void*)mega_fwd, hipFuncAttributeMaxDynamicSharedMemorySize, LDS_BYTES) != hipSuccess) { fprintf(stderr, "kernel_launch: hipFuncSetAttribute failed\n"); grid = -1; return; }
        if (hipOccupancyMaxActiveBlocksPerMultiprocessor(&per_cu, (const void*)mega_fwd, NWAVES * 64, LDS_BYTES) != hipSuccess || per_cu < 1) { fprintf(stderr, "kernel_launch: occupancy query says %d blocks per CU\n", per_cu); (void)hipGetLastError(); grid = -1; return; }
        grid = cus >= 128 ? (cus / 128) * 128 : 0;
        if (grid == 0) { grid = -1; return; }
    }
    if (grid < 0) return;
    if (hipMemsetAsync((char*)d_ws + WS_CTL, 0, CTL_ZERO_BYTES, stream) != hipSuccess) return;
    Args a{};
    for (int i = 0; i < 16; ++i) a.in[i] = (const float*)d_in[i];
    a.out = (float*)d_out; a.ws = (unsigned char*)d_ws;
#if MK_N_LAUNCHES == 1
    a.ph_lo = 0; a.ph_hi = N_PHASES;
    hipLaunchKernelGGL(mega_fwd, dim3(grid), dim3(NWAVES * 64), LDS_BYTES, stream, a);
#else
    for (int p = 0; p < N_PHASES; ++p) { a.ph_lo = p; a.ph_hi = p + 1; hipLaunchKernelGGL(mega_fwd, dim3(grid), dim3(NWAVES * 64), LDS_BYTES, stream, a); }
#endif
}
```

```cpp
#include <hip/hip_runtime.h>
#include <cstdio>
#include <cstdint>
#ifdef MK_PROBE_MASK
#define PG8_PROBE (MK_PROBE_MASK)
#else
#define PG8_PROBE 0
#endif
#ifndef PG8_NT_STORES
#define PG8_NT_STORES 1
#endif
#if PG8_NT_STORES
#define PG8_ST16(p, v) __builtin_nontemporal_store((v), (u32x4*)(p))
#else
#define PG8_ST16(p, v) (*(u32x4*)(p) = (v))
#endif
namespace pg8 {
#define PG8_LAS __attribute__((address_space(3)))
typedef unsigned short bf16_t;
typedef short bf16x8 __attribute__((ext_vector_type(8)));
typedef float f32x4 __attribute__((ext_vector_type(4)));
typedef unsigned u32x4 __attribute__((ext_vector_type(4)));
constexpr int BM = 256, BK = 64, HALF = 128, HTB = HALF * BK * 2  , STAGE_BYTES = 8 * HTB, NXCD = 8, WGM = 8;

__host__ __device__ __forceinline__ int lds_byte(int r, int c) { const int st = (r >> 4) * 2 + (c >> 5), rr = r & 15, cc = c & 31, ob = rr * 64 + cc * 2; return st * 1024 + (ob ^ (((ob >> 9) & 1) << 5)); }
__host__ __device__ __forceinline__ void stage_rc(int b, int& R, int& C) { const int st = b / 1024, sb = b % 1024, swz = sb ^ (((sb >> 9) & 1) << 5); R = (st >> 1) * 16 + swz / 64; C = (st & 1) * 32 + (swz % 64) / 2; }
__host__ __device__ __forceinline__ int perm32(int rho) { const int n = rho >> 4, i = rho & 15; return 8 * (i >> 2) + 4 * n + (i & 3); }

struct Unit { int pm, pn, rep; };
struct Gemm { const bf16_t* A; const bf16_t* Bt; int M, N, K; };

struct StaticOrder {
    int nM, nN, nwg, G, c, nrep;
    __host__ __device__ void init(int M, int N, int G_, int c_, int nrep_ = 1) { nM = M / BM; nN = N / BM; nwg = nM * nN; G = G_; c = c_; nrep = nrep_; }
    __host__ __device__ bool next(int i, Unit& u) const {
        const long L = (long)i * G + c; if (L >= (long)nwg * nrep) return false;
        int wgid = (int)(L % nwg); u.rep = (int)(L / nwg); { const int q = nwg / NXCD, r = nwg % NXCD, xcd = wgid % NXCD, off = wgid / NXCD; wgid = (xcd < r ? xcd * (q + 1) : r * (q + 1) + (xcd - r) * q) + off; }
        const int nig = WGM * nN, gid = wgid / nig, fm = gid * WGM, gsz = (nM - fm) < WGM ? (nM - fm) : WGM;
        u.pm = fm + ((wgid % nig) % gsz); u.pn = (wgid % nig) / gsz; return true;
    }
    __device__ __forceinline__ void a_ready(const Unit&) const {}
    __device__ __forceinline__ void done(const Unit&) const {}
};

__device__ __forceinline__ unsigned cvt_pk_bf16(float lo, float hi) { unsigned r; asm volatile("v_cvt_pk_bf16_f32 %0, %1, %2" : "=v"(r) : "v"(lo), "v"(hi)); return r; }
typedef float f32x2 __attribute__((ext_vector_type(2)));
__device__ __forceinline__ f32x2 gelu_pk(f32x2 v) {
    const f32x2 av = __builtin_elementwise_abs(v), d = av * 0.2316418882f + 1.0f;
    f32x2 t; t.x = __builtin_amdgcn_rcpf(d.x); t.y = __builtin_amdgcn_rcpf(d.y);
    f32x2 q = t * 0.5307027145f + (-0.7265760135f); q = q * t + 0.7107068705f; q = q * t + (-0.142248368f); q = q * t + 0.127414796f; q = q * t;
    const f32x2 s = (v * v) * (-0.72134752044f);
    f32x2 e; e.x = __builtin_amdgcn_exp2f(s.x); e.y = __builtin_amdgcn_exp2f(s.y);
    const f32x2 m = v * (q * e), r = v - m;
    f32x2 o; o.x = v.x < 0.f ? m.x : r.x; o.y = v.y < 0.f ? m.y : r.y; return o;
}

template <int ACT  > struct EpiBf16 {
    static constexpr bool PERM = true, AFTER_DRAIN = false, TWICE = (PG8_PROBE >> 16) & 1; static_assert(ACT == 0 || ACT == 1, "EpiBf16: ACT is 0 (none) or 1 (gelu_pk)");
    bf16_t* O; int ldc; const float* bias; int split_cols; size_t split_stride; float scale0;
    __device__ __forceinline__ void operator()(const f32x4 (&acc)[2][2][4][2], const Unit& u, int wr, int wc, int fr, int fq) const {
        const int row0 = u.pm * BM + wr * 64 + fr; int colt = u.pn * BM; bf16_t* base = O;
        float sc = 1.f; if (split_cols) { const int t = colt / split_cols; base += (size_t)t * split_stride; colt -= t * split_cols; if (t == 0) sc = scale0; }
        const int col0 = colt + wc * 32 + 8 * fq, bcol0 = u.pn * BM + wc * 32 + 8 * fq;
        f32x4 bv[2][2];
#pragma unroll
        for (int bj = 0; bj < 2; ++bj)
#pragma unroll
            for (int n = 0; n < 2; ++n) bv[bj][n] = bias ? *(const f32x4*)(bias + bcol0 + bj * HALF + 4 * n) : (f32x4){0.f, 0.f, 0.f, 0.f};
#pragma unroll
        for (int ai = 0; ai < 2; ++ai)
#pragma unroll
            for (int m = 0; m < 4; ++m) { bf16_t* rowp = base + (size_t)(row0 + ai * HALF + m * 16) * ldc + col0;
#pragma unroll
                for (int bj = 0; bj < 2; ++bj) { f32x4 v0 = acc[ai][bj][m][0] + bv[bj][0], v1 = acc[ai][bj][m][1] + bv[bj][1];
                    if (ACT == 1) { f32x2 a = gelu_pk((f32x2){v0[0], v0[1]}), b = gelu_pk((f32x2){v0[2], v0[3]}), c = gelu_pk((f32x2){v1[0], v1[1]}), d = gelu_pk((f32x2){v1[2], v1[3]});
                        v0 = (f32x4){a.x, a.y, b.x, b.y}; v1 = (f32x4){c.x, c.y, d.x, d.y}; }
                    v0 = v0 * sc; v1 = v1 * sc; u32x4 w; w.x = cvt_pk_bf16(v0[0], v0[1]); w.y = cvt_pk_bf16(v0[2], v0[3]); w.z = cvt_pk_bf16(v1[0], v1[1]); w.w = cvt_pk_bf16(v1[2], v1[3]);
                    PG8_ST16(rowp + bj * HALF, w); } }
    }
};

__device__ __forceinline__ float gelu_tanh(float x) {
    const float y = x * (2.3022082f * (1.0f + 0.044715f * x * x));
    return x * __builtin_amdgcn_rcpf(1.0f + __builtin_amdgcn_exp2f(-y));
}
__device__ __forceinline__ float silu_fast(float x) { return x * __builtin_amdgcn_rcpf(1.0f + __builtin_amdgcn_exp2f(-1.4426950408889634f * x)); }
template <int N> __device__ __forceinline__ float ror16(float v) { return __int_as_float(__builtin_amdgcn_update_dpp(0, __float_as_int(v), 0x120 + N, 0xf, 0xf, false)); }
struct EpiGateUp {
    static constexpr bool PERM = true, AFTER_DRAIN = false, TWICE = (PG8_PROBE >> 14) & 1;
    static constexpr int DFF = 2816;
    bf16_t* ACT; const float* cw; const float* cb; float* GFIRST; float* GLAST; float* UFIRST;
    __device__ __forceinline__ void operator()(const f32x4 (&acc)[2][2][4][2], const Unit& u, int wr, int wc, int fr, int fq) const {
        const int colg = u.pn * 128 + wc * 32 + 8 * fq;
        f32x4 w0[2], w1[2], w2[2], bb[2];
#pragma unroll
        for (int n = 0; n < 2; ++n) { w0[n] = *(const f32x4*)(cw + colg + 4 * n); w1[n] = *(const f32x4*)(cw + DFF + colg + 4 * n); w2[n] = *(const f32x4*)(cw + 2 * DFF + colg + 4 * n); bb[n] = *(const f32x4*)(cb + colg + 4 * n); }
#pragma unroll
        for (int ai = 0; ai < 2; ++ai) {
            f32x4 pp1[2] = {{0.f, 0.f, 0.f, 0.f}, {0.f, 0.f, 0.f, 0.f}}, pp2[2] = {{0.f, 0.f, 0.f, 0.f}, {0.f, 0.f, 0.f, 0.f}};
            const int slab = u.pm * 4 + ai * 2 + wr;
#pragma unroll
            for (int m = 0; m < 4; ++m) {
                f32x4 g[2], uu[2], p1[2], p2[2];
#pragma unroll
                for (int n = 0; n < 2; ++n) { g[n] = acc[ai][0][m][n]; uu[n] = acc[ai][1][m][n];
#pragma unroll
                    for (int j = 0; j < 4; ++j) { p1[n][j] = ror16<1>(g[n][j]); p2[n][j] = ror16<2>(g[n][j]); } }
                const size_t row = (size_t)(u.pm * BM + ai * HALF + wr * 64 + m * 16 + fr);
                u32x4 w;
                unsigned pk[4];
#pragma unroll
                for (int n = 0; n < 2; ++n) {
                    const f32x4 g1 = fr >= 1 ? p1[n] : pp1[n], g2 = fr >= 2 ? p2[n] : pp2[n];
                    const f32x4 cv = w2[n] * g[n] + w1[n] * g1 + w0[n] * g2 + bb[n];
                    float a[4];
#pragma unroll
                    for (int j = 0; j < 4; ++j) a[j] = gelu_tanh(cv[j]) * uu[n][j];
                    pk[2 * n] = cvt_pk_bf16(a[0], a[1]); pk[2 * n + 1] = cvt_pk_bf16(a[2], a[3]);
                }
                w.x = pk[0]; w.y = pk[1]; w.z = pk[2]; w.w = pk[3];
                if (m == 0 && fr < 2) {
                    float* gf = GFIRST + (size_t)(slab * 2 + fr) * DFF + colg; float* uf = UFIRST + (size_t)(slab * 2 + fr) * DFF + colg;
                    *(f32x4*)gf = g[0]; *(f32x4*)(gf + 4) = g[1]; *(f32x4*)uf = uu[0]; *(f32x4*)(uf + 4) = uu[1];
                } else {
                    PG8_ST16(ACT + row * DFF + colg, w);
                }
                if (m == 3 && fr >= 14) { float* gl = GLAST + (size_t)(slab * 2 + (fr - 14)) * DFF + colg; *(f32x4*)gl = g[0]; *(f32x4*)(gl + 4) = g[1]; }
#pragma unroll
                for (int n = 0; n < 2; ++n) { pp1[n] = p1[n]; pp2[n] = p2[n]; }
            }
        }
    }
};

struct EpiProj {
    static constexpr bool PERM = true, AFTER_DRAIN = false, TWICE = (PG8_PROBE >> 15) & 1;
    static constexpr int LDC = 3584;
    bf16_t* O; const float* cw; const float* cb; float* QKFIRST; float* QKLAST;
    __device__ __forceinline__ void operator()(const f32x4 (&acc)[2][2][4][2], const Unit& u, int wr, int wc, int fr, int fq) const {
        if (u.pn < 4) {
            const float ksc = (u.pn >= 2) ? 0.08838834764831845f : 1.0f;
#pragma unroll
            for (int bj = 0; bj < 2; ++bj)
#pragma unroll
                for (int n = 0; n < 2; ++n) {
                    const int colc = u.pn * BM + bj * HALF + wc * 32 + 8 * fq + 4 * n;
                    const f32x4 w0 = *(const f32x4*)(cw + colc), w1 = *(const f32x4*)(cw + 1024 + colc), w2 = *(const f32x4*)(cw + 2048 + colc), w3 = *(const f32x4*)(cw + 3072 + colc), bb = *(const f32x4*)(cb + colc);
#pragma unroll
                    for (int ai = 0; ai < 2; ++ai) {
                        f32x4 pp1 = {0.f, 0.f, 0.f, 0.f}, pp2 = pp1, pp3 = pp1;
                        const int slab = u.pm * 4 + ai * 2 + wr;
#pragma unroll
                        for (int m = 0; m < 4; ++m) {
                            const f32x4 g = acc[ai][bj][m][n]; f32x4 p1, p2, p3;
#pragma unroll
                            for (int j = 0; j < 4; ++j) { p1[j] = ror16<1>(g[j]); p2[j] = ror16<2>(g[j]); p3[j] = ror16<3>(g[j]); }
                            const f32x4 g1 = fr >= 1 ? p1 : pp1, g2 = fr >= 2 ? p2 : pp2, g3 = fr >= 3 ? p3 : pp3;
                            const f32x4 cv = w3 * g + w2 * g1 + w1 * g2 + w0 * g3 + bb;
                            float o[4];
#pragma unroll
                            for (int j = 0; j < 4; ++j) o[j] = silu_fast(cv[j]) * ksc;
                            const size_t row = (size_t)(u.pm * BM + ai * HALF + wr * 64 + m * 16 + fr);
                            if (m == 0 && fr < 3) *(f32x4*)(QKFIRST + (size_t)(slab * 3 + fr) * 1024 + colc) = g;
                            else { typedef unsigned u32x2v __attribute__((ext_vector_type(2))); u32x2v w; w.x = cvt_pk_bf16(o[0], o[1]); w.y = cvt_pk_bf16(o[2], o[3]); *(u32x2v*)(O + row * LDC + colc) = w; }
                            if (m == 3 && fr >= 13) *(f32x4*)(QKLAST + (size_t)(slab * 3 + (fr - 13)) * 1024 + colc) = g;
                            pp1 = p1; pp2 = p2; pp3 = p3;
                        }
                    }
                }
            return;
        }
        const int row0 = u.pm * BM + wr * 64 + fr, col0 = u.pn * BM + wc * 32 + 8 * fq;
        const float sc = (u.pn == 8 || u.pn == 9) ? 0.18033688011112042f : 1.0f;
#pragma unroll
        for (int ai = 0; ai < 2; ++ai)
#pragma unroll
            for (int m = 0; m < 4; ++m) { bf16_t* rowp = O + (size_t)(row0 + ai * HALF + m * 16) * LDC + col0;
#pragma unroll
                for (int bj = 0; bj < 2; ++bj) { const f32x4 v0 = acc[ai][bj][m][0] * sc, v1 = acc[ai][bj][m][1] * sc;
                    u32x4 w; w.x = cvt_pk_bf16(v0[0], v0[1]); w.y = cvt_pk_bf16(v0[2], v0[3]); w.z = cvt_pk_bf16(v1[0], v1[1]); w.w = cvt_pk_bf16(v1[2], v1[3]);
                    PG8_ST16(rowp + bj * HALF, w); } }
    }
};
template <class Epi, class Sched, bool ALIGN_EPI = false, bool SP2 = false>
__device__ __forceinline__ void gemm_phase(PG8_LAS unsigned char* lds, const Gemm g, const Sched& S, const Epi& E) {
    const int tid = threadIdx.x, wid = __builtin_amdgcn_readfirstlane(tid >> 6), lane = tid & 63, wr = wid >> 2, wc = wid & 3, fr = lane & 15, fq = lane >> 4;
    const int K = g.K, nt = K / BK;
    unsigned voffA[2], voffB[2];
#pragma unroll
    for (int i = 0; i < 2; ++i) { int R, C; stage_rc(tid * 16 + i * 8192, R, C); const int Rb = Epi::PERM ? ((R & ~31) + perm32(R & 31)) : R;
        voffA[i] = (unsigned)(R * K + C) * 2u; voffB[i] = (unsigned)(Rb * K + C) * 2u; }
    const size_t kstep = (size_t)(BK * 2);
    const size_t hstep = (size_t)HALF * K * 2;
    const size_t tstep = 2 * hstep;
    const unsigned ldsw = (unsigned)wid * 1024u;
    const int aoff = lds_byte(wr * 64 + fr, fq * 8), boff = lds_byte(wc * 32 + fr, fq * 8);
#define PG8_SA(b, h) (((b) * 2 + (h)) * HTB)
#define PG8_SB(b, h) ((4 + (b) * 2 + (h)) * HTB)
#define PG8_STAGE(bufoff, gbase, voff) do { _Pragma("unroll") for (int _i = 0; _i < 2; ++_i) \
        __builtin_amdgcn_global_load_lds((const unsigned*)((const char*)(gbase) + (voff)[_i]), (PG8_LAS unsigned*)(lds + (bufoff) + ldsw + _i * 8192), 16, 0, 0); } while (0)
#define PG8_LDA(dst, b, h) do { _Pragma("unroll") for (int m = 0; m < 4; ++m) _Pragma("unroll") for (int k = 0; k < 2; ++k) dst[m][k] = *(const PG8_LAS bf16x8*)(lds + PG8_SA(b, h) + aoff + m * 2048 + k * 1024); } while (0)
#define PG8_LDB(dst, b, h) do { _Pragma("unroll") for (int n = 0; n < 2; ++n) _Pragma("unroll") for (int k = 0; k < 2; ++k) dst[n][k] = *(const PG8_LAS bf16x8*)(lds + PG8_SB(b, h) + boff + n * 2048 + k * 1024); } while (0)
#define PG8_MMA(ai, bj, At, Bt) do { __builtin_amdgcn_s_setprio(1); _Pragma("unroll") for (int m = 0; m < 4; ++m) _Pragma("unroll") for (int n = 0; n < 2; ++n) _Pragma("unroll") for (int k = 0; k < 2; ++k) \
        acc[ai][bj][m][n] = __builtin_amdgcn_mfma_f32_16x16x32_bf16(Bt[n][k], At[m][k], acc[ai][bj][m][n], 0, 0, 0); __builtin_amdgcn_s_setprio(0); } while (0)
#define PG8_WAIT_V(n) asm volatile("s_waitcnt vmcnt(" #n ")" ::: "memory")
#define PG8_WAIT_L(n) asm volatile("s_waitcnt lgkmcnt(" #n ")" ::: "memory")
#define PG8_BAR __builtin_amdgcn_s_barrier()
#define PG8_SCHED __builtin_amdgcn_sched_barrier(0)
    Unit cur, nxt; int ui = 0;
    if (!S.next(0, cur)) return;
    f32x4 acc[2][2][4][2];
#pragma unroll
    for (int a = 0; a < 2; ++a)
#pragma unroll
        for (int b = 0; b < 2; ++b)
#pragma unroll
            for (int m = 0; m < 4; ++m)
#pragma unroll
                for (int n = 0; n < 2; ++n) acc[a][b][m][n] = (f32x4){0.f, 0.f, 0.f, 0.f};
    bf16x8 At[4][2], B0[2][2], B1[2][2];
    const char* cA = (const char*)g.A + (size_t)cur.pm * tstep; const char* cB = (const char*)g.Bt + (size_t)cur.pn * tstep;
    S.a_ready(cur);
    if constexpr (SP2) {
        PG8_STAGE(PG8_SB(0, 0), cB, voffB); PG8_STAGE(PG8_SB(0, 1), cB + hstep, voffB); PG8_STAGE(PG8_SA(0, 0), cA, voffA); PG8_STAGE(PG8_SA(0, 1), cA + hstep, voffA);
        if (wr == 1) PG8_BAR;
        PG8_WAIT_V(2); PG8_BAR;
        PG8_STAGE(PG8_SB(1, 0), cB + kstep, voffB); PG8_STAGE(PG8_SA(1, 0), cA + kstep, voffA); PG8_STAGE(PG8_SB(1, 1), cB + hstep + kstep, voffB);
        PG8_WAIT_V(6); PG8_BAR;
    } else {
        PG8_STAGE(PG8_SB(0, 0), cB, voffB); PG8_STAGE(PG8_SA(0, 0), cA, voffA); PG8_STAGE(PG8_SB(0, 1), cB + hstep, voffB); PG8_STAGE(PG8_SA(0, 1), cA + hstep, voffA);
        if (wr == 1) PG8_BAR;
        PG8_WAIT_V(4); PG8_BAR;
        PG8_STAGE(PG8_SB(1, 0), cB + kstep, voffB); PG8_STAGE(PG8_SA(1, 0), cA + kstep, voffA); PG8_STAGE(PG8_SB(1, 1), cB + hstep + kstep, voffB);
        PG8_WAIT_V(6); PG8_BAR;
    }
    for (;;) {
        const bool has_next = S.next(ui + 1, nxt);
        const char* nA = has_next ? (const char*)g.A + (size_t)nxt.pm * tstep : cA; const char* nB = has_next ? (const char*)g.Bt + (size_t)nxt.pn * tstep : cB;
        for (int t = 0; t < nt; t += 2) {
            const bool last = (t == nt - 2);
            const char* a1 = cA + (size_t)(t + 1) * kstep;
            const char* a2 = last ? nA : cA + (size_t)(t + 2) * kstep; const char* b2 = last ? nB : cB + (size_t)(t + 2) * kstep;
            const char* a3 = a2 + kstep; const char* b3 = b2 + kstep;
            if (last && has_next) S.a_ready(nxt);
            if constexpr (SP2) {
            PG8_LDB(B0, 0, 0); PG8_LDB(B1, 0, 1); PG8_SCHED; PG8_LDA(At, 0, 0); PG8_STAGE(PG8_SA(1, 1), a1 + hstep, voffA);
            PG8_WAIT_V(8); PG8_WAIT_L(0); PG8_BAR; PG8_MMA(0, 0, At, B0); PG8_MMA(0, 1, At, B1); PG8_BAR; PG8_SCHED;
            PG8_LDA(At, 0, 1); PG8_STAGE(PG8_SB(0, 0), b2, voffB); PG8_STAGE(PG8_SB(0, 1), b2 + hstep, voffB); PG8_STAGE(PG8_SA(0, 0), a2, voffA);
            PG8_WAIT_V(8); PG8_WAIT_L(0); PG8_BAR; PG8_MMA(1, 0, At, B0); PG8_MMA(1, 1, At, B1); PG8_BAR; PG8_SCHED;
            PG8_LDB(B0, 1, 0); PG8_LDB(B1, 1, 1); PG8_SCHED; PG8_LDA(At, 1, 0); PG8_STAGE(PG8_SA(0, 1), a2 + hstep, voffA);
            PG8_WAIT_V(8); PG8_WAIT_L(0); PG8_BAR; PG8_MMA(0, 0, At, B0); PG8_MMA(0, 1, At, B1); PG8_BAR; PG8_SCHED;
            PG8_LDA(At, 1, 1); PG8_STAGE(PG8_SB(1, 0), b3, voffB); PG8_STAGE(PG8_SB(1, 1), b3 + hstep, voffB); PG8_STAGE(PG8_SA(1, 0), a3, voffA);
            PG8_WAIT_V(8); PG8_WAIT_L(0); PG8_BAR; PG8_MMA(1, 0, At, B0); PG8_MMA(1, 1, At, B1); PG8_BAR; PG8_SCHED;
            } else {
            PG8_LDB(B0, 0, 0); PG8_SCHED; PG8_LDA(At, 0, 0); PG8_STAGE(PG8_SA(1, 1), a1 + hstep, voffA);
            PG8_WAIT_L(8); PG8_BAR; PG8_WAIT_L(0); PG8_MMA(0, 0, At, B0); PG8_BAR; PG8_SCHED;
            PG8_LDB(B1, 0, 1); PG8_STAGE(PG8_SB(0, 0), b2, voffB);
            PG8_BAR; PG8_WAIT_L(0); PG8_MMA(0, 1, At, B1); PG8_BAR;
            PG8_LDA(At, 0, 1); PG8_STAGE(PG8_SA(0, 0), a2, voffA);
            PG8_BAR; PG8_WAIT_L(0); PG8_MMA(1, 0, At, B0); PG8_BAR; PG8_SCHED;
            PG8_STAGE(PG8_SB(0, 1), b2 + hstep, voffB);
            PG8_WAIT_V(6); PG8_BAR; PG8_MMA(1, 1, At, B1); PG8_BAR;
            PG8_LDB(B0, 1, 0); PG8_SCHED; PG8_LDA(At, 1, 0); PG8_STAGE(PG8_SA(0, 1), a2 + hstep, voffA);
            PG8_WAIT_L(8); PG8_BAR; PG8_WAIT_L(0); PG8_MMA(0, 0, At, B0); PG8_BAR; PG8_SCHED;
            PG8_LDB(B1, 1, 1); PG8_STAGE(PG8_SB(1, 0), b3, voffB);
            PG8_BAR; PG8_WAIT_L(0); PG8_MMA(0, 1, At, B1); PG8_BAR;
            PG8_LDA(At, 1, 1); PG8_STAGE(PG8_SA(1, 0), a3, voffA);
            PG8_BAR; PG8_WAIT_L(0); PG8_MMA(1, 0, At, B0); PG8_BAR; PG8_SCHED;
            PG8_STAGE(PG8_SB(1, 1), b3 + hstep, voffB);
            PG8_WAIT_V(6); PG8_BAR; PG8_MMA(1, 1, At, B1); PG8_BAR;
            }
        }
        if constexpr (ALIGN_EPI) { if (wr == 0) PG8_BAR; }
        if constexpr (!Epi::AFTER_DRAIN) { if (!(((PG8_PROBE >> 17) & 1) && cur.rep)) E(acc, cur, wr, wc, fr, fq); S.done(cur); }
        if (!has_next) break;
#pragma unroll
        for (int a = 0; a < 2; ++a)
#pragma unroll
            for (int b = 0; b < 2; ++b)
#pragma unroll
                for (int m = 0; m < 4; ++m)
#pragma unroll
                    for (int n = 0; n < 2; ++n) acc[a][b][m][n] = (f32x4){0.f, 0.f, 0.f, 0.f};
        cur = nxt; cA = nA; cB = nB; ++ui;
        if constexpr (ALIGN_EPI) { if (wr == 1) PG8_BAR; }
    }
    PG8_WAIT_V(0);
    if constexpr (!ALIGN_EPI) { if (wr == 0) PG8_BAR; }
    PG8_BAR;
    if constexpr (Epi::AFTER_DRAIN) { E.fused(acc, cur, wr, wc, fr, fq, lds, wid, lane); S.done(cur); }
#undef PG8_SA
#undef PG8_SB
#undef PG8_STAGE
#undef PG8_LDA
#undef PG8_LDB
#undef PG8_MMA
#undef PG8_WAIT_V
#undef PG8_WAIT_L
#undef PG8_BAR
#undef PG8_SCHED
}
}
#define GAS __attribute__((address_space(1)))
#define LAS __attribute__((address_space(3)))
typedef unsigned short bf16;
typedef unsigned v4u __attribute__((ext_vector_type(4)));
typedef float f32x4 __attribute__((ext_vector_type(4)));
typedef short bf16x8 __attribute__((ext_vector_type(8)));
typedef GAS unsigned gu32;
typedef GAS unsigned long long gu64;
#define RLX_AGENT __ATOMIC_RELAXED, __HIP_MEMORY_SCOPE_AGENT
#define LDS_WAIT() asm volatile("s_waitcnt lgkmcnt(0)" ::: "memory")
#define VM_WAIT() asm volatile("s_waitcnt vmcnt(0)" ::: "memory")
__device__ __forceinline__ unsigned long long rt() { return __builtin_amdgcn_s_memrealtime(); }
__device__ __forceinline__ unsigned f2bf(float f) { unsigned u = __builtin_bit_cast(unsigned, f); return (u + 0x7fffu + ((u >> 16) & 1u)) >> 16; }
__device__ __forceinline__ unsigned pk2(float lo, float hi) { return f2bf(lo) | (f2bf(hi) << 16); }

#define XB_TMO      128
#define XB_XCNT(j)  (256  + 64 * (j))
#define XB_XSUB(j)  (1280 + 64 * (j))
#define XB_XGEN(j)  (2304 + 64 * (j))
#define XB_TOP      3328
#define XB_TOPGEN   3392
#define XCD_BAR_WORDS 3456
#define XB_SPIN_CAP (1u << 18)

__device__ __forceinline__ unsigned xb_ld(unsigned* p)              { return __hip_atomic_load(p, __ATOMIC_RELAXED, __HIP_MEMORY_SCOPE_AGENT); }
__device__ __forceinline__ unsigned xb_add(unsigned* p, unsigned v) { return __hip_atomic_fetch_add(p, v, __ATOMIC_RELAXED, __HIP_MEMORY_SCOPE_AGENT); }
__device__ __forceinline__ unsigned xb_xcc_id() { return (unsigned)__builtin_amdgcn_s_getreg((3 << 11) | 20) & 0xFu; }
#define XB_SPIN(cond, bar) do { unsigned _sp = 0; while (cond) { __builtin_amdgcn_s_sleep(1); \
    if ((++_sp & 255u) == 0u) { if (xb_ld(&(bar)[XB_TMO])) break; if (_sp > XB_SPIN_CAP) { atomicAdd(&(bar)[XB_TMO], 1u); break; } } } } while (0)

struct XcdBarrier {
    unsigned* bar; unsigned x;
    volatile LAS unsigned* st;
};

__device__ __forceinline__ XcdBarrier xcd_barrier_post(unsigned* bar, volatile LAS unsigned* st) {
    XcdBarrier b; b.bar = bar; b.x = xb_xcc_id(); b.st = st;
    if (threadIdx.x == 0) (void)xb_add(&bar[XB_XCNT(b.x)], 1u);
    return b;
}
__device__ __forceinline__ void xcd_barrier_complete(unsigned* bar, unsigned x, unsigned& nloc, unsigned& nx) {
    const unsigned G = gridDim.x * gridDim.y * gridDim.z;
    unsigned sum, cnt, mine, sp = 0u;
    for (;;) {
        sum = 0u; cnt = 0u; mine = 0u;
#pragma unroll
        for (unsigned j = 0; j < 16; ++j) { const unsigned c = xb_ld(&bar[XB_XCNT(j)]); sum += c; cnt += (c > 0u) ? 1u : 0u; mine = (j == x) ? c : mine; }
        if (sum == G) break;
        __builtin_amdgcn_s_sleep(1);
        if ((++sp & 255u) == 0u) { if (xb_ld(&bar[XB_TMO])) break; if (sp > XB_SPIN_CAP) { atomicAdd(&bar[XB_TMO], 1u); break; } }
    }
    nloc = mine > 0u ? mine : 1u; nx = cnt > 0u ? cnt : 1u;
}

__device__ __forceinline__ void xcd_barrier(const XcdBarrier& b) {
    asm volatile("s_waitcnt vmcnt(0)" ::: "memory");
    __syncthreads();
    if (threadIdx.x == 0) {
        unsigned* bar = b.bar;
        __builtin_amdgcn_s_waitcnt(0);
        unsigned nloc = b.st[0], nx = b.st[1];
        if (nloc == 0u) { xcd_barrier_complete(bar, b.x, nloc, nx); b.st[0] = nloc; b.st[1] = nx; }
        const unsigned old = xb_add(&bar[XB_XSUB(b.x)], 1u);
        const unsigned gen = old / nloc;
        if (old + 1u == (gen + 1u) * nloc) {
            __builtin_amdgcn_fence(__ATOMIC_RELEASE, "agent");
            asm volatile("s_waitcnt vmcnt(0)" ::: "memory");
            const unsigned og = xb_add(&bar[XB_TOP], 1u);
            const unsigned tg = og / nx;
            if (og + 1u == (tg + 1u) * nx) xb_add(&bar[XB_TOPGEN], 1u);
            else XB_SPIN(xb_ld(&bar[XB_TOPGEN]) == tg, bar);
            __builtin_amdgcn_fence(__ATOMIC_ACQUIRE, "agent");
            xb_add(&bar[XB_XGEN(b.x)], 1u);
            asm volatile("s_waitcnt vmcnt(0)" ::: "memory");
        } else {
            XB_SPIN(xb_ld(&bar[XB_XGEN(b.x)]) == gen, bar);
            __builtin_amdgcn_fence(__ATOMIC_ACQUIRE, "agent");
            asm volatile("s_waitcnt vmcnt(0)" ::: "memory");
        }
    }
    __syncthreads();
}
namespace mk {
constexpr int NWAVES = 8;
constexpr int BATCH = 16, SEQ = 2048, D = 1024, T = BATCH * SEQ;
constexpr int IN_COLS = 3592, NIN = 3584, DFF = 2816, NUP = 2 * DFF;
constexpr int C_QM = 0, C_KM = 512, C_VM = 1024, C_OM = 1536, C_QS = 2048, C_KS = 2560, C_VS = 3072;
constexpr float EPS = 1e-6f;
constexpr size_t MiB = 1u << 20;
constexpr size_t WS_CTL = 0, CTL_ZERO_BYTES = 1 * MiB;
constexpr size_t WS_WIN = 2 * MiB, WS_WOUT = 9 * MiB, WS_WUP = 11 * MiB, WS_WDN = 22 * MiB, WS_GATES = 28 * MiB;
constexpr size_t WS_H = 32 * MiB, WS_PROJ = 96 * MiB, WS_MIXIN = 320 * MiB, WS_MIX = 384 * MiB;
constexpr size_t WS_QKFIRST = 448 * MiB, WS_QKLAST = 454 * MiB, WS_DN = 460 * MiB, WS_NS = 461 * MiB, WS_SCAL = 462 * MiB, WS_MS = 462 * MiB + 65536, WS_END = 463 * MiB;
constexpr size_t WS_ACT = 96 * MiB, WS_GFIRST = 272 * MiB, WS_GLAST = 283 * MiB, WS_UFIRST = 294 * MiB;
constexpr size_t WS_Y = 320 * MiB;
static_assert(WS_ACT + (size_t)T * DFF * 2 <= WS_GFIRST && WS_UFIRST + 11 * MiB <= WS_MIXIN, "ws map");
constexpr int CW_TMO = 0, CW_BAR = 4096;
constexpr int RING_OFF = 0, RING_BYTES = 131072, LDSCTL_OFF = RING_BYTES, MISC_OFF = LDSCTL_OFF + 320, LDS_BYTES = 147456;

struct Frame {
    LAS unsigned char* lds;
    volatile LAS unsigned* MISC;
    gu32* ctl;
    int tid, lane, wave, vcu, G;
};
__device__ __forceinline__ float wave_sum(float v) {
#pragma unroll
    for (int o = 1; o < 64; o <<= 1) v += __shfl_xor(v, o);
    return v;
}
__device__ __forceinline__ float bf2f(bf16 b) { return __uint_as_float((unsigned)b << 16); }
__device__ __forceinline__ float logsig(float x) { return fminf(x, 0.f) - __logf(1.f + __expf(-fabsf(x))); }
__device__ __forceinline__ float sigmoidf_(float x) { return __builtin_amdgcn_rcpf(1.f + __builtin_amdgcn_exp2f(-1.4426950408889634f * x)); }

__device__ __forceinline__ void ld_bf16_row16(const bf16* row, int lane, f32x4 (&v)[4]) {
    const GAS unsigned long long* p = (const GAS unsigned long long*)row + lane;
#pragma unroll
    for (int j = 0; j < 4; ++j) { const unsigned long long w = p[64 * j]; const unsigned lo = (unsigned)w, hi = (unsigned)(w >> 32);
        v[j] = (f32x4){__uint_as_float(lo << 16), __uint_as_float(lo & 0xffff0000u), __uint_as_float(hi << 16), __uint_as_float(hi & 0xffff0000u)}; }
}
__device__ __forceinline__ float sumsq16(const f32x4 (&v)[4]) { float s = 0.f;
#pragma unroll
    for (int j = 0; j < 4; ++j) s += (v[j].x * v[j].x + v[j].y * v[j].y) + (v[j].z * v[j].z + v[j].w * v[j].w);
    return s; }
__device__ __forceinline__ void transpose_item(const float* W, int ldw, int srccol0, bf16* WT, int K, int destrow0, int k0, LAS float* scr, int lane) {
    float tv[32];
#pragma unroll
    for (int i = 0; i < 32; ++i) tv[i] = W[(size_t)(k0 + 2 * i + (lane >> 5)) * ldw + srccol0 + (lane & 31)];
#pragma unroll
    for (int i = 0; i < 32; ++i) scr[(2 * i + (lane >> 5)) * 33 + (lane & 31)] = tv[i];
    LDS_WAIT(); asm volatile("" ::: "memory");
    const int c = lane & 7;
#pragma unroll
    for (int j = 0; j < 4; ++j) { const int n = (lane >> 3) + 8 * j; const LAS float* s = scr + (8 * c) * 33 + n;
        v4u o; o.x = pk2(s[0 * 33], s[1 * 33]); o.y = pk2(s[2 * 33], s[3 * 33]); o.z = pk2(s[4 * 33], s[5 * 33]); o.w = pk2(s[6 * 33], s[7 * 33]);
        *(GAS v4u*)(WT + (size_t)(destrow0 + n) * K + k0 + 8 * c) = o; }
    LDS_WAIT(); asm volatile("" ::: "memory");
}
struct P0Args { const float *x, *g_pre, *w_in, *b_i, *b_f, *w_out, *w_up, *w_down; bf16 *WT_IN, *WT_OUT, *WT_UP, *WT_DN, *H; float* GATES; };
__device__ __forceinline__ void p0_prologue(Frame& F, const P0Args& a) {
    LAS float* scr = (LAS float*)(F.lds + RING_OFF + F.wave * 16384);
    const int gw = F.vcu * NWAVES + F.wave, NGW = F.G * NWAVES;
    constexpr int I_IN = 16 * (NIN / 32), I_OUT = 16 * 32, I_UP = 16 * (NUP / 32), I_DN = (DFF / 64) * 32;
    constexpr int NITEMS = I_IN + I_OUT + I_UP + I_DN;
#ifndef MK_PROBE_MASK
#define MK_PROBE_MASK 0
#endif
    _Pragma("nounroll") for (int rp_ = 0; rp_ < ((((MK_PROBE_MASK) >> 8) & 1) ? 2 : 1); ++rp_)
    for (int it = gw; it < NITEMS; it += NGW) {
        int r = it;
        if (r < I_IN) { const int nblk = NIN / 32, kb = r / nblk, nb = r % nblk, n0 = 32 * nb; const int src = n0 < 2048 ? n0 : n0 + 8;
            transpose_item(a.w_in, IN_COLS, src, a.WT_IN, D, n0, 64 * kb, scr, F.lane); continue; }
        r -= I_IN;
        if (r < I_OUT) { const int kb = r / 32, nb = r % 32; transpose_item(a.w_out, D, 32 * nb, a.WT_OUT, D, 32 * nb, 64 * kb, scr, F.lane); continue; }
        r -= I_OUT;
        if (r < I_UP) { const int nblk = NUP / 32, kb = r / nblk, nb = r % nblk, n0 = 32 * nb, tj = n0 >> 8, w = n0 & 255; const int src = w < 128 ? 128 * tj + w : DFF + 128 * tj + (w - 128);
            transpose_item(a.w_up, NUP, src, a.WT_UP, D, n0, 64 * kb, scr, F.lane); continue; }
        r -= I_UP;
        { const int kb = r / 32, nb = r % 32; transpose_item(a.w_down, D, 32 * nb, a.WT_DN, DFF, 32 * nb, 64 * kb, scr, F.lane); }
    }
    __syncthreads();
    LAS float* WG = (LAS float*)(F.lds + RING_OFF);
    for (int i = F.tid; i < 8 * D; i += NWAVES * 64) { const int k = i >> 3, g = i & 7; WG[g * D + k] = a.w_in[(size_t)k * IN_COLS + 2048 + g]; }
    __syncthreads();
    f32x4 gain[4];
#pragma unroll
    for (int j = 0; j < 4; ++j) gain[j] = ((const GAS f32x4*)a.g_pre)[64 * j + F.lane];
    const int lane = F.lane, b5 = lane >> 5, b4 = (lane >> 4) & 1, b3 = (lane >> 3) & 1, gsel = 4 * b5 + 2 * b4 + b3;
    const float gbias = gsel < 4 ? a.b_i[gsel] : a.b_f[gsel - 4];
    constexpr int RB = 4;
    _Pragma("nounroll") for (int rp_ = 0; rp_ < ((((MK_PROBE_MASK) >> 9) & 1) ? 2 : 1); ++rp_)
    for (int m0 = gw; m0 < T; m0 += NGW * RB) {
        f32x4 v[RB][4];
#pragma unroll
        for (int q = 0; q < RB; ++q) { const int m = m0 + NGW * q; if (m < T) { const GAS f32x4* xr = (const GAS f32x4*)(a.x + (size_t)m * D) + lane;
#pragma unroll
            for (int j = 0; j < 4; ++j) v[q][j] = xr[64 * j]; } }
#pragma unroll
        for (int q = 0; q < RB; ++q) { const int m = m0 + NGW * q; if (m < T) {
            const float rstd = 1.0f / sqrtf(wave_sum(sumsq16(v[q])) * (1.f / D) + EPS);
#pragma unroll
            for (int j = 0; j < 4; ++j) v[q][j] = v[q][j] * rstd * gain[j];
            GAS unsigned long long* o8 = (GAS unsigned long long*)(a.H + (size_t)m * D) + lane;
#pragma unroll
            for (int j = 0; j < 4; ++j) o8[64 * j] = (unsigned long long)pk2(v[q][j].x, v[q][j].y) | ((unsigned long long)pk2(v[q][j].z, v[q][j].w) << 32);
            float d[8];
#pragma unroll
            for (int g = 0; g < 8; ++g) { float s = 0.f;
#pragma unroll
                for (int j = 0; j < 4; ++j) { const f32x4 w = ((const LAS f32x4*)(WG + g * D))[64 * j + lane]; s += (v[q][j].x * w.x + v[q][j].y * w.y) + (v[q][j].z * w.z + v[q][j].w * w.w); }
                d[g] = s; }
            float e4[4], e2[2], e1;
#pragma unroll
            for (int k = 0; k < 4; ++k) { const float keep = b5 ? d[k + 4] : d[k], send = b5 ? d[k] : d[k + 4]; e4[k] = keep + __shfl_xor(send, 32); }
#pragma unroll
            for (int k = 0; k < 2; ++k) { const float keep = b4 ? e4[k + 2] : e4[k], send = b4 ? e4[k] : e4[k + 2]; e2[k] = keep + __shfl_xor(send, 16); }
            { const float keep = b3 ? e2[1] : e2[0], send = b3 ? e2[0] : e2[1]; e1 = keep + __shfl_xor(send, 8); }
            e1 += __shfl_xor(e1, 4); e1 += __shfl_xor(e1, 2); e1 += __shfl_xor(e1, 1);
            if ((lane & 7) == 0) { const float gv = e1 + gbias; a.GATES[(size_t)m * 8 + gsel] = gsel < 4 ? gv : logsig(gv); }
        } }
    }
}

struct MixArgs { const bf16* PROJ; const float* GATES; const float *cw, *cb, *mnorm; float* HRAW; bf16* MIXIN; const float *QKFIRST, *QKLAST; bf16 *DC, *CS; float *DN, *NS, *SCAL, *MS; };
__device__ __forceinline__ float patch_qk(const float* QKFIRST, const float* QKLAST, const float* cw, const float* cb, int slab, bool has_prev, int rr, int chn, float sc) {
    float x[6];
#pragma unroll
    for (int j = 0; j < 3; ++j) { x[j] = has_prev ? QKLAST[(size_t)((slab - 1) * 3 + j) * 1024 + chn] : 0.f; x[3 + j] = QKFIRST[(size_t)(slab * 3 + j) * 1024 + chn]; }
    float y = cb[chn];
#pragma unroll
    for (int j = 0; j < 4; ++j) { const float xv = rr == 0 ? x[j] : (rr == 1 ? x[j + 1] : x[j + 2]); y += cw[j * 1024 + chn] * xv; }
    return y * sc / (1.0f + __expf(-y));
}
__device__ __forceinline__ void mlstm_naive_unit(Frame& F, const MixArgs& a, int b, int h) {
    LAS float* ql = (LAS float*)(F.lds); LAS float* kl = ql + 64 * 128; LAS float* vl = kl + 64 * 128;
    LAS float* fi = vl + 64 * 128; LAS float* ff = fi + 64; LAS float* red = ff + 64; LAS float* redd = red + 2 * 4 * 128;
    const int tid = F.tid, e = tid & 127, dq = tid >> 7;
    const size_t rowbase = (size_t)b * SEQ;
    float C[32], n[32];
#pragma unroll
    for (int i = 0; i < 32; ++i) { C[i] = 0.f; n[i] = 0.f; }
    for (int chunk = 0; chunk < SEQ / 64; ++chunk) {
        __syncthreads();
        for (int i = 0; i < 16; ++i) {
            const int idx = tid + 512 * i, t = idx >> 7, c = idx & 127, tt = chunk * 64 + t;
            if (t >= 3) { const bf16* pr = a.PROJ + (rowbase + tt) * NIN + h * 128 + c; ql[idx] = bf2f(pr[C_QM]); kl[idx] = bf2f(pr[C_KM]); }
            else { const int slab = b * 32 + chunk; ql[idx] = patch_qk(a.QKFIRST, a.QKLAST, a.cw, a.cb, slab, chunk > 0, t, h * 128 + c, 1.0f); kl[idx] = patch_qk(a.QKFIRST, a.QKLAST, a.cw, a.cb, slab, chunk > 0, t, 512 + h * 128 + c, 0.08838834764831845f); }
            vl[idx] = bf2f(a.PROJ[(rowbase + tt) * NIN + C_VM + h * 128 + c]);
        }
        if (tid < 64) { const size_t r = rowbase + chunk * 64 + tid; fi[tid] = __expf(a.GATES[r * 8 + h]); ff[tid] = __expf(a.GATES[r * 8 + 4 + h]); }
        __syncthreads();
        for (int t = 0; t < 64; ++t) {
            const float fg = ff[t], ig = fi[t], ve = vl[t * 128 + e];
            float acc = 0.f, dacc = 0.f;
#pragma unroll
            for (int dd = 0; dd < 32; ++dd) { const float kd = kl[t * 128 + dq * 32 + dd], qd = ql[t * 128 + dq * 32 + dd];
                C[dd] = fg * C[dd] + (ig * kd) * ve; acc += C[dd] * qd; n[dd] = fg * n[dd] + ig * kd; dacc += n[dd] * qd; }
            LAS float* rb = red + (t & 1) * 512; LAS float* rd = redd + (t & 1) * 4;
            rb[dq * 128 + e] = acc; if (e == 0) rd[dq] = dacc;
            __syncthreads();
            if (tid < 128) { const float num = (rb[e] + rb[128 + e]) + (rb[256 + e] + rb[384 + e]); const float den = (rd[0] + rd[1]) + (rd[2] + rd[3]);
                a.HRAW[(rowbase + chunk * 64 + t) * 512 + h * 128 + e] = num / fmaxf(fabsf(den), 1.0f); }
        }
    }
    VM_WAIT(); __syncthreads(); __builtin_amdgcn_fence(__ATOMIC_ACQUIRE, "agent"); VM_WAIT();
    for (int rr = F.wave; rr < SEQ; rr += NWAVES) {
        const size_t r = rowbase + rr;
        const float h0 = a.HRAW[r * 512 + h * 128 + F.lane], h1 = a.HRAW[r * 512 + h * 128 + 64 + F.lane];
        const float rstd = 1.0f / sqrtf(wave_sum(h0 * h0 + h1 * h1) * (1.f / 128.f) + EPS);
        const float o0 = sigmoidf_(bf2f(a.PROJ[r * NIN + C_OM + h * 128 + F.lane])), o1 = sigmoidf_(bf2f(a.PROJ[r * NIN + C_OM + h * 128 + 64 + F.lane]));
        a.MIXIN[r * D + h * 128 + F.lane] = (bf16)f2bf(o0 * h0 * rstd * a.mnorm[h * 128 + F.lane]);
        a.MIXIN[r * D + h * 128 + 64 + F.lane] = (bf16)f2bf(o1 * h1 * rstd * a.mnorm[h * 128 + 64 + F.lane]);
    }
}
__device__ __forceinline__ void sb_naive_unit(Frame& F, const MixArgs& a, int b, int h, int qblk) {
    LAS float* Kl = (LAS float*)(F.lds); LAS float* Vl = Kl + 64 * 64;
    const int tid = F.tid, t = qblk * 512 + tid;
    const size_t rowbase = (size_t)b * SEQ;
    float q[64], o[64], rem = 0.f;
    { const bf16* qp = a.PROJ + (rowbase + t) * NIN + C_QS + h * 64;
#pragma unroll
      for (int d = 0; d < 64; ++d) { q[d] = bf2f(qp[d]) * 0.6931471805599453f; o[d] = 0.f; } }
    for (int kt = qblk * 8 + 7; kt >= 0; --kt) {
        __syncthreads();
        for (int i = 0; i < 8; ++i) { const int idx = tid + 512 * i, s = idx >> 6, d = idx & 63; const bf16* pr = a.PROJ + (rowbase + kt * 64 + s) * NIN + h * 64 + d;
            Kl[idx] = bf2f(pr[C_KS]); Vl[idx] = bf2f(pr[C_VS]); }
        __syncthreads();
        if (kt * 64 < t) {
            for (int sl = 63; sl >= 0; --sl) {
                if (kt * 64 + sl < t) {
                    float z = 0.f;
#pragma unroll
                    for (int d4 = 0; d4 < 16; ++d4) { const f32x4 kv = ((const LAS f32x4*)(Kl + sl * 64))[d4]; z += (q[4 * d4] * kv.x + q[4 * d4 + 1] * kv.y) + (q[4 * d4 + 2] * kv.z + q[4 * d4 + 3] * kv.w); }
                    const float l = __logf(1.f + __expf(-fabsf(z)));
                    const float ls = fminf(z, 0.f) - l, l1 = fminf(-z, 0.f) - l;
                    const float at = __expf(ls + rem); rem += l1;
#pragma unroll
                    for (int d4 = 0; d4 < 16; ++d4) { const f32x4 vv = ((const LAS f32x4*)(Vl + sl * 64))[d4]; o[4 * d4] += at * vv.x; o[4 * d4 + 1] += at * vv.y; o[4 * d4 + 2] += at * vv.z; o[4 * d4 + 3] += at * vv.w; }
                }
            }
        }
    }
    GAS v4u* op = (GAS v4u*)(a.MIXIN + (rowbase + t) * D + 512 + h * 64);
#pragma unroll
    for (int i = 0; i < 8; ++i) { v4u w; w.x = pk2(o[8 * i], o[8 * i + 1]); w.y = pk2(o[8 * i + 2], o[8 * i + 3]); w.z = pk2(o[8 * i + 4], o[8 * i + 5]); w.w = pk2(o[8 * i + 6], o[8 * i + 7]); op[i] = w; }
}

typedef short v4i16_t __attribute__((ext_vector_type(4)));
typedef float f32x16 __attribute__((ext_vector_type(16)));
__device__ __forceinline__ v4i16_t tr16(const LAS unsigned char* p) { return __builtin_amdgcn_ds_read_tr16_b64_v4i16((LAS v4i16_t*)p); }
__device__ __forceinline__ bf16x8 cat8(v4i16_t a, v4i16_t b) { return (bf16x8){a[0], a[1], a[2], a[3], b[0], b[1], b[2], b[3]}; }
typedef float f32x2_t __attribute__((ext_vector_type(2))); typedef __bf16 bf16x2_t __attribute__((ext_vector_type(2)));
__device__ __forceinline__ unsigned cvtpk(float lo, float hi) { f32x2_t v = {lo, hi}; bf16x2_t b = __builtin_convertvector(v, bf16x2_t); return __builtin_bit_cast(unsigned, b); }
__device__ __forceinline__ bf16x8 pack8(const float* p) { v4u w; w.x = cvtpk(p[0], p[1]); w.y = cvtpk(p[2], p[3]); w.z = cvtpk(p[4], p[5]); w.w = cvtpk(p[6], p[7]); return __builtin_bit_cast(bf16x8, w); }
constexpr int SB_VRS = 192, SB_VBUF = 32 * SB_VRS;
__device__ __forceinline__ void sb_phase(Frame& F, const bf16* PROJ, bf16* MIXIN) {
    LAS unsigned char* vb = F.lds + RING_OFF + F.wave * (2 * SB_VBUF);
    const int lane = F.lane, tl = lane & 31, hh = lane >> 5;
    const int troff = (4 * hh + ((lane & 15) >> 2)) * SB_VRS + (16 * ((lane >> 4) & 1) + 4 * (lane & 3)) * 2;
    for (int bu = F.vcu; bu < 1024; bu += F.G) {
        const int bh = bu & 127, qi = (7 - (bu >> 7)) * 8 + F.wave, b = bh >> 3, h = bh & 7;
        const size_t rowbase = (size_t)b * SEQ;
        const bf16* kvbase = PROJ + rowbase * NIN + h * 64;
        bf16x8 qf[4], kf[4], kn[4]; v4u vr[4], vn[4];
        { const bf16* qp = kvbase + (size_t)(32 * qi + tl) * NIN + C_QS + 8 * hh;
#pragma unroll
          for (int s = 0; s < 4; ++s) qf[s] = *(const GAS bf16x8*)(qp + 16 * s); }
#define SB_LOADK(dst, kb) do { const bf16* kp_ = kvbase + (size_t)(32 * (kb) + tl) * NIN + C_KS + 8 * hh; _Pragma("unroll") for (int s = 0; s < 4; ++s) dst[s] = *(const GAS bf16x8*)(kp_ + 16 * s); } while (0)
#define SB_LOADV(dst, kb) do { _Pragma("unroll") for (int i = 0; i < 4; ++i) { const int idx_ = lane + 64 * i; dst[i] = *(const GAS v4u*)(kvbase + (size_t)(32 * (kb) + (idx_ >> 3)) * NIN + C_VS + 8 * (idx_ & 7)); } } while (0)
#define SB_WRITEV(buf, srcv) do { _Pragma("unroll") for (int i = 0; i < 4; ++i) { const int idx_ = lane + 64 * i; *(LAS v4u*)((buf) + (idx_ >> 3) * SB_VRS + 16 * (idx_ & 7)) = srcv[i]; } } while (0)
        bf16x8 k2[4]; v4u v2[4];
        SB_LOADK(kf, qi); SB_LOADV(vr, qi);
        if (qi > 0) { SB_LOADK(kn, qi - 1); SB_LOADV(vn, qi - 1); }
        SB_WRITEV(vb, vr);
        f32x16 o0, o1;
#pragma unroll
        for (int r = 0; r < 16; ++r) { o0[r] = 0.f; o1[r] = 0.f; }
        float carry = 1.f; int cur = 0;
        for (int kb = qi; kb >= 0; --kb) {
            if (kb > 1) { SB_LOADK(k2, kb - 2); SB_LOADV(v2, kb - 2); }
            f32x16 S;
#pragma unroll
            for (int r = 0; r < 16; ++r) S[r] = 0.f;
#pragma unroll
            for (int s = 0; s < 4; ++s) S = __builtin_amdgcn_mfma_f32_32x32x16_bf16(kf[s], qf[s], S, 0, 0, 0);
            float om[16], bt[16];
            const bool diag = (kb == qi);
#pragma unroll
            for (int r = 0; r < 16; ++r) {
                const float e = __builtin_amdgcn_exp2f(fminf(S[r], 100.f));
                float m_ = __builtin_amdgcn_rcpf(1.f + e), b_ = e * m_;
                if (diag) { const bool masked = ((r & 3) + 8 * (r >> 2) + 4 * hh) >= tl; m_ = masked ? 1.f : m_; b_ = masked ? 0.f : b_; }
                om[r] = m_; bt[r] = b_;
            }
            float xs[16], G[4], pG[4];
#pragma unroll
            for (int g = 0; g < 4; ++g) { xs[4 * g + 3] = 1.f; xs[4 * g + 2] = om[4 * g + 3]; xs[4 * g + 1] = xs[4 * g + 2] * om[4 * g + 2]; xs[4 * g] = xs[4 * g + 1] * om[4 * g + 1]; G[g] = xs[4 * g] * om[4 * g]; }
#pragma unroll
            for (int g = 0; g < 4; ++g) pG[g] = __shfl_xor(G[g], 32);
            float Sg[4]; Sg[3] = carry; Sg[2] = Sg[3] * (G[3] * pG[3]); Sg[1] = Sg[2] * (G[2] * pG[2]); Sg[0] = Sg[1] * (G[1] * pG[1]); carry = Sg[0] * (G[0] * pG[0]);
            float P[16];
#pragma unroll
            for (int g = 0; g < 4; ++g) { const float off = hh ? Sg[g] : Sg[g] * pG[g];
#pragma unroll
                for (int j = 0; j < 4; ++j) P[4 * g + j] = bt[4 * g + j] * (xs[4 * g + j] * off); }
            const bf16x8 pb0 = pack8(P), pb1 = pack8(P + 8);
            const LAS unsigned char* vbase = vb + cur * SB_VBUF + troff;
            { const bf16x8 a00 = cat8(tr16(vbase), tr16(vbase + 8 * SB_VRS)), a01 = cat8(tr16(vbase + 64), tr16(vbase + 8 * SB_VRS + 64));
              const bf16x8 a10 = cat8(tr16(vbase + 16 * SB_VRS), tr16(vbase + 24 * SB_VRS)), a11 = cat8(tr16(vbase + 16 * SB_VRS + 64), tr16(vbase + 24 * SB_VRS + 64));
              o0 = __builtin_amdgcn_mfma_f32_32x32x16_bf16(a00, pb0, o0, 0, 0, 0); o1 = __builtin_amdgcn_mfma_f32_32x32x16_bf16(a01, pb0, o1, 0, 0, 0);
              o0 = __builtin_amdgcn_mfma_f32_32x32x16_bf16(a10, pb1, o0, 0, 0, 0); o1 = __builtin_amdgcn_mfma_f32_32x32x16_bf16(a11, pb1, o1, 0, 0, 0); }
            if (__all(carry < 7.888609052210118e-31f)) break;
            if (kb > 0) { SB_WRITEV(vb + (cur ^ 1) * SB_VBUF, vn);
#pragma unroll
                for (int s = 0; s < 4; ++s) { kf[s] = kn[s]; kn[s] = k2[s]; vn[s] = v2[s]; }
                cur ^= 1; }
        }
#undef SB_LOADK
#undef SB_LOADV
#undef SB_WRITEV
        bf16* orow = MIXIN + (rowbase + 32 * qi + tl) * D + 512 + h * 64 + 4 * hh;
#pragma unroll
        for (int g = 0; g < 4; ++g) {
            *(GAS unsigned long long*)(orow + 8 * g) = (unsigned long long)cvtpk(o0[4 * g], o0[4 * g + 1]) | ((unsigned long long)cvtpk(o0[4 * g + 2], o0[4 * g + 3]) << 32);
            *(GAS unsigned long long*)(orow + 32 + 8 * g) = (unsigned long long)cvtpk(o1[4 * g], o1[4 * g + 1]) | ((unsigned long long)cvtpk(o1[4 * g + 2], o1[4 * g + 3]) << 32);
        }
    }
}

constexpr int ML_RST = 320, ML_RSR = 272;
struct ARegs { v4u k[2], v[2]; float x[6]; float lf, li; };
__device__ __forceinline__ void ml_load_a(ARegs& r, const MixArgs& a, int u, int tid, int lane) {
    const int bh = u >> 5, c = u & 31, b = bh >> 2, h = bh & 3; const size_t row0 = (size_t)b * SEQ + 64 * c;
#pragma unroll
    for (int i = 0; i < 2; ++i) { const int idx = tid + 512 * i, s = idx >> 4, ch = idx & 15; const bf16* pr = a.PROJ + (row0 + s) * NIN + h * 128 + ch * 8;
        if (s >= 3) r.k[i] = *(const GAS v4u*)(pr + C_KM);
        r.v[i] = *(const GAS v4u*)(pr + C_VM); }
    if (tid < 384) { const int chn = 512 + h * 128 + (tid & 127), slab = b * 32 + c;
#pragma unroll
        for (int j = 0; j < 3; ++j) { r.x[j] = c > 0 ? a.QKLAST[(size_t)((slab - 1) * 3 + j) * 1024 + chn] : 0.f; r.x[3 + j] = a.QKFIRST[(size_t)(slab * 3 + j) * 1024 + chn]; } }
    r.lf = a.GATES[(row0 + lane) * 8 + 4 + h]; r.li = a.GATES[(row0 + lane) * 8 + h];
}
__device__ __forceinline__ v4u scale_bf16x8(v4u raw, float ws) { v4u o;
    o.x = pk2(__uint_as_float(raw.x << 16) * ws, __uint_as_float(raw.x & 0xffff0000u) * ws); o.y = pk2(__uint_as_float(raw.y << 16) * ws, __uint_as_float(raw.y & 0xffff0000u) * ws);
    o.z = pk2(__uint_as_float(raw.z << 16) * ws, __uint_as_float(raw.z & 0xffff0000u) * ws); o.w = pk2(__uint_as_float(raw.w << 16) * ws, __uint_as_float(raw.w & 0xffff0000u) * ws); return o; }
__device__ __forceinline__ void ml_pass_a(Frame& F, const MixArgs& a) {
    LAS unsigned char* Kl = F.lds + RING_OFF; LAS unsigned char* Vw = Kl + 64 * ML_RST; LAS float* wk = (LAS float*)(Vw + 64 * ML_RST);
    const int tid = F.tid, lane = F.lane, w = F.wave, hh = lane >> 5;
    const int tro = (8 * hh + ((lane & 15) >> 2)) * ML_RST + (16 * ((lane >> 4) & 1) + 4 * (lane & 3)) * 2;
    int u = F.vcu;
    if ((u & 31) == 31 || u >= 2048) return;
    const int hfix = (u >> 5) & 3, prr = tid >> 7, pchn = 512 + hfix * 128 + (tid & 127);
    float pw[4], pb = 0.f;
    if (tid < 384) { pb = a.cb[pchn];
#pragma unroll
        for (int j = 0; j < 4; ++j) pw[j] = a.cw[j * 1024 + pchn]; }
    ARegs cur, nxt; ml_load_a(cur, a, u, tid, lane);
    for (; u < 2048; u += F.G) {
        const int un = u + F.G;
        __syncthreads();
        float bc = cur.lf;
#pragma unroll
        for (int o = 1; o < 64; o <<= 1) { const float t_ = __shfl_up(bc, o); if (lane >= o) bc += t_; }
        const float av = cur.li - bc; float mx = av;
#pragma unroll
        for (int o = 1; o < 64; o <<= 1) mx = fmaxf(mx, __shfl_xor(mx, o));
        const float wkv = __expf(av - mx);
        if (w == 0) { wk[lane] = wkv; if (lane == 63) { a.SCAL[2 * u] = bc; a.SCAL[2 * u + 1] = mx; } }
#pragma unroll
        for (int i = 0; i < 2; ++i) { const int idx = tid + 512 * i, s = idx >> 4, ch = idx & 15;
            if (s >= 3) *(LAS v4u*)(Kl + s * ML_RST + ch * 16) = cur.k[i];
            *(LAS v4u*)(Vw + s * ML_RST + ch * 16) = scale_bf16x8(cur.v[i], __shfl(wkv, s)); }
        if (tid < 384) { float y = pb;
#pragma unroll
            for (int j = 0; j < 4; ++j) { const float xv = prr == 0 ? cur.x[j] : (prr == 1 ? cur.x[j + 1] : cur.x[j + 2]); y += pw[j] * xv; }
            *(LAS bf16*)(Kl + prr * ML_RST + (tid & 127) * 2) = (bf16)f2bf(y * 0.08838834764831845f / (1.0f + __expf(-y))); }
        if (un < 2048) ml_load_a(nxt, a, un, tid, lane);
        __syncthreads();
        {
            const int d = 16 * w + (lane & 15), sq = lane >> 4; float acc = 0.f;
#pragma unroll
            for (int s = 0; s < 16; ++s) acc += wk[16 * sq + s] * bf2f(*(const LAS bf16*)(Kl + (16 * sq + s) * ML_RST + d * 2));
            acc += __shfl_xor(acc, 16); acc += __shfl_xor(acc, 32);
            if (lane < 16) a.DN[(size_t)u * 128 + d] = acc; }
        const int dt = w >> 1, et0 = 2 * (w & 1);
        f32x16 c0, c1;
#pragma unroll
        for (int r = 0; r < 16; ++r) { c0[r] = 0.f; c1[r] = 0.f; }
#pragma unroll
        for (int kk = 0; kk < 4; ++kk) {
            const LAS unsigned char* ka = Kl + tro + 16 * kk * ML_RST + dt * 64; const LAS unsigned char* va = Vw + tro + 16 * kk * ML_RST + et0 * 64;
            const bf16x8 A = cat8(tr16(ka), tr16(ka + 4 * ML_RST)), B0 = cat8(tr16(va), tr16(va + 4 * ML_RST)), B1 = cat8(tr16(va + 64), tr16(va + 4 * ML_RST + 64));
            c0 = __builtin_amdgcn_mfma_f32_32x32x16_bf16(A, B0, c0, 0, 0, 0); c1 = __builtin_amdgcn_mfma_f32_32x32x16_bf16(A, B1, c1, 0, 0, 0);
        }
        bf16* dcu = a.DC + (size_t)u * 16384;
#pragma unroll
        for (int g = 0; g < 4; ++g) {
            const int fo0 = (((et0 * 8 + 2 * dt + (g >> 1)) * 64) + (lane & 31) + 32 * (g & 1)) * 8 + 4 * hh, fo1 = fo0 + 8 * 64 * 8;
            *(GAS unsigned long long*)(dcu + fo0) = (unsigned long long)cvtpk(c0[4 * g], c0[4 * g + 1]) | ((unsigned long long)cvtpk(c0[4 * g + 2], c0[4 * g + 3]) << 32);
            *(GAS unsigned long long*)(dcu + fo1) = (unsigned long long)cvtpk(c1[4 * g], c1[4 * g + 1]) | ((unsigned long long)cvtpk(c1[4 * g + 2], c1[4 * g + 3]) << 32);
        }
        cur = nxt;
    }
}
__device__ __forceinline__ void ml_pass_b(Frame& F, const MixArgs& a) {
    LAS float* scl = (LAS float*)(F.lds + RING_OFF);
    const int tid = F.tid;
    for (int u = F.vcu; u < 256; u += F.G) {
        const int bh = u >> 2, qtr = u & 3;
        __syncthreads();
        if (tid < 64) scl[tid] = a.SCAL[(size_t)bh * 64 + tid];
        __syncthreads();
        const size_t base = (size_t)bh * 32 * 16384 + qtr * 4096 + tid * 8;
        float C[8], nv = 0.f, ms = 0.f;
#pragma unroll
        for (int i = 0; i < 8; ++i) C[i] = 0.f;
        v4u ring[8];
#pragma unroll
        for (int i = 0; i < 8; ++i) ring[i] = *(const GAS v4u*)(a.DC + base + (size_t)i * 16384);
#pragma unroll
        for (int c = 0; c < 32; ++c) {
            v4u o; o.x = pk2(C[0], C[1]); o.y = pk2(C[2], C[3]); o.z = pk2(C[4], C[5]); o.w = pk2(C[6], C[7]);
            *(GAS v4u*)(a.CS + base + (size_t)c * 16384) = o;
            if (tid < 32) a.NS[(size_t)(bh * 32 + c) * 128 + qtr * 32 + tid] = nv;
            if (qtr == 0 && tid == 0) a.MS[bh * 32 + c] = ms;
            if (c < 31) {
                const float bl = scl[2 * c], pm = scl[2 * c + 1], M = fmaxf(pm, ms), sc = __expf(pm - M), dec = __expf(ms - M);
                ms = bl + M;
                const v4u d = ring[c & 7];
                if (c + 8 < 31) ring[c & 7] = *(const GAS v4u*)(a.DC + base + (size_t)(c + 8) * 16384);
                C[0] = dec * C[0] + sc * __uint_as_float(d.x << 16); C[1] = dec * C[1] + sc * __uint_as_float(d.x & 0xffff0000u);
                C[2] = dec * C[2] + sc * __uint_as_float(d.y << 16); C[3] = dec * C[3] + sc * __uint_as_float(d.y & 0xffff0000u);
                C[4] = dec * C[4] + sc * __uint_as_float(d.z << 16); C[5] = dec * C[5] + sc * __uint_as_float(d.z & 0xffff0000u);
                C[6] = dec * C[6] + sc * __uint_as_float(d.w << 16); C[7] = dec * C[7] + sc * __uint_as_float(d.w & 0xffff0000u);
                if (tid < 32) nv = dec * nv + sc * a.DN[(size_t)(bh * 32 + c) * 128 + qtr * 32 + tid];
            }
        }
    }
}
struct CRegs { v4u q[2], k[2], v[2]; float xq[6], xk[6]; float lf, li, ms, nsv; };
__device__ __forceinline__ void ml_load_c(CRegs& r, const MixArgs& a, int u, int tid, int lane) {
    const int bh = u >> 5, c = u & 31, b = bh >> 2, h = bh & 3; const size_t row0 = (size_t)b * SEQ + 64 * c;
#pragma unroll
    for (int i = 0; i < 2; ++i) { const int idx = tid + 512 * i, s = idx >> 4, ch = idx & 15; const bf16* pr = a.PROJ + (row0 + s) * NIN + h * 128 + ch * 8;
        if (s >= 3) { r.q[i] = *(const GAS v4u*)(pr + C_QM); r.k[i] = *(const GAS v4u*)(pr + C_KM); }
        r.v[i] = *(const GAS v4u*)(pr + C_VM); }
    if (tid < 384) { const int chq = h * 128 + (tid & 127), slab = b * 32 + c;
#pragma unroll
        for (int j = 0; j < 3; ++j) { r.xq[j] = c > 0 ? a.QKLAST[(size_t)((slab - 1) * 3 + j) * 1024 + chq] : 0.f; r.xq[3 + j] = a.QKFIRST[(size_t)(slab * 3 + j) * 1024 + chq];
                                      r.xk[j] = c > 0 ? a.QKLAST[(size_t)((slab - 1) * 3 + j) * 1024 + 512 + chq] : 0.f; r.xk[3 + j] = a.QKFIRST[(size_t)(slab * 3 + j) * 1024 + 512 + chq]; } }
    r.lf = a.GATES[(row0 + lane) * 8 + 4 + h]; r.li = a.GATES[(row0 + lane) * 8 + h]; r.ms = a.MS[u];
    if (tid < 128) r.nsv = a.NS[(size_t)u * 128 + tid];
}
__device__ __forceinline__ void ml_pass_c(Frame& F, const MixArgs& a) {
    LAS unsigned char* Ql = F.lds + RING_OFF; LAS unsigned char* Kl = Ql + 64 * ML_RSR; LAS unsigned char* Vl = Kl + 64 * ML_RSR;
    LAS float* al = (LAS float*)(Vl + 64 * ML_RST); LAS float* Ml = al + 64; LAS float* wil = Ml + 64; LAS float* enm = wil + 64; LAS float* nl = enm + 64; LAS float* ssq = nl + 128;
    const int tid = F.tid, lane = F.lane, w = F.wave, hh = lane >> 5, tl = lane & 31;
    const int et = w & 3, tt = w >> 2, t = 32 * tt + tl;
    int u = F.vcu;
    if (u >= 2048) return;
    const int hfix = (u >> 5) & 3, prr = tid >> 7, pchq = hfix * 128 + (tid & 127);
    float pwq[4], pwk[4], pbq = 0.f, pbk = 0.f;
    if (tid < 384) { pbq = a.cb[pchq]; pbk = a.cb[512 + pchq];
#pragma unroll
        for (int j = 0; j < 4; ++j) { pwq[j] = a.cw[j * 1024 + pchq]; pwk[j] = a.cw[j * 1024 + 512 + pchq]; } }
    f32x4 mn[4];
#pragma unroll
    for (int g = 0; g < 4; ++g) mn[g] = *(const GAS f32x4*)(a.mnorm + hfix * 128 + 32 * et + 8 * g + 4 * hh);
    const int trq = (4 * hh + ((lane & 15) >> 2)) * ML_RST + (32 * et + 16 * ((lane >> 4) & 1) + 4 * (lane & 3)) * 2;
    CRegs cur, nxt; ml_load_c(cur, a, u, tid, lane);
    for (; u < 2048; u += F.G) {
        const int un = u + F.G;
        const int bh = u >> 5, c = u & 31, b = bh >> 2, h = bh & 3;
        const size_t row0 = (size_t)b * SEQ + 64 * c;
        __syncthreads();
        if (w == 0) {
            float bc = cur.lf;
#pragma unroll
            for (int o = 1; o < 64; o <<= 1) { const float t_ = __shfl_up(bc, o); if (lane >= o) bc += t_; }
            const float av = cur.li - bc; float pm = av;
#pragma unroll
            for (int o = 1; o < 64; o <<= 1) { const float t_ = __shfl_up(pm, o); if (lane >= o) pm = fmaxf(pm, t_); }
            const float M = fmaxf(pm, cur.ms);
            al[lane] = av; Ml[lane] = M; wil[lane] = __expf(cur.ms - M); enm[lane] = __expf(-bc - M);
        }
        if (tid < 128) nl[tid] = cur.nsv;
#pragma unroll
        for (int i = 0; i < 2; ++i) { const int idx = tid + 512 * i, s = idx >> 4, ch = idx & 15;
            if (s >= 3) { *(LAS v4u*)(Ql + s * ML_RSR + ch * 16) = cur.q[i]; *(LAS v4u*)(Kl + s * ML_RSR + ch * 16) = cur.k[i]; }
            *(LAS v4u*)(Vl + s * ML_RST + ch * 16) = cur.v[i]; }
        if (tid < 384) { float yq = pbq, yk = pbk;
#pragma unroll
            for (int j = 0; j < 4; ++j) { const float xq = prr == 0 ? cur.xq[j] : (prr == 1 ? cur.xq[j + 1] : cur.xq[j + 2]), xk = prr == 0 ? cur.xk[j] : (prr == 1 ? cur.xk[j + 1] : cur.xk[j + 2]); yq += pwq[j] * xq; yk += pwk[j] * xk; }
            *(LAS bf16*)(Ql + prr * ML_RSR + (tid & 127) * 2) = (bf16)f2bf(yq / (1.0f + __expf(-yq)));
            *(LAS bf16*)(Kl + prr * ML_RSR + (tid & 127) * 2) = (bf16)f2bf(yk * 0.08838834764831845f / (1.0f + __expf(-yk))); }
        bf16x8 cf[8];
#pragma unroll
        for (int kk = 0; kk < 8; ++kk) cf[kk] = *(const GAS bf16x8*)(a.CS + (size_t)u * 16384 + ((et * 8 + kk) * 64 + lane) * 8);
        unsigned long long ogw[4];
#pragma unroll
        for (int g = 0; g < 4; ++g) ogw[g] = *(const GAS unsigned long long*)(a.PROJ + (row0 + t) * NIN + C_OM + h * 128 + 32 * et + 8 * g + 4 * hh);
        if (un < 2048) ml_load_c(nxt, a, un, tid, lane);
        __syncthreads();
        bf16x8 qf[8];
#pragma unroll
        for (int kk = 0; kk < 8; ++kk) qf[kk] = *(const LAS bf16x8*)(Ql + t * ML_RSR + (16 * kk + 8 * hh) * 2);
        float qn = 0.f;
#pragma unroll
        for (int kk = 0; kk < 8; ++kk) { const f32x4 n0 = *(const LAS f32x4*)(nl + 16 * kk + 8 * hh), n1 = *(const LAS f32x4*)(nl + 16 * kk + 8 * hh + 4);
            qn += bf2f((bf16)qf[kk][0]) * n0.x + bf2f((bf16)qf[kk][1]) * n0.y + bf2f((bf16)qf[kk][2]) * n0.z + bf2f((bf16)qf[kk][3]) * n0.w
                + bf2f((bf16)qf[kk][4]) * n1.x + bf2f((bf16)qf[kk][5]) * n1.y + bf2f((bf16)qf[kk][6]) * n1.z + bf2f((bf16)qf[kk][7]) * n1.w; }
        qn += __shfl_xor(qn, 32);
        const float Mt = Ml[t], wi = wil[t];
        f32x16 numI; float dsum = 0.f;
#pragma unroll
        for (int r = 0; r < 16; ++r) numI[r] = 0.f;
        for (int st = 0; st <= tt; ++st) {
            f32x16 S;
#pragma unroll
            for (int r = 0; r < 16; ++r) S[r] = 0.f;
#pragma unroll
            for (int kk = 0; kk < 8; ++kk) { const bf16x8 kfr = *(const LAS bf16x8*)(Kl + (32 * st + tl) * ML_RSR + (16 * kk + 8 * hh) * 2); S = __builtin_amdgcn_mfma_f32_32x32x16_bf16(kfr, qf[kk], S, 0, 0, 0); }
            float P[16];
            const bool diag = (st == tt);
#pragma unroll
            for (int g = 0; g < 4; ++g) { const f32x4 a4 = *(const LAS f32x4*)(al + 32 * st + 8 * g + 4 * hh);
#pragma unroll
                for (int j = 0; j < 4; ++j) { float p = S[4 * g + j] * __expf(a4[j] - Mt); if (diag && (8 * g + 4 * hh + j) > tl) p = 0.f; P[4 * g + j] = p; dsum += p; } }
            const bf16x8 pb0 = pack8(P), pb1 = pack8(P + 8);
            const LAS unsigned char* tv = Vl + 32 * st * ML_RST + trq;
            const bf16x8 A0 = cat8(tr16(tv), tr16(tv + 8 * ML_RST)), A1 = cat8(tr16(tv + 16 * ML_RST), tr16(tv + 24 * ML_RST));
            numI = __builtin_amdgcn_mfma_f32_32x32x16_bf16(A0, pb0, numI, 0, 0, 0); numI = __builtin_amdgcn_mfma_f32_32x32x16_bf16(A1, pb1, numI, 0, 0, 0);
        }
        dsum += __shfl_xor(dsum, 32);
        f32x16 qc;
#pragma unroll
        for (int r = 0; r < 16; ++r) qc[r] = 0.f;
#pragma unroll
        for (int kk = 0; kk < 8; ++kk) qc = __builtin_amdgcn_mfma_f32_32x32x16_bf16(cf[kk], qf[kk], qc, 0, 0, 0);
        const float den = dsum + wi * qn, rdn = 1.0f / fmaxf(fabsf(den), enm[t]);
        float hv[16], ss = 0.f;
#pragma unroll
        for (int r = 0; r < 16; ++r) { hv[r] = (numI[r] + wi * qc[r]) * rdn; ss += hv[r] * hv[r]; }
        ss += __shfl_xor(ss, 32);
        if (hh == 0) ssq[et * 64 + t] = ss;
        __syncthreads();
        const float rstd = 1.0f / sqrtf(((ssq[t] + ssq[64 + t]) + (ssq[128 + t] + ssq[192 + t])) * (1.f / 128.f) + EPS);
#pragma unroll
        for (int g = 0; g < 4; ++g) { const int e = h * 128 + 32 * et + 8 * g + 4 * hh;
            const unsigned lo = (unsigned)ogw[g], hi = (unsigned)(ogw[g] >> 32);
            const float o0 = sigmoidf_(__uint_as_float(lo << 16)) * hv[4 * g] * rstd * mn[g].x, o1 = sigmoidf_(__uint_as_float(lo & 0xffff0000u)) * hv[4 * g + 1] * rstd * mn[g].y;
            const float o2 = sigmoidf_(__uint_as_float(hi << 16)) * hv[4 * g + 2] * rstd * mn[g].z, o3 = sigmoidf_(__uint_as_float(hi & 0xffff0000u)) * hv[4 * g + 3] * rstd * mn[g].w;
            *(GAS unsigned long long*)(a.MIXIN + (row0 + t) * D + e) = (unsigned long long)cvtpk(o0, o1) | ((unsigned long long)cvtpk(o2, o3) << 32); }
        cur = nxt;
    }
}
__device__ __forceinline__ void p2_mixers_naive(Frame& F, const MixArgs& a) {
    const int bx = blockIdx.x;
    if (bx < 64) { mlstm_naive_unit(F, a, bx >> 2, bx & 3); __syncthreads(); }
#if defined(MK_SB_NAIVE)
    else { for (int u = bx - 64; u < 512; u += (F.G - 64)) { const int qblk = 3 - (u >> 7), bh = u & 127; sb_naive_unit(F, a, bh >> 3, bh & 7, qblk); } }
#else
    sb_phase(F, a.PROJ, a.MIXIN);
#endif
}

__device__ __forceinline__ void p3b_rows(Frame& F, const float* x, const bf16* MIX, const float* g1, const float* g2, float* out, bf16* H) {
    const int gw = F.vcu * NWAVES + F.wave, NGW = F.G * NWAVES;
    f32x4 ga[4], gb[4];
#pragma unroll
    for (int j = 0; j < 4; ++j) { ga[j] = ((const GAS f32x4*)g1)[64 * j + F.lane]; gb[j] = ((const GAS f32x4*)g2)[64 * j + F.lane]; }
    constexpr int RB = 4;
    for (int m0 = gw; m0 < T; m0 += NGW * RB) {
        f32x4 mv[RB][4], xv[RB][4];
#pragma unroll
        for (int q = 0; q < RB; ++q) { const int m = m0 + NGW * q; if (m < T) { ld_bf16_row16(MIX + (size_t)m * D, F.lane, mv[q]);
            const GAS f32x4* xr = (const GAS f32x4*)(x + (size_t)m * D) + F.lane;
#pragma unroll
            for (int j = 0; j < 4; ++j) xv[q][j] = xr[64 * j]; } }
#pragma unroll
        for (int q = 0; q < RB; ++q) { const int m = m0 + NGW * q; if (m < T) {
            const float r1 = 1.0f / sqrtf(wave_sum(sumsq16(mv[q])) * (1.f / D) + EPS);
#pragma unroll
            for (int j = 0; j < 4; ++j) xv[q][j] = xv[q][j] + mv[q][j] * r1 * ga[j];
            GAS f32x4* orow = (GAS f32x4*)(out + (size_t)m * D) + F.lane;
#pragma unroll
            for (int j = 0; j < 4; ++j) orow[64 * j] = xv[q][j];
            const float r2 = 1.0f / sqrtf(wave_sum(sumsq16(xv[q])) * (1.f / D) + EPS);
            GAS unsigned long long* o8 = (GAS unsigned long long*)(H + (size_t)m * D) + F.lane;
#pragma unroll
            for (int j = 0; j < 4; ++j) { const f32x4 hv = xv[q][j] * r2 * gb[j]; o8[64 * j] = (unsigned long long)pk2(hv.x, hv.y) | ((unsigned long long)pk2(hv.z, hv.w) << 32); }
        } }
    }
}
__device__ __forceinline__ void p6_rows(Frame& F, const bf16* Y, const float* g3, float* out) {
    const int gw = F.vcu * NWAVES + F.wave, NGW = F.G * NWAVES;
    f32x4 ga[4];
#pragma unroll
    for (int j = 0; j < 4; ++j) ga[j] = ((const GAS f32x4*)g3)[64 * j + F.lane];
    constexpr int RB = 4;
    for (int m0 = gw; m0 < T; m0 += NGW * RB) {
        f32x4 yv[RB][4], xv[RB][4];
#pragma unroll
        for (int q = 0; q < RB; ++q) { const int m = m0 + NGW * q; if (m < T) { ld_bf16_row16(Y + (size_t)m * D, F.lane, yv[q]);
            const GAS f32x4* orow = (const GAS f32x4*)(out + (size_t)m * D) + F.lane;
#pragma unroll
            for (int j = 0; j < 4; ++j) xv[q][j] = orow[64 * j]; } }
#pragma unroll
        for (int q = 0; q < RB; ++q) { const int m = m0 + NGW * q; if (m < T) {
            const float r1 = 1.0f / sqrtf(wave_sum(sumsq16(yv[q])) * (1.f / D) + EPS);
            GAS f32x4* orow = (GAS f32x4*)(out + (size_t)m * D) + F.lane;
#pragma unroll
            for (int j = 0; j < 4; ++j) orow[64 * j] = xv[q][j] + yv[q][j] * r1 * ga[j];
        } }
    }
}
__device__ __forceinline__ void p4b_fixup(Frame& F, const float* cw, const float* cb, const float* GFIRST, const float* GLAST, const float* UFIRST, bf16* ACT) {
    constexpr int C4 = DFF / 4, TOTAL = 512 * 2 * C4;
    for (int it = F.vcu * NWAVES * 64 + F.tid; it < TOTAL; it += F.G * NWAVES * 64) {
        const int c4 = it % C4, rs = it / C4, rr = rs & 1, s = rs >> 1; const bool first = (s & 31) == 0;
        const f32x4 z4 = {0.f, 0.f, 0.f, 0.f};
        const f32x4 g0 = *(const GAS f32x4*)(GFIRST + (size_t)(s * 2 + rr) * DFF + 4 * c4);
        f32x4 gm1, gm2;
        if (rr == 0) { gm1 = first ? z4 : *(const GAS f32x4*)(GLAST + (size_t)((s - 1) * 2 + 1) * DFF + 4 * c4); gm2 = first ? z4 : *(const GAS f32x4*)(GLAST + (size_t)((s - 1) * 2 + 0) * DFF + 4 * c4); }
        else { gm1 = *(const GAS f32x4*)(GFIRST + (size_t)(s * 2 + 0) * DFF + 4 * c4); gm2 = first ? z4 : *(const GAS f32x4*)(GLAST + (size_t)((s - 1) * 2 + 1) * DFF + 4 * c4); }
        const f32x4 w0 = *(const GAS f32x4*)(cw + 4 * c4), w1 = *(const GAS f32x4*)(cw + DFF + 4 * c4), w2 = *(const GAS f32x4*)(cw + 2 * DFF + 4 * c4), bb = *(const GAS f32x4*)(cb + 4 * c4);
        const f32x4 uu = *(const GAS f32x4*)(UFIRST + (size_t)(s * 2 + rr) * DFF + 4 * c4);
        const f32x4 cv = w2 * g0 + w1 * gm1 + w0 * gm2 + bb;
        const float a0 = pg8::gelu_tanh(cv.x) * uu.x, a1 = pg8::gelu_tanh(cv.y) * uu.y, a2 = pg8::gelu_tanh(cv.z) * uu.z, a3 = pg8::gelu_tanh(cv.w) * uu.w;
        *(GAS unsigned long long*)(ACT + (size_t)(64 * s + rr) * DFF + 4 * c4) = (unsigned long long)pk2(a0, a1) | ((unsigned long long)pk2(a2, a3) << 32);
    }
}

__device__ __forceinline__ void fixup_panel(Frame& F, int pm, const float* cw, const float* cb, const float* GFIRST, const float* GLAST, const float* UFIRST, bf16* ACT) {
    constexpr int C4 = DFF / 4, TOTAL = 4 * 2 * C4;
    for (int it = F.tid; it < TOTAL; it += NWAVES * 64) {
        const int c4 = it % C4, rs = it / C4, rr = rs & 1, s = 4 * pm + (rs >> 1); const bool first = (s & 31) == 0;
        const f32x4 z4 = {0.f, 0.f, 0.f, 0.f};
        const f32x4 g0 = *(const GAS f32x4*)(GFIRST + (size_t)(s * 2 + rr) * DFF + 4 * c4);
        f32x4 gm1, gm2;
        if (rr == 0) { gm1 = first ? z4 : *(const GAS f32x4*)(GLAST + (size_t)((s - 1) * 2 + 1) * DFF + 4 * c4); gm2 = first ? z4 : *(const GAS f32x4*)(GLAST + (size_t)((s - 1) * 2 + 0) * DFF + 4 * c4); }
        else { gm1 = *(const GAS f32x4*)(GFIRST + (size_t)(s * 2 + 0) * DFF + 4 * c4); gm2 = first ? z4 : *(const GAS f32x4*)(GLAST + (size_t)((s - 1) * 2 + 1) * DFF + 4 * c4); }
        const f32x4 w0 = *(const GAS f32x4*)(cw + 4 * c4), w1 = *(const GAS f32x4*)(cw + DFF + 4 * c4), w2 = *(const GAS f32x4*)(cw + 2 * DFF + 4 * c4), bb = *(const GAS f32x4*)(cb + 4 * c4);
        const f32x4 uu = *(const GAS f32x4*)(UFIRST + (size_t)(s * 2 + rr) * DFF + 4 * c4);
        const f32x4 cv = w2 * g0 + w1 * gm1 + w0 * gm2 + bb;
        const float a0 = pg8::gelu_tanh(cv.x) * uu.x, a1 = pg8::gelu_tanh(cv.y) * uu.y, a2 = pg8::gelu_tanh(cv.z) * uu.z, a3 = pg8::gelu_tanh(cv.w) * uu.w;
        *(GAS unsigned long long*)(ACT + (size_t)(64 * s + rr) * DFF + 4 * c4) = (unsigned long long)pk2(a0, a1) | ((unsigned long long)pk2(a2, a3) << 32);
    }
}

struct Args { const float* in[16]; float* out; unsigned char* ws; int ph_lo, ph_hi; };
constexpr int N_PHASES = 9;
__global__ void __launch_bounds__(NWAVES * 64, 2) mega_fwd(Args args) {
    extern __shared__ __attribute__((aligned(16))) unsigned char lds[];
    Frame F;
    F.lds = (LAS unsigned char*)lds;
    F.MISC = (volatile LAS unsigned*)(F.lds + MISC_OFF);
    F.tid = threadIdx.x; F.lane = F.tid & 63; F.wave = __builtin_amdgcn_readfirstlane(F.tid >> 6);
    F.G = gridDim.x; { const int bx = blockIdx.x; F.vcu = (F.G % 8 == 0) ? (bx % 8) * (F.G / 8) + bx / 8 : bx; }
    unsigned char* ws = args.ws;
    F.ctl = (gu32*)(ws + WS_CTL);
    const float* x = args.in[0]; const float* g_pre = args.in[1]; const float* w_in = args.in[2]; const float* mconv_w = args.in[3]; const float* mconv_b = args.in[4];
    const float* b_i = args.in[5]; const float* b_f = args.in[6]; const float* mnorm = args.in[7]; const float* w_out = args.in[8]; const float* g_postmix = args.in[9];
    const float* g_preffn = args.in[10]; const float* w_up = args.in[11]; const float* fconv_w = args.in[12]; const float* fconv_b = args.in[13]; const float* w_down = args.in[14];
    const float* g_postffn = args.in[15];
    bf16* WT_IN = (bf16*)(ws + WS_WIN); bf16* WT_OUT = (bf16*)(ws + WS_WOUT); bf16* WT_UP = (bf16*)(ws + WS_WUP); bf16* WT_DN = (bf16*)(ws + WS_WDN);
    float* GATES = (float*)(ws + WS_GATES); bf16* H = (bf16*)(ws + WS_H); bf16* PROJ = (bf16*)(ws + WS_PROJ); bf16* MIXIN = (bf16*)(ws + WS_MIXIN); bf16* MIX = (bf16*)(ws + WS_MIX);
    float* QKFIRST = (float*)(ws + WS_QKFIRST); float* QKLAST = (float*)(ws + WS_QKLAST); float* DN = (float*)(ws + WS_DN); float* NS = (float*)(ws + WS_NS); float* SCAL = (float*)(ws + WS_SCAL); float* MS = (float*)(ws + WS_MS);
    bf16* ACT = (bf16*)(ws + WS_ACT); float* GFIRST = (float*)(ws + WS_GFIRST); float* GLAST = (float*)(ws + WS_GLAST); float* UFIRST = (float*)(ws + WS_UFIRST); bf16* Y = (bf16*)(ws + WS_Y);
    for (int u = F.tid; u < (LDS_BYTES - LDSCTL_OFF) / 4; u += NWAVES * 64) ((LAS unsigned*)(F.lds + LDSCTL_OFF))[u] = 0u;
    __syncthreads();
    XcdBarrier bar = xcd_barrier_post((unsigned*)(F.ctl + CW_BAR), F.MISC + 8);
    const int lo = args.ph_lo, hi = args.ph_hi;
#define IN(k) (lo <= (k) && (k) < hi)
#define SEAM(k) do { if (IN(k) && IN((k) + 1)) xcd_barrier(bar); } while (0)
#ifndef MK_PROBE_MASK
#define MK_PROBE_MASK 0
#endif
#define REPS(k) _Pragma("nounroll") for (int rep_ = 0; rep_ < ((((MK_PROBE_MASK) >> (k)) & 1) ? 2 : 1); ++rep_)
#define GREPS(k) ((((MK_PROBE_MASK) >> (k)) & 1) ? 2 : 1)
#define REPBAR() do { if (rep_) xcd_barrier(bar); } while (0)

    if (IN(0)) REPS(0) { REPBAR(); const P0Args a{x, g_pre, w_in, b_i, b_f, w_out, w_up, w_down, WT_IN, WT_OUT, WT_UP, WT_DN, H, GATES}; p0_prologue(F, a); }
    SEAM(0);
    if (IN(1)) { pg8::Gemm g{H, WT_IN, T, NIN, D}; pg8::StaticOrder S; S.init(T, NIN, F.G, (int)blockIdx.x, GREPS(1));
        pg8::EpiProj E{PROJ, mconv_w, mconv_b, QKFIRST, QKLAST};
        pg8::gemm_phase<pg8::EpiProj, pg8::StaticOrder, true, true>(F.lds + RING_OFF, g, S, E); }
    SEAM(1);
    {
        const MixArgs a{PROJ, GATES, mconv_w, mconv_b, mnorm, args.out, MIXIN, QKFIRST, QKLAST, (bf16*)args.out, (bf16*)args.out + (size_t)2048 * 16384, DN, NS, SCAL, MS};
#if defined(MK_MLSTM_NAIVE)
        if (IN(2)) p2_mixers_naive(F, a);
#else
        if (IN(2)) REPS(2) { REPBAR(); ml_pass_a(F, a); xcd_barrier(bar); ml_pass_b(F, a); __syncthreads(); sb_phase(F, a.PROJ, a.MIXIN); xcd_barrier(bar); ml_pass_c(F, a); }
#endif
    }
    SEAM(2);
    if (IN(3)) { pg8::Gemm g{MIXIN, WT_OUT, T, D, D}; pg8::StaticOrder S; S.init(T, D, F.G, (int)blockIdx.x, GREPS(3));
        pg8::EpiBf16<0> E{MIX, D, nullptr, 0, 0, 1.f};
        pg8::gemm_phase<pg8::EpiBf16<0>, pg8::StaticOrder, true, true>(F.lds + RING_OFF, g, S, E); }
    SEAM(3);
    if (IN(4)) REPS(4) { REPBAR(); p3b_rows(F, x, MIX, g_postmix, g_preffn, args.out, H); }
    SEAM(4);
    if (IN(5)) { pg8::Gemm g{H, WT_UP, T, NUP, D}; pg8::StaticOrder S; S.init(T, NUP, F.G, (int)blockIdx.x, GREPS(5));
        pg8::EpiGateUp E{ACT, fconv_w, fconv_b, GFIRST, GLAST, UFIRST};
        pg8::gemm_phase<pg8::EpiGateUp, pg8::StaticOrder, true, true>(F.lds + RING_OFF, g, S, E); }
    do { if (IN(5) && IN(7)) xcd_barrier(bar); } while (0);
    if (IN(7)) { pg8::Gemm g{ACT, WT_DN, T, D, DFF}; pg8::StaticOrder S; S.init(T, D, F.G, (int)blockIdx.x, GREPS(7));
        { pg8::Unit fu; int lastpm = -1; for (int i = 0; S.next(i, fu); ++i) if (fu.pm != lastpm) { fixup_panel(F, fu.pm, fconv_w, fconv_b, GFIRST, GLAST, UFIRST, ACT); lastpm = fu.pm; } VM_WAIT(); __syncthreads(); }
        pg8::EpiBf16<0> E{Y, D, nullptr, 0, 0, 1.f};
        pg8::gemm_phase<pg8::EpiBf16<0>, pg8::StaticOrder, true, true>(F.lds + RING_OFF, g, S, E); }
    SEAM(7);
    if (IN(8)) p6_rows(F, Y, g_postffn, args.out);
#undef IN
#undef SEAM
}
}

#ifndef MK_N_LAUNCHES
#define MK_N_LAUNCHES 1
#endif
extern "C" void kernel_launch(void* const* d_in, const int* in_sizes, int n_in, void* d_out, int out_size, void* d_ws, size_t ws_size, hipStream_t stream) {
    using namespace mk;
    static int grid = 0;
    if (grid == 0) {
        if (n_in != 16 || in_sizes[0] != T * D || out_size != T * D || ws_size < WS_END) { fprintf(stderr, "kernel_launch: unexpected shapes / workspace (n_in %d, ws %zu); nothing launched\n", n_in, ws_size); grid = -1; return; }
        int dev = 0, cus = 0, per_cu = 0;
        if (hipGetDevice(&dev) != hipSuccess || hipDeviceGetAttribute(&cus, hipDeviceAttributeMultiprocessorCount, dev) != hipSuccess) { grid = -1; return; }
        if (hipFuncSetAttribute((const void*)mega_fwd, hipFuncAttributeMaxDynamicSharedMemorySize, LDS_BYTES) != hipSuccess) { fprintf(stderr, "kernel_launch: hipFuncSetAttribute failed\n"); grid = -1; return; }
        if (hipOccupancyMaxActiveBlocksPerMultiprocessor(&per_cu, (const void*)mega_fwd, NWAVES * 64, LDS_BYTES) != hipSuccess || per_cu < 1) { fprintf(stderr, "kernel_launch: occupancy query says %d blocks per CU\n", per_cu); (void)hipGetLastError(); grid = -1; return; }
        grid = cus >= 128 ? (cus / 128) * 128 : 0;
        if (grid == 0) { grid = -1; return; }
    }
    if (grid < 0) return;
    if (hipMemsetAsync((char*)d_ws + WS_CTL, 0, CTL_ZERO_BYTES, stream) != hipSuccess) return;
    Args a{};
    for (int i = 0; i < 16; ++i) a.in[i] = (const float*)d_in[i];
    a.out = (float*)d_out; a.ws = (unsigned char*)d_ws;
#if MK_N_LAUNCHES == 1
    a.ph_lo = 0; a.ph_hi = N_PHASES;
    hipLaunchKernelGGL(mega_fwd, dim3(grid), dim3(NWAVES * 64), LDS_BYTES, stream, a);
#else
    for (int p = 0; p < N_PHASES; ++p) { a.ph_lo = p; a.ph_hi = p + 1; hipLaunchKernelGGL(mega_fwd, dim3(grid), dim3(NWAVES * 64), LDS_BYTES, stream, a); }
#endif
}
```
